# Optimizing an MI355X kernel written in HIP

```python
import jax, jax.numpy as jnp
from jax import lax
import numpy as np

D_MODEL = 1024
BATCH = 16
SEQ = 256
DEPTH = 1
DEC_BATCH = 4
DEC_SEQ = 4096
PAST_LEN = 512

GRID_W = 64
H_A = 4
DK_A = 128
DV_A = 128
W_A = H_A * DV_A
H_B = 4
DK_B = 128
DV_B = 128
W_B = H_B * DV_B
QKV_B = 2 * H_B * DK_B + W_B
CONV_W = 3
CHUNK = 64
D_FF = -(-(8 * D_MODEL) // (3 * 256)) * 256
EPS = 1e-6
PROJ_SIZES = (H_A * DK_A, H_A * DK_A, H_A * DK_A, W_A, W_A, H_B * DK_B, H_B * DK_B, W_B, W_B, 2 * H_B, 2 * H_B)
D_PROJ = sum(PROJ_SIZES)

kernel_name = 'hybrid_hgrn2_gdn_diffusion_step'


def rms_norm(x, w):
    xf = x.astype(jnp.float32)
    y = xf * lax.rsqrt(jnp.mean(xf * xf, axis=-1, keepdims=True) + EPS)
    return (y * w.astype(jnp.float32)).astype(x.dtype)


def head_rms_norm(o, w):
    o = o * lax.rsqrt(jnp.mean(o * o, axis=-1, keepdims=True) + EPS)
    return o.reshape(o.shape[0], o.shape[1], -1) * w.astype(jnp.float32)


def l2norm(x):
    x = x.astype(jnp.float32)
    return x * lax.rsqrt(jnp.sum(x * x, axis=-1, keepdims=True) + EPS)


def _flip(a):
    return jnp.flip(a, axis=1)


def _chunks(a):
    B, T, H, d = a.shape
    return a.reshape(B, T // CHUNK, CHUNK, H, d).transpose(0, 3, 1, 2, 4).astype(jnp.float32)


def _unchunks(o):
    B, H, N, C, d = o.shape
    return o.transpose(0, 2, 3, 1, 4).reshape(B, N * C, H, d)


def to_columns(a, rows):
    B, T, C = a.shape
    return a.reshape(B, rows, GRID_W, C).transpose(0, 2, 1, 3)


def from_columns(a, rows):
    B, T, C = a.shape
    return a.reshape(B, GRID_W, rows, C).transpose(0, 2, 1, 3).reshape(B, T, C)


def centred_conv(x, w):
    pad = CONV_W // 2
    L = x.shape[-2]
    xp = jnp.pad(x, [(0, 0)] * (x.ndim - 2) + [(pad, pad), (0, 0)])
    return sum(xp[..., j:j + L, :] * w[j] for j in range(CONV_W))


def hgrn2_scan(q, k, v, g, s0):
    q, k, v, g = (_chunks(a) for a in (q, k, v, g))
    G = jnp.cumsum(g, axis=-2)
    G_last = G[..., -1:, :]
    q_dec = q * jnp.exp(G)
    k_dec = k * jnp.exp(-G)
    k_tail = k * jnp.exp(G_last - G)
    causal = jnp.tril(jnp.ones((CHUNK, CHUNK), dtype=bool))
    attn = jnp.where(causal, jnp.einsum('bhntk,bhnsk->bhnts', q_dec, k_dec), 0.0)
    o_intra = jnp.einsum('bhnts,bhnsv->bhntv', attn, v)
    u = jnp.einsum('bhnsk,bhnsv->bhnkv', k_tail, v)
    decay = jnp.exp(G_last[..., 0, :])

    def step(s, inp):
        d_c, u_c = inp
        return d_c[..., None] * s + u_c, s

    s_fin, s_in = lax.scan(step, s0.astype(jnp.float32), (jnp.moveaxis(decay, 2, 0), jnp.moveaxis(u, 2, 0)))
    s_in = jnp.moveaxis(s_in, 0, 2)
    o = o_intra + jnp.einsum('bhntk,bhnkv->bhntv', q_dec, s_in)
    return _unchunks(o), s_fin


def gated_delta_scan(q, k, v, beta, g, s0):
    dv = v.shape[-1]
    q, k, v = (_chunks(a) for a in (q, k, v))
    beta, g = (_chunks(a[..., None])[..., 0] for a in (beta, g))
    G = jnp.cumsum(g, axis=-1)
    causal = jnp.tril(jnp.ones((CHUNK, CHUNK), dtype=bool))
    strict = jnp.tril(jnp.ones((CHUNK, CHUNK), dtype=bool), -1)
    diff = G[..., :, None] - G[..., None, :]
    decay_mask = jnp.where(causal, jnp.exp(jnp.where(causal, diff, 0.0)), 0.0)
    k_beta = k * beta[..., None]
    lower = jnp.where(strict, jnp.einsum('bhntk,bhnsk->bhnts', k_beta, k) * decay_mask, 0.0)
    rhs = jnp.concatenate([v * beta[..., None], k_beta * jnp.exp(G)[..., None]], axis=-1)
    sol = lax.linalg.triangular_solve(lower + jnp.eye(CHUNK, dtype=jnp.float32), rhs,
                                      left_side=True, lower=True, unit_diagonal=True)
    u, w = sol[..., :dv], sol[..., dv:]
    attn = jnp.einsum('bhntk,bhnsk->bhnts', q, k) * decay_mask
    q_dec = q * jnp.exp(G)[..., None]
    G_last = G[..., -1:]
    k_tail = k * jnp.exp(G_last - G)[..., None]
    decay = jnp.exp(G_last[..., 0])

    def step(s, inp):
        u_c, w_c, attn_c, q_c, kt_c, d_c = inp
        v_new = u_c - jnp.einsum('bhck,bhkv->bhcv', w_c, s)
        o_c = jnp.einsum('bhtk,bhkv->bhtv', q_c, s) + jnp.einsum('bhts,bhsv->bhtv', attn_c, v_new)
        s = s * d_c[..., None, None] + jnp.einsum('bhsk,bhsv->bhkv', kt_c, v_new)
        return s, o_c

    xs = tuple(jnp.moveaxis(a, 2, 0) for a in (u, w, attn, q_dec, k_tail, decay))
    s_fin, o = lax.scan(step, s0.astype(jnp.float32), xs)
    return _unchunks(jnp.moveaxis(o, 0, 2)), s_fin


def _mixer(h, st_a, st_b, p, grid_rows):
    B, T, _ = h.shape
    split_at = np.cumsum(PROJ_SIZES)[:-1].tolist()
    a_q, a_ff, a_fb, a_i, a_g, b_q, b_k, b_v, b_z, b_beta, b_a = jnp.split(h @ p['w_in'], split_at, axis=-1)
    heads = lambda a, n: a.reshape(B, T, n, -1)

    q_a = heads(jax.nn.silu(a_q), H_A)
    v_a = heads(a_i, H_A)
    lb = p['lb']
    f_fwd = lb[0] + (1.0 - lb[0]) * jax.nn.sigmoid(a_ff.astype(jnp.float32))
    f_bwd = lb[1] + (1.0 - lb[1]) * jax.nn.sigmoid(a_fb.astype(jnp.float32))
    oa_f, sa_f = hgrn2_scan(q_a, heads(1.0 - f_fwd, H_A), v_a, heads(jnp.log(f_fwd), H_A), st_a[:, 0])
    oa_b, sa_b = hgrn2_scan(_flip(q_a), _flip(heads(1.0 - f_bwd, H_A)), _flip(v_a),
                            _flip(heads(jnp.log(f_bwd), H_A)), st_a[:, 1])
    o_a = head_rms_norm(oa_f + _flip(oa_b), p['hgrn_out_norm']) * jax.nn.silu(a_g.astype(jnp.float32))

    qkv = jnp.concatenate([b_q, b_k, b_v], axis=-1)
    gates = jnp.concatenate([b_beta, b_a], axis=-1)
    if grid_rows is None:
        qkv = qkv[:, None]
    else:
        qkv = to_columns(qkv, grid_rows)
        gates = to_columns(gates, grid_rows).reshape(B, T, -1)
    qkv = jax.nn.silu(centred_conv(qkv, p['conv_w'])).reshape(B, T, -1)
    q_b, k_b, v_b = jnp.split(qkv, [H_B * DK_B, 2 * H_B * DK_B], axis=-1)
    q_b = l2norm(heads(q_b, H_B)) * (DK_B ** -0.5)
    k_b = l2norm(heads(k_b, H_B))
    v_b = heads(v_b, H_B)
    gates = gates.astype(jnp.float32)
    beta = jax.nn.sigmoid(gates[..., :2 * H_B]).reshape(B, T, 2, H_B)
    g = -jnp.exp(p['A_log'].astype(jnp.float32)) * jax.nn.softplus(
        gates[..., 2 * H_B:].reshape(B, T, 2, H_B) + p['dt_bias'].astype(jnp.float32))
    ob_f, sb_f = gated_delta_scan(q_b, k_b, v_b, beta[:, :, 0], g[:, :, 0], st_b[:, 0])
    ob_b, sb_b = gated_delta_scan(_flip(q_b), _flip(k_b), _flip(v_b), _flip(beta[:, :, 1]),
                                  _flip(g[:, :, 1]), st_b[:, 1])
    o_b = ob_f + _flip(ob_b)
    if grid_rows is not None:
        o_b = from_columns(o_b.reshape(B, T, -1), grid_rows).reshape(B, T, H_B, DV_B)
    o_b = head_rms_norm(o_b, p['gdn_out_norm']) * jax.nn.silu(b_z.astype(jnp.float32))

    y = jnp.concatenate([o_a, o_b], axis=-1).astype(h.dtype) @ p['w_out']
    return y, jnp.stack([sa_f, sa_b], axis=1), jnp.stack([sb_f, sb_b], axis=1)


def _layer(x, mod, st_a, st_b, p, grid_rows):
    sh1, sc1, g1, sh2, sc2, g2 = jnp.split(mod[:, None, :], 6, axis=-1)
    h = rms_norm(x, p['norm1']) * (1 + sc1) + sh1
    y, st_a, st_b = _mixer(h, st_a, st_b, p, grid_rows)
    x = x + g1 * y
    h = rms_norm(x, p['norm2']) * (1 + sc2) + sh2
    ff = (jax.nn.silu(h @ p['w_gate']) * (h @ p['w_up'])) @ p['w_down']
    return x + g2 * ff, st_a, st_b


def setup_inputs(seed: int = 0) -> dict:
    key = jax.random.key(seed)
    ks = jax.random.split(key, 22)
    nrm = lambda k, s, sc: jax.random.normal(k, s, jnp.float32) * sc
    dt = jnp.exp(jax.random.uniform(ks[14], (DEPTH, 2, H_B), jnp.float32, np.log(1e-3), np.log(1e-1)))
    return {
        'x_prompt': nrm(ks[0], (BATCH, SEQ, D_MODEL), 1.0),
        'x_sample': nrm(ks[1], (DEC_BATCH, DEC_SEQ, D_MODEL), 1.0),
        'c': nrm(ks[2], (DEC_BATCH, D_MODEL), 1.0),
        'state_hgrn': nrm(ks[3], (DEC_BATCH, DEPTH, 2, H_A, DK_A, DV_A), 0.5),
        'state_gdn': nrm(ks[4], (DEC_BATCH, DEPTH, 2, H_B, DK_B, DV_B), 0.5),
        'c_ctx': nrm(ks[5], (D_MODEL,), 1.0),
        'w_ada': nrm(ks[6], (DEPTH, D_MODEL, 6 * D_MODEL), 0.5 * D_MODEL ** -0.5),
        'b_ada': nrm(ks[7], (DEPTH, 6 * D_MODEL), 0.02),
        'norm1': 1.0 + nrm(ks[8], (DEPTH, D_MODEL), 0.02),
        'norm2': 1.0 + nrm(ks[9], (DEPTH, D_MODEL), 0.02),
        'w_in': nrm(ks[10], (DEPTH, D_MODEL, D_PROJ), D_MODEL ** -0.5),
        'conv_w': nrm(ks[11], (DEPTH, CONV_W, QKV_B), CONV_W ** -0.5),
        'hgrn_lb': nrm(ks[12], (DEPTH + 1, 2, H_A * DK_A), 0.1),
        'gdn_A_log': jnp.log(jax.random.uniform(ks[13], (DEPTH, 2, H_B), jnp.float32, 1.0, 16.0)),
        'gdn_dt_bias': dt + jnp.log(-jnp.expm1(-dt)),
        'hgrn_out_norm': 1.0 + nrm(ks[15], (DEPTH, W_A), 0.02),
        'gdn_out_norm': 1.0 + nrm(ks[16], (DEPTH, W_B), 0.02),
        'w_out': nrm(ks[17], (DEPTH, W_A + W_B, D_MODEL), (W_A + W_B) ** -0.5),
        'w_gate': nrm(ks[18], (DEPTH, D_MODEL, D_FF), D_MODEL ** -0.5),
        'w_up': nrm(ks[19], (DEPTH, D_MODEL, D_FF), D_MODEL ** -0.5),
        'w_down': nrm(ks[20], (DEPTH, D_FF, D_MODEL), D_FF ** -0.5),
        'norm_f': 1.0 + nrm(ks[21], (D_MODEL,), 0.02),
    }


def reference(x_prompt, x_sample, c, state_hgrn, state_gdn, c_ctx, w_ada, b_ada, norm1, norm2, w_in,
              conv_w, hgrn_lb, gdn_A_log, gdn_dt_bias, hgrn_out_norm, gdn_out_norm, w_out, w_gate, w_up,
              w_down, norm_f):
    rows = x_sample.shape[1] // GRID_W
    lb_all = jnp.cumsum(jax.nn.softmax(hgrn_lb.astype(jnp.float32), axis=0), axis=0)
    s_ctx = jax.nn.silu(c_ctx)[None]
    s_lat = jax.nn.silu(c)
    xp, xs = x_prompt, x_sample
    zeros_a = jnp.zeros((x_prompt.shape[0], 2, H_A, DK_A, DV_A), jnp.float32)
    zeros_b = jnp.zeros((x_prompt.shape[0], 2, H_B, DK_B, DV_B), jnp.float32)
    new_a, new_b = [], []
    for l in range(DEPTH):
        p = {'norm1': norm1[l], 'norm2': norm2[l], 'w_in': w_in[l], 'conv_w': conv_w[l], 'lb': lb_all[l],
             'A_log': gdn_A_log[l], 'dt_bias': gdn_dt_bias[l], 'hgrn_out_norm': hgrn_out_norm[l],
             'gdn_out_norm': gdn_out_norm[l], 'w_out': w_out[l], 'w_gate': w_gate[l], 'w_up': w_up[l],
             'w_down': w_down[l]}
        m_ctx = s_ctx @ w_ada[l] + b_ada[l]
        m_lat = s_lat @ w_ada[l] + b_ada[l]
        xp, sa, sb = _layer(xp, m_ctx, zeros_a, zeros_b, p, None)
        xs, _, _ = _layer(xs, m_lat, state_hgrn[:, l], state_gdn[:, l], p, rows)
        new_a.append(sa)
        new_b.append(sb)
    new_state_hgrn = jnp.stack(new_a, axis=1)
    new_state_gdn = jnp.stack(new_b, axis=1)
    y_prompt = rms_norm(xp, norm_f)
    y_sample = rms_norm(xs, norm_f)
    return (y_prompt, y_sample, new_state_hgrn, new_state_gdn)
```

```cpp
#include <hip/hip_runtime.h>
#include <cstdio>
#include <cstdint>

#ifndef MK_ONE_LAUNCH
#define MK_ONE_LAUNCH 1
#endif

#define LAS __attribute__((address_space(3)))
#define GAS __attribute__((address_space(1)))
typedef unsigned short bf16;
typedef short bf16x8 __attribute__((ext_vector_type(8)));
typedef float f32x4 __attribute__((ext_vector_type(4)));
typedef float f32x2 __attribute__((ext_vector_type(2)));
typedef unsigned u32x4 __attribute__((ext_vector_type(4)));
typedef unsigned u32x2 __attribute__((ext_vector_type(2)));
typedef GAS unsigned gu32;

constexpr int NT = 20480, NCTX = 4096, DM = 1024, DPROJ = 4624, NPAD = 4864, DFF = 2816, NSEQ = 20;
constexpr float EPS = 1e-6f;
constexpr int NWAVES = 8, NTHR = 512;
enum { I_XP = 0, I_XS, I_C, I_SH, I_SG, I_CCTX, I_WADA, I_BADA, I_N1, I_N2, I_WIN, I_CONV, I_LB, I_ALOG, I_DTB, I_HNORM, I_GNORM, I_WOUT, I_WGATE, I_WUP, I_WDOWN, I_NF, N_IN };

constexpr size_t MiB = 1u << 20;
constexpr size_t WS_CTL = 0, CTL_ZERO_BYTES = 1 * MiB;
constexpr size_t WS_MOD = 1 * MiB;
constexpr size_t WS_BETA = 2 * MiB, WS_GG = 3 * MiB;
constexpr size_t WS_BQ = 4 * MiB, WS_BK = 24 * MiB, WS_BV = 44 * MiB;
constexpr size_t WS_OB = 4 * MiB;
constexpr size_t WS_AG = 64 * MiB, WS_BZ = 84 * MiB;
constexpr size_t WS_I = 104 * MiB;
constexpr size_t WS_H = 104 * MiB;
constexpr size_t WS_WIN = 144 * MiB;
constexpr size_t WS_YIN = 104 * MiB;
constexpr size_t WS_WOUT = 236 * MiB, WS_WGU = 238 * MiB, WS_WDN = 249 * MiB;
constexpr size_t WS_H2 = 4 * MiB;
constexpr size_t WS_GU = 44 * MiB;
constexpr size_t WS_END = 256 * MiB;
constexpr size_t OUT_QA = 0, OUT_VA = 20 * MiB, OUT_GF = 40 * MiB, OUT_GB = 60 * MiB, OUT_OA = 0, OUT_GOVF = 40 * MiB;
constexpr size_t OUT_Y_FLOATS = (size_t)NT * DM, STATE_FLOATS = (size_t)16 * 2 * 4 * 128 * 128;
constexpr int HREC = 41472;
constexpr int GREC = 73984;
constexpr int NUC = 2560, NVB = 1280;
constexpr size_t WS_HVB = WS_I + (size_t)NUC * HREC;
constexpr int N1G = 2154;
static_assert((size_t)N1G * GREC <= 152 * MiB && (size_t)(NUC - N1G) * GREC <= 40 * MiB, "GDN image split");
static_assert(WS_HVB + (size_t)NVB * 16384 <= WS_END, "HGRN images fit");
constexpr int L_WN = 0, L_QD = 16384, L_AT = 32768, L_KT = 40960, L_U = 57344, L_SC = 73728;

constexpr int CW_BAR = 4096;
constexpr int RING_BYTES = 131072, LDSCTL_OFF = RING_BYTES, MISC_OFF = LDSCTL_OFF + 320, LDS_BYTES = 147456;

#define LDS_WAIT() asm volatile("s_waitcnt lgkmcnt(0)" ::: "memory")
#define VM_WAIT() asm volatile("s_waitcnt vmcnt(0)" ::: "memory")
#define RLX_AGENT __ATOMIC_RELAXED, __HIP_MEMORY_SCOPE_AGENT
__device__ __forceinline__ unsigned f2bf(float f) { unsigned u = __builtin_bit_cast(unsigned, f); return (u + 0x7fffu + ((u >> 16) & 1u)) >> 16; }
__device__ __forceinline__ unsigned pk2(float lo, float hi) { return f2bf(lo) | (f2bf(hi) << 16); }
__device__ __forceinline__ float bflo(unsigned w) { return __builtin_bit_cast(float, w << 16); }
__device__ __forceinline__ float bfhi(unsigned w) { return __builtin_bit_cast(float, w & 0xffff0000u); }
__device__ __forceinline__ float bf2f(unsigned short h) { return __builtin_bit_cast(float, (unsigned)h << 16); }
__device__ __forceinline__ float siluf(float x) { return x / (1.f + __expf(-x)); }
__device__ __forceinline__ float sigmf(float x) { return 1.f / (1.f + __expf(-x)); }
__device__ __forceinline__ f32x4 mfma16(bf16x8 a, bf16x8 b, f32x4 c) { return __builtin_amdgcn_mfma_f32_16x16x32_bf16(a, b, c, 0, 0, 0); }
__device__ __forceinline__ bf16x8 as_frag(u32x4 v) { return __builtin_bit_cast(bf16x8, v); }
__device__ __forceinline__ float wave_sum(float v) {
#pragma unroll
    for (int o = 1; o < 64; o <<= 1) v += __shfl_xor(v, o);
    return v;
}
__device__ __forceinline__ int seq_base(int s) { return s < 16 ? s * 256 : NCTX + (s - 16) * 4096; }
__device__ __forceinline__ int seq_nchunk(int s) { return s < 16 ? 4 : 64; }
__device__ __forceinline__ int chunk_base(int s) { return s < 16 ? 4 * s : 64 + 64 * (s - 16); }
__device__ __forceinline__ int tok_a(int s, int n, int i) { return seq_base(s) + 64 * n + i; }
__device__ __forceinline__ int tok_b(int s, int n, int i) { return s < 16 ? s * 256 + 64 * n + i : NCTX + (s - 16) * 4096 + 64 * i + n; }
__device__ __forceinline__ int kperm(int g, int j) { return 16 * (j >> 2) + 4 * g + (j & 3); }

namespace pg8 {
#define PG8_LAS __attribute__((address_space(3)))
typedef unsigned short bf16_t;
typedef short bf16x8 __attribute__((ext_vector_type(8)));
typedef float f32x4 __attribute__((ext_vector_type(4)));
typedef unsigned u32x4 __attribute__((ext_vector_type(4)));
constexpr int BM = 256, BK = 64, HALF = 128, HTB = HALF * BK * 2  , STAGE_BYTES = 8 * HTB, NXCD = 8, WGM = 8;

__host__ __device__ __forceinline__ int lds_byte(int r, int c) { const int st = (r >> 4) * 2 + (c >> 5), rr = r & 15, cc = c & 31, ob = rr * 64 + cc * 2; return st * 1024 + (ob ^ (((ob >> 9) & 1) << 5)); }
__host__ __device__ __forceinline__ void stage_rc(int b, int& R, int& C) { const int st = b / 1024, sb = b % 1024, swz = sb ^ (((sb >> 9) & 1) << 5); R = (st >> 1) * 16 + swz / 64; C = (st & 1) * 32 + (swz % 64) / 2; }
__host__ __device__ __forceinline__ int perm32(int rho) { const int n = rho >> 4, i = rho & 15; return 8 * (i >> 2) + 4 * n + (i & 3); }

struct Unit { int pm, pn; };
struct Gemm { const bf16_t* A; const bf16_t* Bt; int M, N, K; };

struct StaticOrder {
    int nM, nN, nwg, G, c;
    __host__ __device__ void init(int M, int N, int G_, int c_) { nM = M / BM; nN = N / BM; nwg = nM * nN; G = G_; c = c_; }
    __host__ __device__ bool next(int i, Unit& u) const {
        const long L = (long)i * G + c; if (L >= nwg) return false;
        int wgid = (int)L; { const int q = nwg / NXCD, r = nwg % NXCD, xcd = wgid % NXCD, off = wgid / NXCD; wgid = (xcd < r ? xcd * (q + 1) : r * (q + 1) + (xcd - r) * q) + off; }
        const int nig = WGM * nN, gid = wgid / nig, fm = gid * WGM, gsz = (nM - fm) < WGM ? (nM - fm) : WGM;
        u.pm = fm + ((wgid % nig) % gsz); u.pn = (wgid % nig) / gsz; return true;
    }
    __device__ __forceinline__ void a_ready(const Unit&) const {}
    __device__ __forceinline__ void done(const Unit&) const {}
};


__device__ __forceinline__ unsigned pkbf(float lo, float hi) { return ::pk2(lo, hi); }

struct EpiProj {
    static constexpr bool PERM = true, AFTER_DRAIN = false;
    bf16_t *d0, *d1, *d2, *d3, *d4, *d5, *d6, *d7, *d8;
    float* BETA; float* GG;
    const float* lbraw;
    const float* Alog; const float* dtb;
    __device__ __forceinline__ void operator()(const f32x4 (&acc)[2][2][4][2], const Unit& u, int wr, int wc, int fr, int fq) const {
        const int pn = u.pn, row0 = u.pm * BM + wr * 64 + fr;
        if (pn < 18) {
            const int seg = pn >> 1;
            bf16_t* base = seg == 0 ? d0 : seg == 1 ? d1 : seg == 2 ? d2 : seg == 3 ? d3 : seg == 4 ? d4 : seg == 5 ? d5 : seg == 6 ? d6 : seg == 7 ? d7 : d8;
            const int mode = (seg == 0 || seg == 4 || seg == 8) ? 1 : ((seg == 1 || seg == 2) ? 2 : 0);
#pragma unroll
            for (int bj = 0; bj < 2; ++bj) {
                const int c0 = (pn & 1) * 256 + bj * HALF + wc * 32 + 8 * fq;
                float lb[8];
                if (mode == 2) {
                    const int dir = seg - 1;
#pragma unroll
                    for (int e = 0; e < 8; ++e) { const float x0 = lbraw[dir * 512 + c0 + e], x1 = lbraw[1024 + dir * 512 + c0 + e]; lb[e] = 1.f / (1.f + __expf(x1 - x0)); }
                }
#pragma unroll
                for (int ai = 0; ai < 2; ++ai)
#pragma unroll
                    for (int m = 0; m < 4; ++m) {
                        float v[8];
#pragma unroll
                        for (int e = 0; e < 4; ++e) { v[e] = acc[ai][bj][m][0][e]; v[4 + e] = acc[ai][bj][m][1][e]; }
                        if (mode == 1) {
#pragma unroll
                            for (int e = 0; e < 8; ++e) v[e] = ::siluf(v[e]);
                        } else if (mode == 2) {
#pragma unroll
                            for (int e = 0; e < 8; ++e) { const float f = lb[e] + (1.f - lb[e]) * ::sigmf(v[e]); v[e] = __logf(f); }
                        }
                        u32x4 w; w.x = pkbf(v[0], v[1]); w.y = pkbf(v[2], v[3]); w.z = pkbf(v[4], v[5]); w.w = pkbf(v[6], v[7]);
                        *(u32x4*)(base + (size_t)(row0 + ai * HALF + m * 16) * 512 + c0) = w;
                    }
            }
        } else {
            if (wc == 0 && fq < 2) {
                float al[8], db[8];
                if (fq == 1) {
#pragma unroll
                    for (int e = 0; e < 8; ++e) { al[e] = -__expf(Alog[e]); db[e] = dtb[e]; }
                }
#pragma unroll
                for (int ai = 0; ai < 2; ++ai)
#pragma unroll
                    for (int m = 0; m < 4; ++m) {
                        const int row = row0 + ai * HALF + m * 16;
                        float v[8];
#pragma unroll
                        for (int e = 0; e < 4; ++e) { v[e] = acc[ai][0][m][0][e]; v[4 + e] = acc[ai][0][m][1][e]; }
                        if (fq == 0) {
#pragma unroll
                            for (int e = 0; e < 8; ++e) v[e] = ::sigmf(v[e]);
                            *(f32x4*)(BETA + (size_t)row * 8) = (f32x4){v[0], v[1], v[2], v[3]};
                            *(f32x4*)(BETA + (size_t)row * 8 + 4) = (f32x4){v[4], v[5], v[6], v[7]};
                        } else {
#pragma unroll
                            for (int e = 0; e < 8; ++e) { const float x = v[e] + db[e]; const float sp = x > 15.f ? x : log1pf(__expf(x)); v[e] = al[e] * sp; }
                            *(f32x4*)(GG + (size_t)row * 8) = (f32x4){v[0], v[1], v[2], v[3]};
                            *(f32x4*)(GG + (size_t)row * 8 + 4) = (f32x4){v[4], v[5], v[6], v[7]};
                        }
                    }
            }
        }
    }
};

struct EpiRes {
    static constexpr bool PERM = true, AFTER_DRAIN = false;
    const float* base0; const float* base1;
    float* out; const float* mod; int goff;
    __device__ __forceinline__ void operator()(const f32x4 (&acc)[2][2][4][2], const Unit& u, int wr, int wc, int fr, int fq) const {
        const int row0 = u.pm * BM + wr * 64 + fr;
        const int mr = u.pm < 16 ? 0 : 1 + ((u.pm - 16) >> 4);
        const float* gp = mod + (size_t)mr * 6144 + goff;
#pragma unroll
        for (int bj = 0; bj < 2; ++bj) {
            const int c0 = u.pn * BM + bj * HALF + wc * 32 + 8 * fq;
            const f32x4 g0 = *(const f32x4*)(gp + c0), g1 = *(const f32x4*)(gp + c0 + 4);
#pragma unroll
            for (int ai = 0; ai < 2; ++ai)
#pragma unroll
                for (int m = 0; m < 4; ++m) {
                    const int row = row0 + ai * HALF + m * 16;
                    const float* bp = (row < 4096 ? base0 + (size_t)row * 1024 : base1 + (size_t)(row - 4096) * 1024) + c0;
                    const f32x4 b0 = *(const f32x4*)bp, b1 = *(const f32x4*)(bp + 4);
                    float* op = out + (size_t)row * 1024 + c0;
                    *(f32x4*)op = b0 + g0 * acc[ai][bj][m][0];
                    *(f32x4*)(op + 4) = b1 + g1 * acc[ai][bj][m][1];
                }
        }
    }
};

struct EpiGU {
    static constexpr bool PERM = true, AFTER_DRAIN = false;
    bf16_t* GU;
    __device__ __forceinline__ void operator()(const f32x4 (&acc)[2][2][4][2], const Unit& u, int wr, int wc, int fr, int fq) const {
        const int row0 = u.pm * BM + wr * 64 + fr, c0 = u.pn * HALF + wc * 32 + 8 * fq;
#pragma unroll
        for (int ai = 0; ai < 2; ++ai)
#pragma unroll
            for (int m = 0; m < 4; ++m) {
                float v[8];
#pragma unroll
                for (int e = 0; e < 4; ++e) { v[e] = ::siluf(acc[ai][0][m][0][e]) * acc[ai][1][m][0][e]; v[4 + e] = ::siluf(acc[ai][0][m][1][e]) * acc[ai][1][m][1][e]; }
                u32x4 w; w.x = pkbf(v[0], v[1]); w.y = pkbf(v[2], v[3]); w.z = pkbf(v[4], v[5]); w.w = pkbf(v[6], v[7]);
                *(u32x4*)(GU + (size_t)(row0 + ai * HALF + m * 16) * 2816 + c0) = w;
            }
    }
};
template <class Epi, class Sched, bool ALIGN_EPI = false, bool SP2 = false>
__device__ __forceinline__ void gemm_phase(PG8_LAS unsigned char* lds, const Gemm g, const Sched& S, const Epi& E) {
    const int tid = threadIdx.x, wid = __builtin_amdgcn_readfirstlane(tid >> 6), lane = tid & 63, wr = wid >> 2, wc = wid & 3, fr = lane & 15, fq = lane >> 4;
    const int K = g.K, nt = K / BK;
    unsigned voffA[2], voffB[2];
#pragma unroll
    for (int i = 0; i < 2; ++i) { int R, C; stage_rc(tid * 16 + i * 8192, R, C); const int Rb = Epi::PERM ? ((R & ~31) + perm32(R & 31)) : R;
        voffA[i] = (unsigned)(R * K + C) * 2u; voffB[i] = (unsigned)(Rb * K + C) * 2u; }
    const size_t kstep = (size_t)(BK * 2);
    const size_t hstep = (size_t)HALF * K * 2;
    const size_t tstep = 2 * hstep;
    const unsigned ldsw = (unsigned)wid * 1024u;
    const int aoff = lds_byte(wr * 64 + fr, fq * 8), boff = lds_byte(wc * 32 + fr, fq * 8);
#define PG8_SA(b, h) (((b) * 2 + (h)) * HTB)
#define PG8_SB(b, h) ((4 + (b) * 2 + (h)) * HTB)
#define PG8_STAGE(bufoff, gbase, voff) do { _Pragma("unroll") for (int _i = 0; _i < 2; ++_i) \
        __builtin_amdgcn_global_load_lds((const unsigned*)((const char*)(gbase) + (voff)[_i]), (PG8_LAS unsigned*)(lds + (bufoff) + ldsw + _i * 8192), 16, 0, 0); } while (0)
#define PG8_LDA(dst, b, h) do { _Pragma("unroll") for (int m = 0; m < 4; ++m) _Pragma("unroll") for (int k = 0; k < 2; ++k) dst[m][k] = *(const PG8_LAS bf16x8*)(lds + PG8_SA(b, h) + aoff + m * 2048 + k * 1024); } while (0)
#define PG8_LDB(dst, b, h) do { _Pragma("unroll") for (int n = 0; n < 2; ++n) _Pragma("unroll") for (int k = 0; k < 2; ++k) dst[n][k] = *(const PG8_LAS bf16x8*)(lds + PG8_SB(b, h) + boff + n * 2048 + k * 1024); } while (0)
#define PG8_MMA(ai, bj, At, Bt) do { __builtin_amdgcn_s_setprio(1); _Pragma("unroll") for (int m = 0; m < 4; ++m) _Pragma("unroll") for (int n = 0; n < 2; ++n) _Pragma("unroll") for (int k = 0; k < 2; ++k) \
        acc[ai][bj][m][n] = __builtin_amdgcn_mfma_f32_16x16x32_bf16(Bt[n][k], At[m][k], acc[ai][bj][m][n], 0, 0, 0); __builtin_amdgcn_s_setprio(0); } while (0)
#define PG8_WAIT_V(n) asm volatile("s_waitcnt vmcnt(" #n ")" ::: "memory")
#define PG8_WAIT_L(n) asm volatile("s_waitcnt lgkmcnt(" #n ")" ::: "memory")
#define PG8_BAR __builtin_amdgcn_s_barrier()
#define PG8_SCHED __builtin_amdgcn_sched_barrier(0)
    Unit cur, nxt; int ui = 0;
    if (!S.next(0, cur)) return;
    f32x4 acc[2][2][4][2];
#pragma unroll
    for (int a = 0; a < 2; ++a)
#pragma unroll
        for (int b = 0; b < 2; ++b)
#pragma unroll
            for (int m = 0; m < 4; ++m)
#pragma unroll
                for (int n = 0; n < 2; ++n) acc[a][b][m][n] = (f32x4){0.f, 0.f, 0.f, 0.f};
    bf16x8 At[4][2], B0[2][2], B1[2][2];
    const char* cA = (const char*)g.A + (size_t)cur.pm * tstep; const char* cB = (const char*)g.Bt + (size_t)cur.pn * tstep;
    S.a_ready(cur);
    if constexpr (SP2) {
        PG8_STAGE(PG8_SB(0, 0), cB, voffB); PG8_STAGE(PG8_SB(0, 1), cB + hstep, voffB); PG8_STAGE(PG8_SA(0, 0), cA, voffA); PG8_STAGE(PG8_SA(0, 1), cA + hstep, voffA);
        if (wr == 1) PG8_BAR;
        PG8_WAIT_V(2); PG8_BAR;
        PG8_STAGE(PG8_SB(1, 0), cB + kstep, voffB); PG8_STAGE(PG8_SA(1, 0), cA + kstep, voffA); PG8_STAGE(PG8_SB(1, 1), cB + hstep + kstep, voffB);
        PG8_WAIT_V(6); PG8_BAR;
    } else {
        PG8_STAGE(PG8_SB(0, 0), cB, voffB); PG8_STAGE(PG8_SA(0, 0), cA, voffA); PG8_STAGE(PG8_SB(0, 1), cB + hstep, voffB); PG8_STAGE(PG8_SA(0, 1), cA + hstep, voffA);
        if (wr == 1) PG8_BAR;
        PG8_WAIT_V(4); PG8_BAR;
        PG8_STAGE(PG8_SB(1, 0), cB + kstep, voffB); PG8_STAGE(PG8_SA(1, 0), cA + kstep, voffA); PG8_STAGE(PG8_SB(1, 1), cB + hstep + kstep, voffB);
        PG8_WAIT_V(6); PG8_BAR;
    }
    for (;;) {
        const bool has_next = S.next(ui + 1, nxt);
        const char* nA = has_next ? (const char*)g.A + (size_t)nxt.pm * tstep : cA; const char* nB = has_next ? (const char*)g.Bt + (size_t)nxt.pn * tstep : cB;
        for (int t = 0; t < nt; t += 2) {
            const bool last = (t == nt - 2);
            const char* a1 = cA + (size_t)(t + 1) * kstep;
            const char* a2 = last ? nA : cA + (size_t)(t + 2) * kstep; const char* b2 = last ? nB : cB + (size_t)(t + 2) * kstep;
            const char* a3 = a2 + kstep; const char* b3 = b2 + kstep;
            if (last && has_next) S.a_ready(nxt);
            if constexpr (SP2) {
            PG8_LDB(B0, 0, 0); PG8_LDB(B1, 0, 1); PG8_SCHED; PG8_LDA(At, 0, 0); PG8_STAGE(PG8_SA(1, 1), a1 + hstep, voffA);
            PG8_WAIT_V(8); PG8_WAIT_L(0); PG8_BAR; PG8_MMA(0, 0, At, B0); PG8_MMA(0, 1, At, B1); PG8_BAR; PG8_SCHED;
            PG8_LDA(At, 0, 1); PG8_STAGE(PG8_SB(0, 0), b2, voffB); PG8_STAGE(PG8_SB(0, 1), b2 + hstep, voffB); PG8_STAGE(PG8_SA(0, 0), a2, voffA);
            PG8_WAIT_V(8); PG8_WAIT_L(0); PG8_BAR; PG8_MMA(1, 0, At, B0); PG8_MMA(1, 1, At, B1); PG8_BAR; PG8_SCHED;
            PG8_LDB(B0, 1, 0); PG8_LDB(B1, 1, 1); PG8_SCHED; PG8_LDA(At, 1, 0); PG8_STAGE(PG8_SA(0, 1), a2 + hstep, voffA);
            PG8_WAIT_V(8); PG8_WAIT_L(0); PG8_BAR; PG8_MMA(0, 0, At, B0); PG8_MMA(0, 1, At, B1); PG8_BAR; PG8_SCHED;
            PG8_LDA(At, 1, 1); PG8_STAGE(PG8_SB(1, 0), b3, voffB); PG8_STAGE(PG8_SB(1, 1), b3 + hstep, voffB); PG8_STAGE(PG8_SA(1, 0), a3, voffA);
            PG8_WAIT_V(8); PG8_WAIT_L(0); PG8_BAR; PG8_MMA(1, 0, At, B0); PG8_MMA(1, 1, At, B1); PG8_BAR; PG8_SCHED;
            } else {
            PG8_LDB(B0, 0, 0); PG8_SCHED; PG8_LDA(At, 0, 0); PG8_STAGE(PG8_SA(1, 1), a1 + hstep, voffA);
            PG8_WAIT_L(8); PG8_BAR; PG8_WAIT_L(0); PG8_MMA(0, 0, At, B0); PG8_BAR; PG8_SCHED;
            PG8_LDB(B1, 0, 1); PG8_STAGE(PG8_SB(0, 0), b2, voffB);
            PG8_BAR; PG8_WAIT_L(0); PG8_MMA(0, 1, At, B1); PG8_BAR;
            PG8_LDA(At, 0, 1); PG8_STAGE(PG8_SA(0, 0), a2, voffA);
            PG8_BAR; PG8_WAIT_L(0); PG8_MMA(1, 0, At, B0); PG8_BAR; PG8_SCHED;
            PG8_STAGE(PG8_SB(0, 1), b2 + hstep, voffB);
            PG8_WAIT_V(6); PG8_BAR; PG8_MMA(1, 1, At, B1); PG8_BAR;
            PG8_LDB(B0, 1, 0); PG8_SCHED; PG8_LDA(At, 1, 0); PG8_STAGE(PG8_SA(0, 1), a2 + hstep, voffA);
            PG8_WAIT_L(8); PG8_BAR; PG8_WAIT_L(0); PG8_MMA(0, 0, At, B0); PG8_BAR; PG8_SCHED;
            PG8_LDB(B1, 1, 1); PG8_STAGE(PG8_SB(1, 0), b3, voffB);
            PG8_BAR; PG8_WAIT_L(0); PG8_MMA(0, 1, At, B1); PG8_BAR;
            PG8_LDA(At, 1, 1); PG8_STAGE(PG8_SA(1, 0), a3, voffA);
            PG8_BAR; PG8_WAIT_L(0); PG8_MMA(1, 0, At, B0); PG8_BAR; PG8_SCHED;
            PG8_STAGE(PG8_SB(1, 1), b3 + hstep, voffB);
            PG8_WAIT_V(6); PG8_BAR; PG8_MMA(1, 1, At, B1); PG8_BAR;
            }
        }
        if constexpr (ALIGN_EPI) { if (wr == 0) PG8_BAR; }
        if constexpr (!Epi::AFTER_DRAIN) { E(acc, cur, wr, wc, fr, fq); S.done(cur); }
        if (!has_next) break;
#pragma unroll
        for (int a = 0; a < 2; ++a)
#pragma unroll
            for (int b = 0; b < 2; ++b)
#pragma unroll
                for (int m = 0; m < 4; ++m)
#pragma unroll
                    for (int n = 0; n < 2; ++n) acc[a][b][m][n] = (f32x4){0.f, 0.f, 0.f, 0.f};
        cur = nxt; cA = nA; cB = nB; ++ui;
        if constexpr (ALIGN_EPI) { if (wr == 1) PG8_BAR; }
    }
    PG8_WAIT_V(0);
    if constexpr (!ALIGN_EPI) { if (wr == 0) PG8_BAR; }
    PG8_BAR;
    if constexpr (Epi::AFTER_DRAIN) { E.fused(acc, cur, wr, wc, fr, fq, lds, wid, lane); S.done(cur); }
#undef PG8_SA
#undef PG8_SB
#undef PG8_STAGE
#undef PG8_LDA
#undef PG8_LDB
#undef PG8_MMA
#undef PG8_WAIT_V
#undef PG8_WAIT_L
#undef PG8_BAR
#undef PG8_SCHED
}
}

#define XB_TMO      128
#define XB_XCNT(j)  (256  + 64 * (j))
#define XB_XSUB(j)  (1280 + 64 * (j))
#define XB_XGEN(j)  (2304 + 64 * (j))
#define XB_TOP      3328
#define XB_TOPGEN   3392
#define XCD_BAR_WORDS 3456
#define XB_SPIN_CAP (1u << 18)

__device__ __forceinline__ unsigned xb_ld(unsigned* p)              { return __hip_atomic_load(p, __ATOMIC_RELAXED, __HIP_MEMORY_SCOPE_AGENT); }
__device__ __forceinline__ unsigned xb_add(unsigned* p, unsigned v) { return __hip_atomic_fetch_add(p, v, __ATOMIC_RELAXED, __HIP_MEMORY_SCOPE_AGENT); }
__device__ __forceinline__ unsigned xb_xcc_id() { return (unsigned)__builtin_amdgcn_s_getreg((3 << 11) | 20) & 0xFu; }
#define XB_SPIN(cond, bar) do { unsigned _sp = 0; while (cond) { __builtin_amdgcn_s_sleep(1); \
    if ((++_sp & 255u) == 0u) { if (xb_ld(&(bar)[XB_TMO])) break; if (_sp > XB_SPIN_CAP) { atomicAdd(&(bar)[XB_TMO], 1u); break; } } } } while (0)

struct XcdBarrier {
    unsigned* bar; unsigned x;
    volatile LAS unsigned* st;
};

__device__ __forceinline__ XcdBarrier xcd_barrier_post(unsigned* bar, volatile LAS unsigned* st) {
    XcdBarrier b; b.bar = bar; b.x = xb_xcc_id(); b.st = st;
    if (threadIdx.x == 0) (void)xb_add(&bar[XB_XCNT(b.x)], 1u);
    return b;
}
__device__ __forceinline__ void xcd_barrier_complete(unsigned* bar, unsigned x, unsigned& nloc, unsigned& nx) {
    const unsigned G = gridDim.x * gridDim.y * gridDim.z;
    unsigned sum, cnt, mine, sp = 0u;
    for (;;) {
        sum = 0u; cnt = 0u; mine = 0u;
#pragma unroll
        for (unsigned j = 0; j < 16; ++j) { const unsigned c = xb_ld(&bar[XB_XCNT(j)]); sum += c; cnt += (c > 0u) ? 1u : 0u; mine = (j == x) ? c : mine; }
        if (sum == G) break;
        __builtin_amdgcn_s_sleep(1);
        if ((++sp & 255u) == 0u) { if (xb_ld(&bar[XB_TMO])) break; if (sp > XB_SPIN_CAP) { atomicAdd(&bar[XB_TMO], 1u); break; } }
    }
    nloc = mine > 0u ? mine : 1u; nx = cnt > 0u ? cnt : 1u;
}

__device__ __forceinline__ void xcd_barrier(const XcdBarrier& b) {
    asm volatile("s_waitcnt vmcnt(0)" ::: "memory");
    __syncthreads();
    if (threadIdx.x == 0) {
        unsigned* bar = b.bar;
        __builtin_amdgcn_s_waitcnt(0);
        unsigned nloc = b.st[0], nx = b.st[1];
        if (nloc == 0u) { xcd_barrier_complete(bar, b.x, nloc, nx); b.st[0] = nloc; b.st[1] = nx; }
        const unsigned old = xb_add(&bar[XB_XSUB(b.x)], 1u);
        const unsigned gen = old / nloc;
        if (old + 1u == (gen + 1u) * nloc) {
            __builtin_amdgcn_fence(__ATOMIC_RELEASE, "agent");
            asm volatile("s_waitcnt vmcnt(0)" ::: "memory");
            const unsigned og = xb_add(&bar[XB_TOP], 1u);
            const unsigned tg = og / nx;
            if (og + 1u == (tg + 1u) * nx) xb_add(&bar[XB_TOPGEN], 1u);
            else XB_SPIN(xb_ld(&bar[XB_TOPGEN]) == tg, bar);
            __builtin_amdgcn_fence(__ATOMIC_ACQUIRE, "agent");
            xb_add(&bar[XB_XGEN(b.x)], 1u);
            asm volatile("s_waitcnt vmcnt(0)" ::: "memory");
        } else {
            XB_SPIN(xb_ld(&bar[XB_XGEN(b.x)]) == gen, bar);
            __builtin_amdgcn_fence(__ATOMIC_ACQUIRE, "agent");
            asm volatile("s_waitcnt vmcnt(0)" ::: "memory");
        }
    }
    __syncthreads();
}

struct Args { const float* in[N_IN]; float* out; unsigned char* ws; int ph_lo, ph_hi; };
struct Frame {
    LAS unsigned char* lds;
    int tid, lane, wave, bid, G;
    const float* in[N_IN];
    float* out; unsigned char* ws;
};
#define WSP(T, off) ((T*)(F.ws + (off)))
#define OUTB(T, off) ((T*)((unsigned char*)F.out + (off)))

__device__ __forceinline__ void transpose_item(const float* W, int K, int N, bf16* WT, int dst_row0, int k0, int n0, LAS float* scr, int lane) {
#pragma unroll 8
    for (int i = 0; i < 32; ++i) { const int kk = 2 * i + (lane >> 5), n = n0 + (lane & 31); scr[kk * 33 + (lane & 31)] = n < N ? W[(size_t)(k0 + kk) * N + n] : 0.f; }
    LDS_WAIT(); asm volatile("" ::: "memory");
    const int c = lane & 7;
#pragma unroll
    for (int j = 0; j < 4; ++j) { const int n = (lane >> 3) + 8 * j; const LAS float* s = scr + (8 * c) * 33 + n;
        u32x4 o; o.x = pk2(s[0 * 33], s[1 * 33]); o.y = pk2(s[2 * 33], s[3 * 33]); o.z = pk2(s[4 * 33], s[5 * 33]); o.w = pk2(s[6 * 33], s[7 * 33]);
        *(u32x4*)(WT + (size_t)(dst_row0 + n) * K + k0 + 8 * c) = o; }
    LDS_WAIT(); asm volatile("" ::: "memory");
}

__device__ __forceinline__ void p0_prologue(Frame& F) {
    const int gw = F.bid * NWAVES + F.wave, NGW = F.G * NWAVES;
    {
        LAS float* scr = (LAS float*)(F.lds + 49152 + F.wave * 8704);
        constexpr int NB = NPAD / 32, NITEMS = 16 * NB;
        for (int it = gw; it < NITEMS; it += NGW) { const int kb = it / NB, nb = it % NB; transpose_item(F.in[I_WIN], 1024, DPROJ, WSP(bf16, WS_WIN), 32 * nb, 64 * kb, 32 * nb, scr, F.lane); }
    }
    {
        LAS float* sc = (LAS float*)F.lds;
        LAS float* red = (LAS float*)(F.lds + 32768);
        for (int idx = F.tid; idx < 5 * 1024; idx += NTHR) { const int r = idx >> 10, k = idx & 1023; const float v = r == 0 ? F.in[I_CCTX][k] : F.in[I_C][(r - 1) * 1024 + k]; sc[idx] = siluf(v); }
        __syncthreads();
        const float* wada = F.in[I_WADA]; const float* bada = F.in[I_BADA]; float* mod = WSP(float, WS_MOD);
        for (int cg = F.bid; cg < 256; cg += F.G) {
            const int col = F.tid % 24, kq = F.tid / 24;
            if (F.tid < 504) {
                float a0 = 0.f, a1 = 0.f, a2 = 0.f, a3 = 0.f, a4 = 0.f;
                const float* wp = wada + 24 * cg + col;
                for (int k = kq; k < 1024; k += 21) { const float w = wp[(size_t)k * 6144]; a0 += sc[k] * w; a1 += sc[1024 + k] * w; a2 += sc[2048 + k] * w; a3 += sc[3072 + k] * w; a4 += sc[4096 + k] * w; }
                LAS float* rp = red + (kq * 24 + col) * 5; rp[0] = a0; rp[1] = a1; rp[2] = a2; rp[3] = a3; rp[4] = a4;
            }
            __syncthreads();
            if (F.tid < 120) { const int c2 = F.tid % 24, r = F.tid / 24; float s = 0.f; for (int q = 0; q < 21; ++q) s += red[(q * 24 + c2) * 5 + r]; mod[r * 6144 + 24 * cg + c2] = s + bada[24 * cg + c2]; }
            __syncthreads();
        }
    }
}

__device__ __forceinline__ void modnorm_rows(Frame& F, const float* x0, const float* x1, const float* nw, int sh_off, int sc_off, bf16* H) {
    const int gw = F.bid * NWAVES + F.wave, NGW = F.G * NWAVES;
    const float* mod = WSP(float, WS_MOD);
    for (int m = gw; m < NT; m += NGW) {
        const float* xr = m < NCTX ? x0 + (size_t)m * DM : x1 + (size_t)(m - NCTX) * DM;
        const int mr = m < NCTX ? 0 : 1 + ((m - NCTX) >> 12);
        const float* mp = mod + (size_t)mr * 6144;
        f32x4 v[4]; float s = 0.f;
#pragma unroll
        for (int j = 0; j < 4; ++j) { v[j] = *(const f32x4*)(xr + 4 * F.lane + 256 * j); s += (v[j].x * v[j].x + v[j].y * v[j].y) + (v[j].z * v[j].z + v[j].w * v[j].w); }
        const float rstd = 1.f / sqrtf(wave_sum(s) * (1.f / DM) + EPS);
#pragma unroll
        for (int j = 0; j < 4; ++j) {
            const int c = 4 * F.lane + 256 * j;
            const f32x4 w = *(const f32x4*)(nw + c), sc = *(const f32x4*)(mp + sc_off + c), sh = *(const f32x4*)(mp + sh_off + c);
            const f32x4 h = (v[j] * rstd * w) * (sc + 1.f) + sh;
            u32x2 o; o.x = pk2(h.x, h.y); o.y = pk2(h.z, h.w);
            *(u32x2*)(H + (size_t)m * DM + c) = o;
        }
    }
}

__device__ __forceinline__ void final_norm(Frame& F) {
    const int gw = F.bid * NWAVES + F.wave, NGW = F.G * NWAVES;
    const float* nf = F.in[I_NF];
    for (int m = gw; m < NT; m += NGW) {
        float* xr = F.out + (size_t)m * DM;
        f32x4 v[4]; float s = 0.f;
#pragma unroll
        for (int j = 0; j < 4; ++j) { v[j] = *(const f32x4*)(xr + 4 * F.lane + 256 * j); s += (v[j].x * v[j].x + v[j].y * v[j].y) + (v[j].z * v[j].z + v[j].w * v[j].w); }
        const float rstd = 1.f / sqrtf(wave_sum(s) * (1.f / DM) + EPS);
#pragma unroll
        for (int j = 0; j < 4; ++j) { const int c = 4 * F.lane + 256 * j; const f32x4 w = *(const f32x4*)(nf + c); *(f32x4*)(xr + c) = v[j] * rstd * w; }
    }
}

__device__ __forceinline__ void p5_headnorm(Frame& F) {
    const int gw = F.bid * NWAVES + F.wave, NGW = F.G * NWAVES;
    {
        LAS float* scr = (LAS float*)(F.lds + F.wave * 8704);
        constexpr int I_O = 16 * 32, I_G = 16 * 88, I_D = 44 * 32, NITEMS = I_O + 2 * I_G + I_D;
        for (int it = gw; it < NITEMS; it += NGW) {
            int r = it;
            if (r < I_O) { const int kb = r / 32, nb = r % 32; transpose_item(F.in[I_WOUT], 1024, 1024, WSP(bf16, WS_WOUT), 32 * nb, 64 * kb, 32 * nb, scr, F.lane); continue; } r -= I_O;
            if (r < I_G) { const int kb = r / 88, nb = r % 88, n0 = 32 * nb; transpose_item(F.in[I_WGATE], 1024, DFF, WSP(bf16, WS_WGU), 256 * (n0 >> 7) + (n0 & 127), 64 * kb, n0, scr, F.lane); continue; } r -= I_G;
            if (r < I_G) { const int kb = r / 88, nb = r % 88, n0 = 32 * nb; transpose_item(F.in[I_WUP], 1024, DFF, WSP(bf16, WS_WGU), 256 * (n0 >> 7) + 128 + (n0 & 127), 64 * kb, n0, scr, F.lane); continue; } r -= I_G;
            { const int kb = r / 32, nb = r % 32; transpose_item(F.in[I_WDOWN], DFF, 1024, WSP(bf16, WS_WDN), 32 * nb, 64 * kb, 32 * nb, scr, F.lane); }
        }
    }
    const bf16* OA0 = OUTB(bf16, OUT_OA); const bf16* OA1 = OUTB(bf16, OUT_OA + 20 * MiB);
    const bf16* OB0 = WSP(bf16, WS_OB);   const bf16* OB1 = WSP(bf16, WS_OB + 20 * MiB);
    const bf16* AG = WSP(bf16, WS_AG);    const bf16* BZ = WSP(bf16, WS_BZ);
    bf16* Y = WSP(bf16, WS_YIN);
    for (int m = gw; m < NT; m += NGW) {
        const int half = F.lane >> 5, c = 16 * (F.lane & 31);
        const bf16* o0 = (half ? OB0 : OA0) + (size_t)m * 512 + c; const bf16* o1 = (half ? OB1 : OA1) + (size_t)m * 512 + c;
        const bf16* gt = (half ? BZ : AG) + (size_t)m * 512 + c;
        const float* nw = (half ? F.in[I_GNORM] : F.in[I_HNORM]) + c;
        float o[16]; float ss = 0.f;
#pragma unroll
        for (int q = 0; q < 2; ++q) {
            const u32x4 a = *(const u32x4*)(o0 + 8 * q), b = *(const u32x4*)(o1 + 8 * q);
#pragma unroll
            for (int e = 0; e < 4; ++e) { o[8 * q + 2 * e] = bflo(a[e]) + bflo(b[e]); o[8 * q + 2 * e + 1] = bfhi(a[e]) + bfhi(b[e]); }
        }
#pragma unroll
        for (int e = 0; e < 16; ++e) ss += o[e] * o[e];
        ss += __shfl_xor(ss, 1); ss += __shfl_xor(ss, 2); ss += __shfl_xor(ss, 4);
        const float rstd = 1.f / sqrtf(ss * (1.f / 128.f) + EPS);
#pragma unroll
        for (int q = 0; q < 2; ++q) {
            const u32x4 g = *(const u32x4*)(gt + 8 * q);
            const f32x4 w0 = *(const f32x4*)(nw + 8 * q), w1 = *(const f32x4*)(nw + 8 * q + 4);
            float y[8];
#pragma unroll
            for (int e = 0; e < 4; ++e) { y[2 * e] = o[8 * q + 2 * e] * rstd * (e < 2 ? w0[2 * e] : w1[2 * e - 4]) * bflo(g[e]); y[2 * e + 1] = o[8 * q + 2 * e + 1] * rstd * (e < 2 ? w0[2 * e + 1] : w1[2 * e - 3]) * bfhi(g[e]); }
            u32x4 w; w.x = pk2(y[0], y[1]); w.y = pk2(y[2], y[3]); w.z = pk2(y[4], y[5]); w.w = pk2(y[6], y[7]);
            *(u32x4*)(Y + (size_t)m * DM + half * 512 + c + 8 * q) = w;
        }
    }
}

__device__ __forceinline__ int uc_index(int s, int n, int h, int dir) { return ((chunk_base(s) + n) * 4 + h) * 2 + dir; }
__device__ __forceinline__ unsigned char* grec_ptr(Frame& F, int uc) { return uc < N1G ? F.ws + WS_I + (size_t)uc * GREC : (unsigned char*)F.out + OUT_GOVF + (size_t)(uc - N1G) * GREC; }
__device__ __forceinline__ unsigned char* hrec_ptr(Frame& F, int uc) { return F.ws + WS_I + (size_t)uc * HREC; }
__device__ __forceinline__ bool allowed(int dir, int t, int s) { return dir ? (s >= t) : (s <= t); }

__device__ __forceinline__ void write_qd_image(Frame& F, const LAS bf16* X, int pitch, const LAS float* rowscale, unsigned char* dst) {
    const int r = F.lane & 15, g = F.lane >> 4, mt = F.wave >> 1;
#pragma unroll
    for (int q = 0; q < 2; ++q) {
        const int ks = 2 * (F.wave & 1) + q, row = 16 * mt + r;
        const u32x2 a = *(const LAS u32x2*)(X + row * pitch + 32 * ks + 4 * g), b = *(const LAS u32x2*)(X + row * pitch + 32 * ks + 16 + 4 * g);
        u32x4 o;
        if (rowscale) { const float sc = rowscale[row];
            o.x = pk2(bflo(a.x) * sc, bfhi(a.x) * sc); o.y = pk2(bflo(a.y) * sc, bfhi(a.y) * sc); o.z = pk2(bflo(b.x) * sc, bfhi(b.x) * sc); o.w = pk2(bflo(b.y) * sc, bfhi(b.y) * sc);
        } else { o.x = a.x; o.y = a.y; o.z = b.x; o.w = b.y; }
        *(u32x4*)(dst + ((mt * 4 + ks) * 64 + F.lane) * 16) = o;
    }
}
__device__ __forceinline__ void write_at_image(Frame& F, const LAS bf16* KA, const LAS bf16* QB, int pitch, const LAS float* Cs, int dir, unsigned char* dst) {
    const int r = F.lane & 15, g = F.lane >> 4, mt = F.wave >> 1, ks2 = F.wave & 1;
    f32x4 a0 = {0.f, 0.f, 0.f, 0.f}, a1 = {0.f, 0.f, 0.f, 0.f};
#pragma unroll
    for (int kd = 0; kd < 4; ++kd) {
        const bf16x8 bq = as_frag(*(const LAS u32x4*)(QB + (16 * mt + r) * pitch + 32 * kd + 8 * g));
        const bf16x8 k0 = as_frag(*(const LAS u32x4*)(KA + (32 * ks2 + r) * pitch + 32 * kd + 8 * g));
        const bf16x8 k1 = as_frag(*(const LAS u32x4*)(KA + (32 * ks2 + 16 + r) * pitch + 32 * kd + 8 * g));
        a0 = mfma16(k0, bq, a0); a1 = mfma16(k1, bq, a1);
    }
    const int t = 16 * mt + r; const float ct = Cs ? Cs[t] : 0.f;
    float v[8];
#pragma unroll
    for (int j = 0; j < 8; ++j) {
        const int s = 32 * ks2 + kperm(g, j); const bool ok = allowed(dir, t, s);
        float x = (j < 4) ? a0[j & 3] : a1[j & 3];
        if (Cs) { const float e = __expf(ok ? ct - Cs[s] : 0.f); x *= e; }
        v[j] = ok ? x : 0.f;
    }
    u32x4 o; o.x = pk2(v[0], v[1]); o.y = pk2(v[2], v[3]); o.z = pk2(v[4], v[5]); o.w = pk2(v[6], v[7]);
    *(u32x4*)(dst + ((mt * 2 + ks2) * 64 + F.lane) * 16) = o;
}

__device__ __forceinline__ void p3_hgrn(Frame& F) {
    constexpr int PITCH = 136;
    LAS bf16* QDb = (LAS bf16*)(F.lds);
    LAS bf16* KDb = (LAS bf16*)(F.lds + 17408);
    LAS unsigned char* KTi = F.lds + 34816;
    LAS float* part = (LAS float*)(F.lds + 51200);
    LAS float* etot = (LAS float*)(F.lds + 55296);
    const bf16* QA = OUTB(bf16, OUT_QA); const bf16* VA = OUTB(bf16, OUT_VA);
    for (int task = F.bid; task < NUC; task += F.G) {
        const int dir = task & 1, h = (task >> 1) & 3, cidx = task >> 3;
        int s, n; if (cidx < 64) { s = cidx >> 2; n = cidx & 3; } else { s = 16 + ((cidx - 64) >> 6); n = (cidx - 64) & 63; }
        const bf16* Gd = OUTB(bf16, dir ? OUT_GB : OUT_GF);
        unsigned char* rec = hrec_ptr(F, task);
        const int cp = F.tid & 63, re = F.tid >> 6, c0 = 2 * cp;
        float f0[8], f1[8], q0[8], q1[8], p0[8], p1[8];
#pragma unroll
        for (int e = 0; e < 8; ++e) {
            const size_t off = (size_t)tok_a(s, n, 8 * re + e) * 512 + h * 128 + c0;
            const unsigned gw = *(const unsigned*)(Gd + off), qw = *(const unsigned*)(QA + off);
            f0[e] = __expf(bflo(gw)); f1[e] = __expf(bfhi(gw)); q0[e] = bflo(qw); q1[e] = bfhi(qw);
        }
        if (dir == 0) { float a = 1.f, b = 1.f;
#pragma unroll
            for (int e = 0; e < 8; ++e) { a *= f0[e]; b *= f1[e]; p0[e] = a; p1[e] = b; }
            part[re * 128 + c0] = a; part[re * 128 + c0 + 1] = b;
        } else { float a = 1.f, b = 1.f;
#pragma unroll
            for (int e = 7; e >= 0; --e) { a *= f0[e]; b *= f1[e]; p0[e] = a; p1[e] = b; }
            part[re * 128 + c0] = a; part[re * 128 + c0 + 1] = b;
        }
        __syncthreads();
        float o0 = 1.f, o1 = 1.f, t0 = 1.f, t1 = 1.f;
#pragma unroll
        for (int r2 = 0; r2 < 8; ++r2) { const float a = part[r2 * 128 + c0], b = part[r2 * 128 + c0 + 1]; t0 *= a; t1 *= b; const bool pre = dir ? (r2 > re) : (r2 < re); if (pre) { o0 *= a; o1 *= b; } }
        if (re == 0) { etot[c0] = t0; etot[c0 + 1] = t1; }
        float kt0[8], kt1[8];
#pragma unroll
        for (int e = 0; e < 8; ++e) {
            const float E0 = o0 * p0[e], E1 = o1 * p1[e];
            const float k0 = 1.f - f0[e], k1 = 1.f - f1[e];
            const float kd0 = k0 / E0, kd1 = k1 / E1;
            const int row = 8 * re + e;
            *(LAS unsigned*)(QDb + row * PITCH + c0) = pk2(q0[e] * E0, q1[e] * E1);
            *(LAS unsigned*)(KDb + row * PITCH + c0) = pk2(kd0, kd1);
            kt0[e] = kd0 * t0; kt1[e] = kd1 * t1;
        }
        {
            const int ks = re >> 2, hf = (re >> 1) & 1;
#pragma unroll
            for (int cc = 0; cc < 2; ++cc) {
                const int c = c0 + cc, kt = c >> 4, r = c & 15; const float* kv = cc ? kt1 : kt0;
#pragma unroll
                for (int p = 0; p < 2; ++p) {
                    const int g = 2 * (re & 1) + p;
                    u32x2 w; w.x = pk2(kv[4 * p], kv[4 * p + 1]); w.y = pk2(kv[4 * p + 2], kv[4 * p + 3]);
                    *(LAS u32x2*)(KTi + ((kt * 2 + ks) * 64 + g * 16 + r) * 16 + 8 * hf) = w;
                }
            }
        }
        __syncthreads();
        write_qd_image(F, QDb, PITCH, nullptr, rec);
        write_at_image(F, KDb, QDb, PITCH, nullptr, dir, rec + 16384);
        for (int i = F.tid; i < 1024; i += NTHR) *(u32x4*)(rec + 24576 + i * 16) = *(const LAS u32x4*)(KTi + i * 16);
        if (F.tid < 32) *(f32x4*)(rec + 40960 + F.tid * 16) = *(const LAS f32x4*)((LAS unsigned char*)etot + F.tid * 16);
        if (dir == 0) {
            unsigned char* vb = F.ws + WS_HVB + (size_t)(task >> 1) * 16384;
            const int c = F.lane & 15, g = F.lane >> 4, w = F.wave;
#pragma unroll
            for (int ks2 = 0; ks2 < 2; ++ks2) {
                unsigned short x[8];
#pragma unroll
                for (int j = 0; j < 8; ++j) x[j] = VA[(size_t)tok_a(s, n, 32 * ks2 + kperm(g, j)) * 512 + h * 128 + 16 * w + c];
                u32x4 o; o.x = x[0] | ((unsigned)x[1] << 16); o.y = x[2] | ((unsigned)x[3] << 16); o.z = x[4] | ((unsigned)x[5] << 16); o.w = x[6] | ((unsigned)x[7] << 16);
                *(u32x4*)(vb + ((w * 2 + ks2) * 64 + F.lane) * 16) = o;
            }
        }
        __syncthreads();
    }
}

__device__ __forceinline__ int lp_rowoff(int a) { if (a == 0) return 0; const int A = a - 1, m = A >> 2, r = A & 3; return 8 * m * (m + 1) + 4 * r * (m + 1); }

__device__ __forceinline__ int idx_tp(int t, int sx, int tp) { return t * tp + sx; }
__device__ __forceinline__ void p3_gdn(Frame& F) {
    constexpr int PITCH = 136, TP = 72;
    LAS float* Lp = (LAS float*)(F.lds);
    LAS bf16* Tp = (LAS bf16*)(F.lds + 8448);
    LAS bf16* Tm = (LAS bf16*)(F.lds + 17664);
    LAS float* Cs = (LAS float*)(F.lds + 26880);
    LAS bf16* Qb = (LAS bf16*)(F.lds + 28672);
    LAS bf16* Kb = (LAS bf16*)(F.lds + 46080);
    LAS bf16* VT = (LAS bf16*)(F.lds + 63488);
    LAS bf16* KGT = (LAS bf16*)(F.lds + 81920);
    LAS float* Bs = Cs + 64;
    LAS float* Es = Cs + 128;
    LAS float* Ets = Cs + 192;
    LAS float* Sc = Cs + 256;
    const bf16* BQ = WSP(bf16, WS_BQ); const bf16* BK = WSP(bf16, WS_BK); const bf16* BV = WSP(bf16, WS_BV);
    const float* BETA = WSP(float, WS_BETA); const float* GGp = WSP(float, WS_GG);
    const float* convw = F.in[I_CONV];
    for (int task = F.bid; task < NUC; task += F.G) {
        const int dir = task & 1, h = (task >> 1) & 3, cidx = task >> 3;
        int s, n; if (cidx < 64) { s = cidx >> 2; n = cidx & 3; } else { s = 16 + ((cidx - 64) >> 6); n = (cidx - 64) & 63; }
        unsigned char* rec = grec_ptr(F, task);
        if (F.wave == 0) {
            const int m = tok_b(s, n, F.lane);
            const float beta = BETA[(size_t)m * 8 + dir * 4 + h], gg = GGp[(size_t)m * 8 + dir * 4 + h];
            float c = gg;
#pragma unroll
            for (int d = 1; d < 64; d <<= 1) { const float o = dir ? __shfl_down(c, d) : __shfl_up(c, d); const bool ok = dir ? (F.lane + d < 64) : (F.lane >= d); c += ok ? o : 0.f; }
            const float ctot = __shfl(c, dir ? 0 : 63);
            Cs[F.lane] = c; Bs[F.lane] = beta; Es[F.lane] = __expf(c); Ets[F.lane] = __expf(ctot - c);
            if (F.lane == 0) Sc[0] = __expf(ctot);
        }
        __syncthreads();
        {
            const int i = F.tid >> 3, seg = F.tid & 7, ch0 = 16 * seg;
            const int m = tok_b(s, n, i);
            int pos, len, dlt; if (s < 16) { pos = 64 * n + i; len = 256; dlt = 1; } else { pos = i; len = 64; dlt = 64; }
            const bool hasp = pos > 0, hasn = pos + 1 < len;
            const float beta = Bs[i], kg = -beta * Es[i];
#pragma unroll
            for (int a = 0; a < 3; ++a) {
                float val[16];
                const bf16* src = (a == 0 ? BQ : (a == 1 ? BK : BV)) + (size_t)m * 512 + h * 128 + ch0;
                const float* wc = convw + a * 512 + h * 128 + ch0;
#pragma unroll
                for (int q = 0; q < 2; ++q) {
                    const u32x4 zz = {0u, 0u, 0u, 0u};
                    const u32x4 xm = hasp ? *(const u32x4*)(src - (ptrdiff_t)dlt * 512 + 8 * q) : zz;
                    const u32x4 x0 = *(const u32x4*)(src + 8 * q);
                    const u32x4 xp = hasn ? *(const u32x4*)(src + (ptrdiff_t)dlt * 512 + 8 * q) : zz;
                    f32x4 w0[2], w1[2], w2[2];
#pragma unroll
                    for (int hh = 0; hh < 2; ++hh) { w0[hh] = *(const f32x4*)(wc + 8 * q + 4 * hh); w1[hh] = *(const f32x4*)(wc + 1536 + 8 * q + 4 * hh); w2[hh] = *(const f32x4*)(wc + 3072 + 8 * q + 4 * hh); }
#pragma unroll
                    for (int e = 0; e < 4; ++e) {
                        const int ch = 8 * q + 2 * e, hh = e >> 1, ee = 2 * (e & 1);
                        const float y0 = bflo(xm[e]) * w0[hh][ee] + bflo(x0[e]) * w1[hh][ee] + bflo(xp[e]) * w2[hh][ee];
                        const float y1 = bfhi(xm[e]) * w0[hh][ee + 1] + bfhi(x0[e]) * w1[hh][ee + 1] + bfhi(xp[e]) * w2[hh][ee + 1];
                        val[ch] = siluf(y0); val[ch + 1] = siluf(y1);
                    }
                }
                if (a < 2) {
                    float ss = 0.f;
#pragma unroll
                    for (int e = 0; e < 16; ++e) ss += val[e] * val[e];
                    ss += __shfl_xor(ss, 1); ss += __shfl_xor(ss, 2); ss += __shfl_xor(ss, 4);
                    const float rn = (1.f / sqrtf(ss + EPS)) * (a == 0 ? 0.08838834764831845f : 1.f);
                    unsigned pw[8];
#pragma unroll
                    for (int e = 0; e < 8; ++e) pw[e] = pk2(val[2 * e] * rn, val[2 * e + 1] * rn);
                    LAS bf16* dstp = (a == 0 ? Qb : Kb) + i * PITCH + ch0;
                    *(LAS u32x4*)(dstp) = (u32x4){pw[0], pw[1], pw[2], pw[3]}; *(LAS u32x4*)(dstp + 8) = (u32x4){pw[4], pw[5], pw[6], pw[7]};
                    if (a == 1) { LAS bf16* kp = KGT + ch0 * TP + i;
#pragma unroll
                        for (int e = 0; e < 16; ++e) kp[e * TP] = (bf16)f2bf(kg * val[e] * rn); }
                } else { LAS bf16* vp = VT + ch0 * TP + i;
#pragma unroll
                    for (int e = 0; e < 16; ++e) vp[e * TP] = (bf16)f2bf(beta * val[e]); }
                asm volatile("" ::: "memory");
            }
        }
        __syncthreads();
        {
            const int r = F.lane & 15, g = F.lane >> 4, tt = F.wave >> 1, sp = F.wave & 1;
            f32x4 a0 = {0.f, 0.f, 0.f, 0.f}, a1 = {0.f, 0.f, 0.f, 0.f};
#pragma unroll
            for (int kd = 0; kd < 4; ++kd) {
                const bf16x8 at = as_frag(*(const LAS u32x4*)(Kb + (16 * tt + r) * PITCH + 32 * kd + 8 * g));
                const bf16x8 b0 = as_frag(*(const LAS u32x4*)(Kb + (32 * sp + r) * PITCH + 32 * kd + 8 * g));
                const bf16x8 b1 = as_frag(*(const LAS u32x4*)(Kb + (32 * sp + 16 + r) * PITCH + 32 * kd + 8 * g));
                a0 = mfma16(at, b0, a0); a1 = mfma16(at, b1, a1);
            }
#pragma unroll
            for (int q = 0; q < 2; ++q)
#pragma unroll
                for (int i = 0; i < 4; ++i) {
                    const int t = 16 * tt + 4 * g + i, sx = 32 * sp + 16 * q + r;
                    const bool ok = dir ? (sx > t) : (sx < t);
                    if (ok) {
                        const float v = Bs[t] * (q ? a1[i] : a0[i]) * __expf(Cs[t] - Cs[sx]);
                        const int a = dir ? 63 - t : t, b = dir ? 63 - sx : sx;
                        Lp[lp_rowoff(a) + b] = v;
                    }
                }
        }
        write_at_image(F, Kb, Qb, PITCH, Cs, dir, rec + L_AT);
        write_qd_image(F, Qb, PITCH, Es, rec + L_QD);
        {
            const int r = F.lane & 15, g = F.lane >> 4, kt = F.wave;
#pragma unroll
            for (int ks2 = 0; ks2 < 2; ++ks2) {
                float v[8];
#pragma unroll
                for (int j = 0; j < 8; ++j) { const int sx = 32 * ks2 + kperm(g, j); v[j] = bf2f(Kb[sx * PITCH + 16 * kt + r]) * Ets[sx]; }
                u32x4 o; o.x = pk2(v[0], v[1]); o.y = pk2(v[2], v[3]); o.z = pk2(v[4], v[5]); o.w = pk2(v[6], v[7]);
                *(u32x4*)(rec + L_KT + ((kt * 2 + ks2) * 64 + F.lane) * 16) = o;
            }
        }
        if (F.tid == 0) *(float*)(rec + L_SC) = Sc[0];
        __syncthreads();
#ifndef NO_STAGE_D
        if (F.wave == 0) {
            float T[64];
            const int j = F.lane;
#pragma unroll
            for (int t = 0; t < 64; ++t) {
                float acc = 0.f;
                const LAS float* lrow = Lp + lp_rowoff(t);
#pragma unroll
                for (int s4 = 0; s4 < (t + 3) / 4; ++s4) {
                    const f32x4 l = *(const LAS f32x4*)(lrow + 4 * s4);
#pragma unroll
                    for (int e = 0; e < 4; ++e) if (4 * s4 + e < t) acc += l[e] * T[4 * s4 + e];
                }
                int jj = j; asm volatile("" : "+v"(jj));
                T[t] = (t == jj ? 1.f : 0.f) - acc;
                asm volatile("" ::: "memory");
            }
            LAS bf16* tp = Tp + j;
#pragma unroll
            for (int t = 0; t < 64; ++t) tp[t * TP] = (bf16)f2bf(T[t]);
        }
#endif
        __syncthreads();
        for (int idx = F.tid; idx < 4096; idx += NTHR) { const int t = idx >> 6, sx = idx & 63; Tm[t * TP + sx] = dir ? Tp[(63 - t) * TP + (63 - sx)] : Tp[idx_tp(t, sx, TP)]; }
        __syncthreads();
        {
            const int r = F.lane & 15, g = F.lane >> 4;
            {
                const int w = F.wave;
                bf16x8 bv[2];
#pragma unroll
                for (int ks2 = 0; ks2 < 2; ++ks2) bv[ks2] = as_frag(*(const LAS u32x4*)(VT + (16 * w + r) * TP + 32 * ks2 + 8 * g));
#pragma unroll
                for (int mt = 0; mt < 4; ++mt) {
                    f32x4 a = {0.f, 0.f, 0.f, 0.f};
#pragma unroll
                    for (int ks2 = 0; ks2 < 2; ++ks2) a = mfma16(as_frag(*(const LAS u32x4*)(Tm + (16 * mt + r) * TP + 32 * ks2 + 8 * g)), bv[ks2], a);
                    u32x2 o; o.x = pk2(a[0], a[1]); o.y = pk2(a[2], a[3]);
                    *(u32x2*)(rec + L_U + ((w * 4 + mt) * 64 + F.lane) * 8) = o;
                }
            }
            {
                const int mt = F.wave >> 1;
                bf16x8 bt[2];
#pragma unroll
                for (int ks2 = 0; ks2 < 2; ++ks2) bt[ks2] = as_frag(*(const LAS u32x4*)(Tm + (16 * mt + r) * TP + 32 * ks2 + 8 * g));
#pragma unroll
                for (int q = 0; q < 2; ++q) {
                    const int ks = 2 * (F.wave & 1) + q;
                    f32x4 a0 = {0.f, 0.f, 0.f, 0.f}, a1 = {0.f, 0.f, 0.f, 0.f};
#pragma unroll
                    for (int ks2 = 0; ks2 < 2; ++ks2) {
                        a0 = mfma16(as_frag(*(const LAS u32x4*)(KGT + (32 * ks + r) * TP + 32 * ks2 + 8 * g)), bt[ks2], a0);
                        a1 = mfma16(as_frag(*(const LAS u32x4*)(KGT + (32 * ks + 16 + r) * TP + 32 * ks2 + 8 * g)), bt[ks2], a1);
                    }
                    u32x4 o; o.x = pk2(a0[0], a0[1]); o.y = pk2(a0[2], a0[3]); o.z = pk2(a1[0], a1[1]); o.w = pk2(a1[2], a1[3]);
                    *(u32x4*)(rec + L_WN + ((mt * 4 + ks) * 64 + F.lane) * 16) = o;
                }
            }
        }
        __syncthreads();
    }
}

template <bool GDN>
__device__ __forceinline__ void p4_chain(Frame& F) {
    LAS unsigned char* img = F.lds;
    const int c = F.lane & 15, g = F.lane >> 4, w = F.wave;
    const float* st_in = F.in[GDN ? I_SG : I_SH];
    float* st_out = F.out + OUT_Y_FLOATS + (GDN ? STATE_FLOATS : 0);
    bf16* Obase = GDN ? WSP(bf16, WS_OB) : OUTB(bf16, OUT_OA);
    constexpr int N16 = GDN ? GREC / 16 : HREC / 16;
    constexpr int NST = (N16 + NTHR - 1) / NTHR;
    for (int uidx = F.bid; uidx < 160; uidx += F.G) {
        int s, h, dir;
        if (uidx < 32) { s = 16 + (uidx >> 3); h = (uidx >> 1) & 3; dir = uidx & 1; } else { const int j = uidx - 32; s = j >> 3; h = (j >> 1) & 3; dir = j & 1; }
        const int N = seq_nchunk(s), bq = s < 16 ? s : s - 16;
        f32x4 S[8];
        if (s >= 16) {
            const float* sp = st_in + (size_t)((bq * 2 + dir) * 4 + h) * 16384 + 16 * w + c;
#pragma unroll
            for (int kt = 0; kt < 8; ++kt)
#pragma unroll
                for (int i = 0; i < 4; ++i) S[kt][i] = sp[(16 * kt + 4 * g + i) * 128];
        } else {
#pragma unroll
            for (int kt = 0; kt < 8; ++kt) S[kt] = (f32x4){0.f, 0.f, 0.f, 0.f};
        }
        u32x4 stg[NST]; u32x4 stv[2];
#define P4_ISSUE(STEP) do { \
            const int n_ = dir ? N - 1 - (STEP) : (STEP); const int uc_ = uc_index(s, n_, h, dir); \
            const unsigned char* rec_ = GDN ? grec_ptr(F, uc_) : hrec_ptr(F, uc_); \
            _Pragma("unroll") for (int q = 0; q < NST; ++q) { const int idx = F.tid + q * NTHR; if (idx < N16) stg[q] = *(const u32x4*)(rec_ + (size_t)idx * 16); } \
            if (!GDN) { const unsigned char* vb_ = F.ws + WS_HVB + (size_t)(uc_ >> 1) * 16384; \
                _Pragma("unroll") for (int q = 0; q < 2; ++q) stv[q] = *(const u32x4*)(vb_ + (size_t)(F.tid + q * NTHR) * 16); } \
        } while (0)
        P4_ISSUE(0);
        for (int step = 0; step < N; ++step) {
#pragma unroll
            for (int q = 0; q < NST; ++q) { const int idx = F.tid + q * NTHR; if (idx < N16) *(LAS u32x4*)(img + (GDN ? 0 : L_QD) + idx * 16) = stg[q]; }
            if (!GDN) {
#pragma unroll
                for (int q = 0; q < 2; ++q) *(LAS u32x4*)(img + L_WN + (F.tid + q * NTHR) * 16) = stv[q];
            }
            __syncthreads();
            if (step + 1 < N) P4_ISSUE(step + 1);
            const int n = dir ? N - 1 - step : step;
            bf16x8 Sb[4];
#pragma unroll
            for (int ks = 0; ks < 4; ++ks) { u32x4 o; o.x = pk2(S[2 * ks][0], S[2 * ks][1]); o.y = pk2(S[2 * ks][2], S[2 * ks][3]); o.z = pk2(S[2 * ks + 1][0], S[2 * ks + 1][1]); o.w = pk2(S[2 * ks + 1][2], S[2 * ks + 1][3]); Sb[ks] = as_frag(o); }
            bf16x8 Xb[2];
            if (GDN) {
                f32x4 X[4];
#pragma unroll
                for (int mt = 0; mt < 4; ++mt) {
                    const u32x2 uu = *(const LAS u32x2*)(img + L_U + ((w * 4 + mt) * 64 + F.lane) * 8);
                    f32x4 a = {bflo(uu.x), bfhi(uu.x), bflo(uu.y), bfhi(uu.y)};
#pragma unroll
                    for (int ks = 0; ks < 4; ++ks) a = mfma16(as_frag(*(const LAS u32x4*)(img + L_WN + ((mt * 4 + ks) * 64 + F.lane) * 16)), Sb[ks], a);
                    X[mt] = a;
                }
#pragma unroll
                for (int k2 = 0; k2 < 2; ++k2) { u32x4 o; o.x = pk2(X[2 * k2][0], X[2 * k2][1]); o.y = pk2(X[2 * k2][2], X[2 * k2][3]); o.z = pk2(X[2 * k2 + 1][0], X[2 * k2 + 1][1]); o.w = pk2(X[2 * k2 + 1][2], X[2 * k2 + 1][3]); Xb[k2] = as_frag(o); }
            } else {
#pragma unroll
                for (int k2 = 0; k2 < 2; ++k2) Xb[k2] = as_frag(*(const LAS u32x4*)(img + L_WN + ((w * 2 + k2) * 64 + F.lane) * 16));
            }
#pragma unroll
            for (int mt = 0; mt < 4; ++mt) {
                f32x4 a = {0.f, 0.f, 0.f, 0.f};
#pragma unroll
                for (int ks = 0; ks < 4; ++ks) a = mfma16(as_frag(*(const LAS u32x4*)(img + L_QD + ((mt * 4 + ks) * 64 + F.lane) * 16)), Sb[ks], a);
#pragma unroll
                for (int k2 = 0; k2 < 2; ++k2) a = mfma16(as_frag(*(const LAS u32x4*)(img + L_AT + ((mt * 2 + k2) * 64 + F.lane) * 16)), Xb[k2], a);
#pragma unroll
                for (int i = 0; i < 4; ++i) {
                    const int li = 16 * mt + 4 * g + i;
                    const int m = GDN ? tok_b(s, n, li) : tok_a(s, n, li);
                    Obase[(size_t)dir * (10 * MiB) + (size_t)m * 512 + h * 128 + 16 * w + c] = (bf16)f2bf(a[i]);
                }
            }
#pragma unroll
            for (int kt = 0; kt < 8; ++kt) {
                f32x4 d;
                if (GDN) { const float ds = *(const LAS float*)(img + L_SC); d = (f32x4){ds, ds, ds, ds}; }
                else d = *(const LAS f32x4*)(img + L_U + (16 * kt + 4 * g) * 4);
                f32x4 a = S[kt] * d;
#pragma unroll
                for (int k2 = 0; k2 < 2; ++k2) a = mfma16(as_frag(*(const LAS u32x4*)(img + L_KT + ((kt * 2 + k2) * 64 + F.lane) * 16)), Xb[k2], a);
                S[kt] = a;
            }
            __syncthreads();
        }
        if (s < 16) {
            float* sp = st_out + (size_t)((bq * 2 + dir) * 4 + h) * 16384 + 16 * w + c;
#pragma unroll
            for (int kt = 0; kt < 8; ++kt)
#pragma unroll
                for (int i = 0; i < 4; ++i) sp[(16 * kt + 4 * g + i) * 128] = S[kt][i];
        }
    }
}

constexpr int NPHASE = 13;
__global__ void __launch_bounds__(NTHR, 2) mk_fwd(Args args) {
    extern __shared__ __attribute__((aligned(16))) unsigned char lds_raw[];
    Frame F;
    F.lds = (LAS unsigned char*)lds_raw;
    F.tid = threadIdx.x; F.lane = F.tid & 63; F.wave = __builtin_amdgcn_readfirstlane(F.tid >> 6);
    F.bid = blockIdx.x; F.G = gridDim.x;
#pragma unroll
    for (int i = 0; i < N_IN; ++i) F.in[i] = args.in[i];
    F.out = args.out; F.ws = args.ws;
    volatile LAS unsigned* MISC = (volatile LAS unsigned*)(F.lds + MISC_OFF);
    for (int u = F.tid; u < (LDS_BYTES - LDSCTL_OFF) / 4; u += NTHR) ((LAS unsigned*)(F.lds + LDSCTL_OFF))[u] = 0u;
    __syncthreads();
    const int lo = args.ph_lo, hi = args.ph_hi;
    const bool multi = (hi - lo) > 1;
    XcdBarrier bar; bar.bar = (unsigned*)(F.ws + WS_CTL) + CW_BAR; bar.x = 0; bar.st = nullptr;
    if (multi) bar = xcd_barrier_post((unsigned*)(F.ws + WS_CTL) + CW_BAR, MISC + 8);
#ifndef PH_MASK
#define PH_MASK 0x1fff
#endif
#define IN(k) (((PH_MASK >> (k)) & 1) && lo <= (k) && (k) < hi)
#define SEAM(k) do { if (IN(k) && IN((k) + 1)) xcd_barrier(bar); } while (0)

    if (IN(0)) { p0_prologue(F); } SEAM(0);
    if (IN(1)) { modnorm_rows(F, F.in[I_XP], F.in[I_XS], F.in[I_N1], 0, 1024, WSP(bf16, WS_H)); } SEAM(1);
    if (IN(2)) {
        pg8::Gemm g{WSP(bf16, WS_H), WSP(bf16, WS_WIN), NT, NPAD, DM}; pg8::StaticOrder S; S.init(NT, NPAD, F.G, F.bid);
        pg8::EpiProj E;
        E.d0 = OUTB(bf16, OUT_QA); E.d1 = OUTB(bf16, OUT_GF); E.d2 = OUTB(bf16, OUT_GB); E.d3 = OUTB(bf16, OUT_VA); E.d4 = WSP(bf16, WS_AG);
        E.d5 = WSP(bf16, WS_BQ); E.d6 = WSP(bf16, WS_BK); E.d7 = WSP(bf16, WS_BV); E.d8 = WSP(bf16, WS_BZ);
        E.BETA = WSP(float, WS_BETA); E.GG = WSP(float, WS_GG); E.lbraw = F.in[I_LB]; E.Alog = F.in[I_ALOG]; E.dtb = F.in[I_DTB];
        pg8::gemm_phase<pg8::EpiProj, pg8::StaticOrder, true, true>(F.lds, g, S, E);
    } SEAM(2);
    if (IN(3)) { p3_hgrn(F); } SEAM(3);
    if (IN(4)) { p4_chain<false>(F); } SEAM(4);
    if (IN(5)) { p3_gdn(F); } SEAM(5);
    if (IN(6)) { p4_chain<true>(F); } SEAM(6);
    if (IN(7)) { p5_headnorm(F); } SEAM(7);
    if (IN(8)) {
        pg8::Gemm g{WSP(bf16, WS_YIN), WSP(bf16, WS_WOUT), NT, DM, DM}; pg8::StaticOrder S; S.init(NT, DM, F.G, F.bid);
        pg8::EpiRes E{F.in[I_XP], F.in[I_XS], F.out, WSP(float, WS_MOD), 2048};
        pg8::gemm_phase<pg8::EpiRes, pg8::StaticOrder, true, true>(F.lds, g, S, E);
    } SEAM(8);
    if (IN(9)) { modnorm_rows(F, F.out, F.out + (size_t)NCTX * DM, F.in[I_N2], 3072, 4096, WSP(bf16, WS_H2)); } SEAM(9);
    if (IN(10)) {
        pg8::Gemm g{WSP(bf16, WS_H2), WSP(bf16, WS_WGU), NT, 2 * DFF, DM}; pg8::StaticOrder S; S.init(NT, 2 * DFF, F.G, F.bid);
        pg8::EpiGU E{WSP(bf16, WS_GU)};
        pg8::gemm_phase<pg8::EpiGU, pg8::StaticOrder, true, true>(F.lds, g, S, E);
    } SEAM(10);
    if (IN(11)) {
        pg8::Gemm g{WSP(bf16, WS_GU), WSP(bf16, WS_WDN), NT, DM, DFF}; pg8::StaticOrder S; S.init(NT, DM, F.G, F.bid);
        pg8::EpiRes E{F.out, F.out + (size_t)NCTX * DM, F.out, WSP(float, WS_MOD), 5120};
        pg8::gemm_phase<pg8::EpiRes, pg8::StaticOrder, true, true>(F.lds, g, S, E);
    } SEAM(11);
    if (IN(12)) { final_norm(F); }
#undef IN
#undef SEAM
}

extern "C" void kernel_launch(void* const* d_in, const int* in_sizes, int n_in, void* d_out, int out_size, void* d_ws, size_t ws_size, hipStream_t stream) {
    static int grid = 0;
    if (grid == 0) {
        if (n_in != N_IN || ws_size < WS_END) { fprintf(stderr, "kernel_launch: unexpected n_in %d / ws %zu\n", n_in, ws_size); grid = -1; return; }
        int dev = 0, cus = 0;
        if (hipGetDevice(&dev) != hipSuccess || hipDeviceGetAttribute(&cus, hipDeviceAttributeMultiprocessorCount, dev) != hipSuccess) { grid = -1; return; }
        if (hipFuncSetAttribute((const void*)mk_fwd, hipFuncAttributeMaxDynamicSharedMemorySize, LDS_BYTES) != hipSuccess) { fprintf(stderr, "kernel_launch: hipFuncSetAttribute failed\n"); grid = -1; return; }
        int per_cu = 0;
        if (hipOccupancyMaxActiveBlocksPerMultiprocessor(&per_cu, (const void*)mk_fwd, NTHR, LDS_BYTES) != hipSuccess || per_cu < 1) { fprintf(stderr, "kernel_launch: occupancy query reports %d\n", per_cu); }
        (void)hipGetLastError();
        grid = cus;
    }
    if (grid < 0) return;
    (void)hipMemsetAsync((char*)d_ws + WS_CTL, 0, CTL_ZERO_BYTES, stream);
    Args a{};
    for (int i = 0; i < N_IN; ++i) a.in[i] = (const float*)d_in[i];
    a.out = (float*)d_out; a.ws = (unsigned char*)d_ws;
#if MK_ONE_LAUNCH
    a.ph_lo = 0; a.ph_hi = NPHASE;
    hipLaunchKernelGGL(mk_fwd, dim3(grid), dim3(NTHR), LDS_BYTES, stream, a);
#else
    for (int k = 0; k < NPHASE; ++k) { a.ph_lo = k; a.ph_hi = k + 1; hipLaunchKernelGGL(mk_fwd, dim3(grid), dim3(NTHR), LDS_BYTES, stream, a); }
#endif
}
```

```cpp
#include <hip/hip_runtime.h>
#include <cstdio>
#include <cstdint>

#ifndef REP_MASK
#define REP_MASK 0x0
#endif
#ifndef PROBE_ID
#define PROBE_ID 0
#endif
#define PROBE_K 1
#ifndef MK_ONE_LAUNCH
#define MK_ONE_LAUNCH 1
#endif

#define LAS __attribute__((address_space(3)))
#define GAS __attribute__((address_space(1)))
typedef unsigned short bf16;
typedef short bf16x8 __attribute__((ext_vector_type(8)));
typedef float f32x4 __attribute__((ext_vector_type(4)));
typedef float f32x2 __attribute__((ext_vector_type(2)));
typedef unsigned u32x4 __attribute__((ext_vector_type(4)));
typedef unsigned u32x2 __attribute__((ext_vector_type(2)));
typedef GAS unsigned gu32;

constexpr int NT = 20480, NCTX = 4096, DM = 1024, DPROJ = 4624, NPAD = 4864, DFF = 2816, NSEQ = 20;
constexpr float EPS = 1e-6f;
constexpr int NWAVES = 8, NTHR = 512;
enum { I_XP = 0, I_XS, I_C, I_SH, I_SG, I_CCTX, I_WADA, I_BADA, I_N1, I_N2, I_WIN, I_CONV, I_LB, I_ALOG, I_DTB, I_HNORM, I_GNORM, I_WOUT, I_WGATE, I_WUP, I_WDOWN, I_NF, N_IN };

constexpr size_t MiB = 1u << 20;
constexpr size_t WS_CTL = 0, CTL_ZERO_BYTES = 1 * MiB;
constexpr size_t WS_MOD = 1 * MiB;
constexpr size_t WS_BETA = 2 * MiB, WS_GG = 3 * MiB;
constexpr size_t WS_BQ = 4 * MiB, WS_BK = 24 * MiB, WS_BV = 44 * MiB;
constexpr size_t WS_OB = 4 * MiB;
constexpr size_t WS_AG = 64 * MiB, WS_BZ = 84 * MiB;
constexpr size_t WS_I = 104 * MiB;
constexpr size_t WS_H = 104 * MiB;
constexpr size_t WS_WIN = 144 * MiB;
constexpr size_t WS_YIN = 104 * MiB;
constexpr size_t WS_WOUT = 236 * MiB, WS_WGU = 238 * MiB, WS_WDN = 249 * MiB;
constexpr size_t WS_H2 = 4 * MiB;
constexpr size_t WS_GU = 44 * MiB;
constexpr size_t WS_END = 256 * MiB;
constexpr size_t OUT_QA = 0, OUT_VA = 20 * MiB, OUT_GF = 40 * MiB, OUT_GB = 60 * MiB, OUT_OA = 0, OUT_GOVF = 40 * MiB;
constexpr size_t OUT_Y_FLOATS = (size_t)NT * DM, STATE_FLOATS = (size_t)16 * 2 * 4 * 128 * 128;
constexpr int HREC = 41472;
constexpr int GREC = 73984;
constexpr int NUC = 2560, NVB = 1280;
constexpr size_t WS_HVB = WS_I + (size_t)NUC * HREC;
constexpr int N1G = 2154;
static_assert((size_t)N1G * GREC <= 152 * MiB && (size_t)(NUC - N1G) * GREC <= 40 * MiB, "GDN image split");
static_assert(WS_HVB + (size_t)NVB * 16384 <= WS_END, "HGRN images fit");
constexpr int L_WN = 0, L_QD = 16384, L_AT = 32768, L_KT = 40960, L_U = 57344, L_SC = 73728;

constexpr int CW_BAR = 4096;
constexpr int CW_PROG_H = 16384, CW_PROG_G = 16384 + 64 * 32;
constexpr int P4_PD = 4;
constexpr int P4_BUF = 74752;
constexpr int RING_BYTES = 2 * P4_BUF, LDSCTL_OFF = RING_BYTES, MISC_OFF = LDSCTL_OFF + 320, LDS_BYTES = RING_BYTES + 1024;
static_assert(RING_BYTES >= 131072 && LDS_BYTES <= 163840, "LDS map");

#define PROBE_BEGIN(id) do { if (PROBE_ID == (id) && blockIdx.x == 0 && threadIdx.x == 0) probe_t0 = __builtin_amdgcn_s_memrealtime(); } while (0)
#define PROBE_END(id) do { if (PROBE_ID == (id) && blockIdx.x == 0 && threadIdx.x == 0) probe_acc += __builtin_amdgcn_s_memrealtime() - probe_t0; } while (0)
#define LDS_WAIT() asm volatile("s_waitcnt lgkmcnt(0)" ::: "memory")
#define VM_WAIT() asm volatile("s_waitcnt vmcnt(0)" ::: "memory")
#define RLX_AGENT __ATOMIC_RELAXED, __HIP_MEMORY_SCOPE_AGENT
__device__ __forceinline__ unsigned f2bf(float f) { unsigned u = __builtin_bit_cast(unsigned, f); return (u + 0x7fffu + ((u >> 16) & 1u)) >> 16; }
__device__ __forceinline__ unsigned pk2(float lo, float hi) { return f2bf(lo) | (f2bf(hi) << 16); }
__device__ __forceinline__ float bflo(unsigned w) { return __builtin_bit_cast(float, w << 16); }
__device__ __forceinline__ float bfhi(unsigned w) { return __builtin_bit_cast(float, w & 0xffff0000u); }
__device__ __forceinline__ float bf2f(unsigned short h) { return __builtin_bit_cast(float, (unsigned)h << 16); }
__device__ __forceinline__ float siluf(float x) { return x * __builtin_amdgcn_rcpf(1.f + __expf(-x)); }
__device__ __forceinline__ float sigmf(float x) { return __builtin_amdgcn_rcpf(1.f + __expf(-x)); }
__device__ __forceinline__ f32x4 mfma16(bf16x8 a, bf16x8 b, f32x4 c) { return __builtin_amdgcn_mfma_f32_16x16x32_bf16(a, b, c, 0, 0, 0); }
__device__ __forceinline__ bf16x8 as_frag(u32x4 v) { return __builtin_bit_cast(bf16x8, v); }
__device__ __forceinline__ float wave_sum(float v) {
#pragma unroll
    for (int o = 1; o < 64; o <<= 1) v += __shfl_xor(v, o);
    return v;
}
__device__ __forceinline__ int seq_base(int s) { return s < 16 ? s * 256 : NCTX + (s - 16) * 4096; }
__device__ __forceinline__ int seq_nchunk(int s) { return s < 16 ? 4 : 64; }
__device__ __forceinline__ int chunk_base(int s) { return s < 16 ? 4 * s : 64 + 64 * (s - 16); }
__device__ __forceinline__ int tok_a(int s, int n, int i) { return seq_base(s) + 64 * n + i; }
__device__ __forceinline__ int tok_b(int s, int n, int i) { return s < 16 ? s * 256 + 64 * n + i : NCTX + (s - 16) * 4096 + 64 * i + n; }
__device__ __forceinline__ int kperm(int g, int j) { return 16 * (j >> 2) + 4 * g + (j & 3); }

namespace pg8 {
#define PG8_LAS __attribute__((address_space(3)))
typedef unsigned short bf16_t;
typedef short bf16x8 __attribute__((ext_vector_type(8)));
typedef float f32x4 __attribute__((ext_vector_type(4)));
typedef unsigned u32x4 __attribute__((ext_vector_type(4)));
constexpr int BM = 256, BK = 64, HALF = 128, HTB = HALF * BK * 2  , STAGE_BYTES = 8 * HTB, NXCD = 8, WGM = 8;

__host__ __device__ __forceinline__ int lds_byte(int r, int c) { const int st = (r >> 4) * 2 + (c >> 5), rr = r & 15, cc = c & 31, ob = rr * 64 + cc * 2; return st * 1024 + (ob ^ (((ob >> 9) & 1) << 5)); }
__host__ __device__ __forceinline__ void stage_rc(int b, int& R, int& C) { const int st = b / 1024, sb = b % 1024, swz = sb ^ (((sb >> 9) & 1) << 5); R = (st >> 1) * 16 + swz / 64; C = (st & 1) * 32 + (swz % 64) / 2; }
__host__ __device__ __forceinline__ int perm32(int rho) { const int n = rho >> 4, i = rho & 15; return 8 * (i >> 2) + 4 * n + (i & 3); }

struct Unit { int pm, pn; };
struct Gemm { const bf16_t* A; const bf16_t* Bt; int M, N, K; };

struct StaticOrder {
    int nM, nN, nwg, G, c;
    __host__ __device__ void init(int M, int N, int G_, int c_) { nM = M / BM; nN = N / BM; nwg = nM * nN; G = G_; c = c_; }
    __host__ __device__ bool next(int i, Unit& u) const {
        const long L = (long)i * G + c; if (L >= nwg) return false;
        int wgid = (int)L; { const int q = nwg / NXCD, r = nwg % NXCD, xcd = wgid % NXCD, off = wgid / NXCD; wgid = (xcd < r ? xcd * (q + 1) : r * (q + 1) + (xcd - r) * q) + off; }
        const int nig = WGM * nN, gid = wgid / nig, fm = gid * WGM, gsz = (nM - fm) < WGM ? (nM - fm) : WGM;
        u.pm = fm + ((wgid % nig) % gsz); u.pn = (wgid % nig) / gsz; return true;
    }
    __device__ __forceinline__ void a_ready(const Unit&) const {}
    __device__ __forceinline__ void done(const Unit&) const {}
};


__device__ __forceinline__ unsigned pkbf(float lo, float hi) { return ::pk2(lo, hi); }

struct EpiProj {
    static constexpr bool PERM = true, AFTER_DRAIN = false;
    bf16_t *d0, *d1, *d2, *d3, *d4, *d5, *d6, *d7, *d8;
    float* BETA; float* GG;
    const float* lbraw;
    const float* Alog; const float* dtb;
    __device__ __forceinline__ void operator()(const f32x4 (&acc)[2][2][4][2], const Unit& u, int wr, int wc, int fr, int fq) const {
        const int pn = u.pn, row0 = u.pm * BM + wr * 64 + fr;
        if (pn < 18) {
            const int seg = pn >> 1;
            bf16_t* base = seg == 0 ? d0 : seg == 1 ? d1 : seg == 2 ? d2 : seg == 3 ? d3 : seg == 4 ? d4 : seg == 5 ? d5 : seg == 6 ? d6 : seg == 7 ? d7 : d8;
            const int mode = (seg == 0 || seg == 4 || seg == 8) ? 1 : ((seg == 1 || seg == 2) ? 2 : 0);
#pragma unroll
            for (int bj = 0; bj < 2; ++bj) {
                const int c0 = (pn & 1) * 256 + bj * HALF + wc * 32 + 8 * fq;
                float lb[8];
                if (mode == 2) {
                    const int dir = seg - 1;
#pragma unroll
                    for (int e = 0; e < 8; ++e) { const float x0 = lbraw[dir * 512 + c0 + e], x1 = lbraw[1024 + dir * 512 + c0 + e]; lb[e] = 1.f / (1.f + __expf(x1 - x0)); }
                }
#pragma unroll
                for (int ai = 0; ai < 2; ++ai)
#pragma unroll
                    for (int m = 0; m < 4; ++m) {
                        float v[8];
#pragma unroll
                        for (int e = 0; e < 4; ++e) { v[e] = acc[ai][bj][m][0][e]; v[4 + e] = acc[ai][bj][m][1][e]; }
                        if (mode == 1) {
#pragma unroll
                            for (int e = 0; e < 8; ++e) v[e] = ::siluf(v[e]);
                        } else if (mode == 2) {
#pragma unroll
                            for (int e = 0; e < 8; ++e) { const float f = lb[e] + (1.f - lb[e]) * ::sigmf(v[e]); v[e] = __logf(f); }
                        }
                        u32x4 w; w.x = pkbf(v[0], v[1]); w.y = pkbf(v[2], v[3]); w.z = pkbf(v[4], v[5]); w.w = pkbf(v[6], v[7]);
                        *(u32x4*)(base + (size_t)(row0 + ai * HALF + m * 16) * 512 + c0) = w;
                    }
            }
        } else {
            if (wc == 0 && fq < 2) {
                float al[8], db[8];
                if (fq == 1) {
#pragma unroll
                    for (int e = 0; e < 8; ++e) { al[e] = -__expf(Alog[e]); db[e] = dtb[e]; }
                }
#pragma unroll
                for (int ai = 0; ai < 2; ++ai)
#pragma unroll
                    for (int m = 0; m < 4; ++m) {
                        const int row = row0 + ai * HALF + m * 16;
                        float v[8];
#pragma unroll
                        for (int e = 0; e < 4; ++e) { v[e] = acc[ai][0][m][0][e]; v[4 + e] = acc[ai][0][m][1][e]; }
                        if (fq == 0) {
#pragma unroll
                            for (int e = 0; e < 8; ++e) v[e] = ::sigmf(v[e]);
                            *(f32x4*)(BETA + (size_t)row * 8) = (f32x4){v[0], v[1], v[2], v[3]};
                            *(f32x4*)(BETA + (size_t)row * 8 + 4) = (f32x4){v[4], v[5], v[6], v[7]};
                        } else {
#pragma unroll
                            for (int e = 0; e < 8; ++e) { const float x = v[e] + db[e]; const float sp = x > 15.f ? x : log1pf(__expf(x)); v[e] = al[e] * sp; }
                            *(f32x4*)(GG + (size_t)row * 8) = (f32x4){v[0], v[1], v[2], v[3]};
                            *(f32x4*)(GG + (size_t)row * 8 + 4) = (f32x4){v[4], v[5], v[6], v[7]};
                        }
                    }
            }
        }
    }
};

struct EpiRes {
    static constexpr bool PERM = true, AFTER_DRAIN = false;
    const float* base0; const float* base1;
    float* out; const float* mod; int goff;
    __device__ __forceinline__ void operator()(const f32x4 (&acc)[2][2][4][2], const Unit& u, int wr, int wc, int fr, int fq) const {
        const int row0 = u.pm * BM + wr * 64 + fr;
        const int mr = u.pm < 16 ? 0 : 1 + ((u.pm - 16) >> 4);
        const float* gp = mod + (size_t)mr * 6144 + goff;
#pragma unroll
        for (int bj = 0; bj < 2; ++bj) {
            const int c0 = u.pn * BM + bj * HALF + wc * 32 + 8 * fq;
            const f32x4 g0 = *(const f32x4*)(gp + c0), g1 = *(const f32x4*)(gp + c0 + 4);
#pragma unroll
            for (int ai = 0; ai < 2; ++ai)
#pragma unroll
                for (int m = 0; m < 4; ++m) {
                    const int row = row0 + ai * HALF + m * 16;
                    const float* bp = (row < 4096 ? base0 + (size_t)row * 1024 : base1 + (size_t)(row - 4096) * 1024) + c0;
                    const f32x4 b0 = *(const f32x4*)bp, b1 = *(const f32x4*)(bp + 4);
                    float* op = out + (size_t)row * 1024 + c0;
                    *(f32x4*)op = b0 + g0 * acc[ai][bj][m][0];
                    *(f32x4*)(op + 4) = b1 + g1 * acc[ai][bj][m][1];
                }
        }
    }
};

struct EpiGU {
    static constexpr bool PERM = true, AFTER_DRAIN = false;
    bf16_t* GU;
    __device__ __forceinline__ void operator()(const f32x4 (&acc)[2][2][4][2], const Unit& u, int wr, int wc, int fr, int fq) const {
        const int row0 = u.pm * BM + wr * 64 + fr, c0 = u.pn * HALF + wc * 32 + 8 * fq;
#pragma unroll
        for (int ai = 0; ai < 2; ++ai)
#pragma unroll
            for (int m = 0; m < 4; ++m) {
                float v[8];
#pragma unroll
                for (int e = 0; e < 4; ++e) { v[e] = ::siluf(acc[ai][0][m][0][e]) * acc[ai][1][m][0][e]; v[4 + e] = ::siluf(acc[ai][0][m][1][e]) * acc[ai][1][m][1][e]; }
                u32x4 w; w.x = pkbf(v[0], v[1]); w.y = pkbf(v[2], v[3]); w.z = pkbf(v[4], v[5]); w.w = pkbf(v[6], v[7]);
                *(u32x4*)(GU + (size_t)(row0 + ai * HALF + m * 16) * 2816 + c0) = w;
            }
    }
};
template <class Epi, class Sched, bool ALIGN_EPI = false, bool SP2 = false>
__device__ __forceinline__ void gemm_phase(PG8_LAS unsigned char* lds, const Gemm g, const Sched& S, const Epi& E) {
    const int tid = threadIdx.x, wid = __builtin_amdgcn_readfirstlane(tid >> 6), lane = tid & 63, wr = wid >> 2, wc = wid & 3, fr = lane & 15, fq = lane >> 4;
    const int K = g.K, nt = K / BK;
    unsigned voffA[2], voffB[2];
#pragma unroll
    for (int i = 0; i < 2; ++i) { int R, C; stage_rc(tid * 16 + i * 8192, R, C); const int Rb = Epi::PERM ? ((R & ~31) + perm32(R & 31)) : R;
        voffA[i] = (unsigned)(R * K + C) * 2u; voffB[i] = (unsigned)(Rb * K + C) * 2u; }
    const size_t kstep = (size_t)(BK * 2);
    const size_t hstep = (size_t)HALF * K * 2;
    const size_t tstep = 2 * hstep;
    const unsigned ldsw = (unsigned)wid * 1024u;
    const int aoff = lds_byte(wr * 64 + fr, fq * 8), boff = lds_byte(wc * 32 + fr, fq * 8);
#define PG8_SA(b, h) (((b) * 2 + (h)) * HTB)
#define PG8_SB(b, h) ((4 + (b) * 2 + (h)) * HTB)
#define PG8_STAGE(bufoff, gbase, voff) do { _Pragma("unroll") for (int _i = 0; _i < 2; ++_i) \
        __builtin_amdgcn_global_load_lds((const unsigned*)((const char*)(gbase) + (voff)[_i]), (PG8_LAS unsigned*)(lds + (bufoff) + ldsw + _i * 8192), 16, 0, 0); } while (0)
#define PG8_LDA(dst, b, h) do { _Pragma("unroll") for (int m = 0; m < 4; ++m) _Pragma("unroll") for (int k = 0; k < 2; ++k) dst[m][k] = *(const PG8_LAS bf16x8*)(lds + PG8_SA(b, h) + aoff + m * 2048 + k * 1024); } while (0)
#define PG8_LDB(dst, b, h) do { _Pragma("unroll") for (int n = 0; n < 2; ++n) _Pragma("unroll") for (int k = 0; k < 2; ++k) dst[n][k] = *(const PG8_LAS bf16x8*)(lds + PG8_SB(b, h) + boff + n * 2048 + k * 1024); } while (0)
#define PG8_MMA(ai, bj, At, Bt) do { __builtin_amdgcn_s_setprio(1); _Pragma("unroll") for (int m = 0; m < 4; ++m) _Pragma("unroll") for (int n = 0; n < 2; ++n) _Pragma("unroll") for (int k = 0; k < 2; ++k) \
        acc[ai][bj][m][n] = __builtin_amdgcn_mfma_f32_16x16x32_bf16(Bt[n][k], At[m][k], acc[ai][bj][m][n], 0, 0, 0); __builtin_amdgcn_s_setprio(0); } while (0)
#define PG8_WAIT_V(n) asm volatile("s_waitcnt vmcnt(" #n ")" ::: "memory")
#define PG8_WAIT_L(n) asm volatile("s_waitcnt lgkmcnt(" #n ")" ::: "memory")
#define PG8_BAR __builtin_amdgcn_s_barrier()
#define PG8_SCHED __builtin_amdgcn_sched_barrier(0)
    Unit cur, nxt; int ui = 0;
    if (!S.next(0, cur)) return;
    f32x4 acc[2][2][4][2];
#pragma unroll
    for (int a = 0; a < 2; ++a)
#pragma unroll
        for (int b = 0; b < 2; ++b)
#pragma unroll
            for (int m = 0; m < 4; ++m)
#pragma unroll
                for (int n = 0; n < 2; ++n) acc[a][b][m][n] = (f32x4){0.f, 0.f, 0.f, 0.f};
    bf16x8 At[4][2], B0[2][2], B1[2][2];
    const char* cA = (const char*)g.A + (size_t)cur.pm * tstep; const char* cB = (const char*)g.Bt + (size_t)cur.pn * tstep;
    S.a_ready(cur);
    if constexpr (SP2) {
        PG8_STAGE(PG8_SB(0, 0), cB, voffB); PG8_STAGE(PG8_SB(0, 1), cB + hstep, voffB); PG8_STAGE(PG8_SA(0, 0), cA, voffA); PG8_STAGE(PG8_SA(0, 1), cA + hstep, voffA);
        if (wr == 1) PG8_BAR;
        PG8_WAIT_V(2); PG8_BAR;
        PG8_STAGE(PG8_SB(1, 0), cB + kstep, voffB); PG8_STAGE(PG8_SA(1, 0), cA + kstep, voffA); PG8_STAGE(PG8_SB(1, 1), cB + hstep + kstep, voffB);
        PG8_WAIT_V(6); PG8_BAR;
    } else {
        PG8_STAGE(PG8_SB(0, 0), cB, voffB); PG8_STAGE(PG8_SA(0, 0), cA, voffA); PG8_STAGE(PG8_SB(0, 1), cB + hstep, voffB); PG8_STAGE(PG8_SA(0, 1), cA + hstep, voffA);
        if (wr == 1) PG8_BAR;
        PG8_WAIT_V(4); PG8_BAR;
        PG8_STAGE(PG8_SB(1, 0), cB + kstep, voffB); PG8_STAGE(PG8_SA(1, 0), cA + kstep, voffA); PG8_STAGE(PG8_SB(1, 1), cB + hstep + kstep, voffB);
        PG8_WAIT_V(6); PG8_BAR;
    }
    for (;;) {
        const bool has_next = S.next(ui + 1, nxt);
        const char* nA = has_next ? (const char*)g.A + (size_t)nxt.pm * tstep : cA; const char* nB = has_next ? (const char*)g.Bt + (size_t)nxt.pn * tstep : cB;
        for (int t = 0; t < nt; t += 2) {
            const bool last = (t == nt - 2);
            const char* a1 = cA + (size_t)(t + 1) * kstep;
            const char* a2 = last ? nA : cA + (size_t)(t + 2) * kstep; const char* b2 = last ? nB : cB + (size_t)(t + 2) * kstep;
            const char* a3 = a2 + kstep; const char* b3 = b2 + kstep;
            if (last && has_next) S.a_ready(nxt);
            if constexpr (SP2) {
            PG8_LDB(B0, 0, 0); PG8_LDB(B1, 0, 1); PG8_SCHED; PG8_LDA(At, 0, 0); PG8_STAGE(PG8_SA(1, 1), a1 + hstep, voffA);
            PG8_WAIT_V(8); PG8_WAIT_L(0); PG8_BAR; PG8_MMA(0, 0, At, B0); PG8_MMA(0, 1, At, B1); PG8_BAR; PG8_SCHED;
            PG8_LDA(At, 0, 1); PG8_STAGE(PG8_SB(0, 0), b2, voffB); PG8_STAGE(PG8_SB(0, 1), b2 + hstep, voffB); PG8_STAGE(PG8_SA(0, 0), a2, voffA);
            PG8_WAIT_V(8); PG8_WAIT_L(0); PG8_BAR; PG8_MMA(1, 0, At, B0); PG8_MMA(1, 1, At, B1); PG8_BAR; PG8_SCHED;
            PG8_LDB(B0, 1, 0); PG8_LDB(B1, 1, 1); PG8_SCHED; PG8_LDA(At, 1, 0); PG8_STAGE(PG8_SA(0, 1), a2 + hstep, voffA);
            PG8_WAIT_V(8); PG8_WAIT_L(0); PG8_BAR; PG8_MMA(0, 0, At, B0); PG8_MMA(0, 1, At, B1); PG8_BAR; PG8_SCHED;
            PG8_LDA(At, 1, 1); PG8_STAGE(PG8_SB(1, 0), b3, voffB); PG8_STAGE(PG8_SB(1, 1), b3 + hstep, voffB); PG8_STAGE(PG8_SA(1, 0), a3, voffA);
            PG8_WAIT_V(8); PG8_WAIT_L(0); PG8_BAR; PG8_MMA(1, 0, At, B0); PG8_MMA(1, 1, At, B1); PG8_BAR; PG8_SCHED;
            } else {
            PG8_LDB(B0, 0, 0); PG8_SCHED; PG8_LDA(At, 0, 0); PG8_STAGE(PG8_SA(1, 1), a1 + hstep, voffA);
            PG8_WAIT_L(8); PG8_BAR; PG8_WAIT_L(0); PG8_MMA(0, 0, At, B0); PG8_BAR; PG8_SCHED;
            PG8_LDB(B1, 0, 1); PG8_STAGE(PG8_SB(0, 0), b2, voffB);
            PG8_BAR; PG8_WAIT_L(0); PG8_MMA(0, 1, At, B1); PG8_BAR;
            PG8_LDA(At, 0, 1); PG8_STAGE(PG8_SA(0, 0), a2, voffA);
            PG8_BAR; PG8_WAIT_L(0); PG8_MMA(1, 0, At, B0); PG8_BAR; PG8_SCHED;
            PG8_STAGE(PG8_SB(0, 1), b2 + hstep, voffB);
            PG8_WAIT_V(6); PG8_BAR; PG8_MMA(1, 1, At, B1); PG8_BAR;
            PG8_LDB(B0, 1, 0); PG8_SCHED; PG8_LDA(At, 1, 0); PG8_STAGE(PG8_SA(0, 1), a2 + hstep, voffA);
            PG8_WAIT_L(8); PG8_BAR; PG8_WAIT_L(0); PG8_MMA(0, 0, At, B0); PG8_BAR; PG8_SCHED;
            PG8_LDB(B1, 1, 1); PG8_STAGE(PG8_SB(1, 0), b3, voffB);
            PG8_BAR; PG8_WAIT_L(0); PG8_MMA(0, 1, At, B1); PG8_BAR;
            PG8_LDA(At, 1, 1); PG8_STAGE(PG8_SA(1, 0), a3, voffA);
            PG8_BAR; PG8_WAIT_L(0); PG8_MMA(1, 0, At, B0); PG8_BAR; PG8_SCHED;
            PG8_STAGE(PG8_SB(1, 1), b3 + hstep, voffB);
            PG8_WAIT_V(6); PG8_BAR; PG8_MMA(1, 1, At, B1); PG8_BAR;
            }
        }
        if constexpr (ALIGN_EPI) { if (wr == 0) PG8_BAR; }
        if constexpr (!Epi::AFTER_DRAIN) { E(acc, cur, wr, wc, fr, fq); S.done(cur); }
        if (!has_next) break;
#pragma unroll
        for (int a = 0; a < 2; ++a)
#pragma unroll
            for (int b = 0; b < 2; ++b)
#pragma unroll
                for (int m = 0; m < 4; ++m)
#pragma unroll
                    for (int n = 0; n < 2; ++n) acc[a][b][m][n] = (f32x4){0.f, 0.f, 0.f, 0.f};
        cur = nxt; cA = nA; cB = nB; ++ui;
        if constexpr (ALIGN_EPI) { if (wr == 1) PG8_BAR; }
    }
    PG8_WAIT_V(0);
    if constexpr (!ALIGN_EPI) { if (wr == 0) PG8_BAR; }
    PG8_BAR;
    if constexpr (Epi::AFTER_DRAIN) { E.fused(acc, cur, wr, wc, fr, fq, lds, wid, lane); S.done(cur); }
#undef PG8_SA
#undef PG8_SB
#undef PG8_STAGE
#undef PG8_LDA
#undef PG8_LDB
#undef PG8_MMA
#undef PG8_WAIT_V
#undef PG8_WAIT_L
#undef PG8_BAR
#undef PG8_SCHED
}
}

#define XB_TMO      128
#define XB_XCNT(j)  (256  + 64 * (j))
#define XB_XSUB(j)  (1280 + 64 * (j))
#define XB_XGEN(j)  (2304 + 64 * (j))
#define XB_TOP      3328
#define XB_TOPGEN   3392
#define XCD_BAR_WORDS 3456
#define XB_SPIN_CAP (1u << 18)

__device__ __forceinline__ unsigned xb_ld(unsigned* p)              { return __hip_atomic_load(p, __ATOMIC_RELAXED, __HIP_MEMORY_SCOPE_AGENT); }
__device__ __forceinline__ unsigned xb_add(unsigned* p, unsigned v) { return __hip_atomic_fetch_add(p, v, __ATOMIC_RELAXED, __HIP_MEMORY_SCOPE_AGENT); }
__device__ __forceinline__ unsigned xb_xcc_id() { return (unsigned)__builtin_amdgcn_s_getreg((3 << 11) | 20) & 0xFu; }
#define XB_SPIN(cond, bar) do { unsigned _sp = 0; while (cond) { __builtin_amdgcn_s_sleep(1); \
    if ((++_sp & 255u) == 0u) { if (xb_ld(&(bar)[XB_TMO])) break; if (_sp > XB_SPIN_CAP) { atomicAdd(&(bar)[XB_TMO], 1u); break; } } } } while (0)

struct XcdBarrier {
    unsigned* bar; unsigned x;
    volatile LAS unsigned* st;
};

__device__ __forceinline__ XcdBarrier xcd_barrier_post(unsigned* bar, volatile LAS unsigned* st) {
    XcdBarrier b; b.bar = bar; b.x = xb_xcc_id(); b.st = st;
    if (threadIdx.x == 0) (void)xb_add(&bar[XB_XCNT(b.x)], 1u);
    return b;
}
__device__ __forceinline__ void xcd_barrier_complete(unsigned* bar, unsigned x, unsigned& nloc, unsigned& nx) {
    const unsigned G = gridDim.x * gridDim.y * gridDim.z;
    unsigned sum, cnt, mine, sp = 0u;
    for (;;) {
        sum = 0u; cnt = 0u; mine = 0u;
#pragma unroll
        for (unsigned j = 0; j < 16; ++j) { const unsigned c = xb_ld(&bar[XB_XCNT(j)]); sum += c; cnt += (c > 0u) ? 1u : 0u; mine = (j == x) ? c : mine; }
        if (sum == G) break;
        __builtin_amdgcn_s_sleep(1);
        if ((++sp & 255u) == 0u) { if (xb_ld(&bar[XB_TMO])) break; if (sp > XB_SPIN_CAP) { atomicAdd(&bar[XB_TMO], 1u); break; } }
    }
    nloc = mine > 0u ? mine : 1u; nx = cnt > 0u ? cnt : 1u;
}

__device__ __forceinline__ void xcd_barrier(const XcdBarrier& b) {
    asm volatile("s_waitcnt vmcnt(0)" ::: "memory");
    __syncthreads();
    if (threadIdx.x == 0) {
        unsigned* bar = b.bar;
        __builtin_amdgcn_s_waitcnt(0);
        unsigned nloc = b.st[0], nx = b.st[1];
        if (nloc == 0u) { xcd_barrier_complete(bar, b.x, nloc, nx); b.st[0] = nloc; b.st[1] = nx; }
        const unsigned old = xb_add(&bar[XB_XSUB(b.x)], 1u);
        const unsigned gen = old / nloc;
        if (old + 1u == (gen + 1u) * nloc) {
            __builtin_amdgcn_fence(__ATOMIC_RELEASE, "agent");
            asm volatile("s_waitcnt vmcnt(0)" ::: "memory");
            const unsigned og = xb_add(&bar[XB_TOP], 1u);
            const unsigned tg = og / nx;
            if (og + 1u == (tg + 1u) * nx) xb_add(&bar[XB_TOPGEN], 1u);
            else XB_SPIN(xb_ld(&bar[XB_TOPGEN]) == tg, bar);
            __builtin_amdgcn_fence(__ATOMIC_ACQUIRE, "agent");
            xb_add(&bar[XB_XGEN(b.x)], 1u);
            asm volatile("s_waitcnt vmcnt(0)" ::: "memory");
        } else {
            XB_SPIN(xb_ld(&bar[XB_XGEN(b.x)]) == gen, bar);
            __builtin_amdgcn_fence(__ATOMIC_ACQUIRE, "agent");
            asm volatile("s_waitcnt vmcnt(0)" ::: "memory");
        }
    }
    __syncthreads();
}

struct Args { const float* in[N_IN]; float* out; unsigned char* ws; int ph_lo, ph_hi; };
struct Frame {
    LAS unsigned char* lds;
    int tid, lane, wave, bid, G;
    unsigned long long pacc, pt0;
    const float* in[N_IN];
    float* out; unsigned char* ws;
};
#define probe_acc F.pacc
#define probe_t0 F.pt0
#define WSP(T, off) ((T*)(F.ws + (off)))
#define OUTB(T, off) ((T*)((unsigned char*)F.out + (off)))

__device__ __forceinline__ void transpose_item(const float* W, int K, int N, bf16* WT, int dst_row0, int k0, int n0, LAS float* scr, int lane) {
#pragma unroll 8
    for (int i = 0; i < 32; ++i) { const int kk = 2 * i + (lane >> 5), n = n0 + (lane & 31); scr[kk * 33 + (lane & 31)] = n < N ? W[(size_t)(k0 + kk) * N + n] : 0.f; }
    LDS_WAIT(); asm volatile("" ::: "memory");
    const int c = lane & 7;
#pragma unroll
    for (int j = 0; j < 4; ++j) { const int n = (lane >> 3) + 8 * j; const LAS float* s = scr + (8 * c) * 33 + n;
        u32x4 o; o.x = pk2(s[0 * 33], s[1 * 33]); o.y = pk2(s[2 * 33], s[3 * 33]); o.z = pk2(s[4 * 33], s[5 * 33]); o.w = pk2(s[6 * 33], s[7 * 33]);
        *(u32x4*)(WT + (size_t)(dst_row0 + n) * K + k0 + 8 * c) = o; }
    LDS_WAIT(); asm volatile("" ::: "memory");
}

__device__ __forceinline__ void p0_prologue(Frame& F) {
    const int gw = F.bid * NWAVES + F.wave, NGW = F.G * NWAVES;
    {
        LAS float* scr = (LAS float*)(F.lds + 49152 + F.wave * 8704);
        constexpr int NB = NPAD / 32, NITEMS = 16 * NB;
        for (int it = gw; it < NITEMS; it += NGW) { const int kb = it / NB, nb = it % NB; transpose_item(F.in[I_WIN], 1024, DPROJ, WSP(bf16, WS_WIN), 32 * nb, 64 * kb, 32 * nb, scr, F.lane); }
    }
    {
        LAS float* sc = (LAS float*)F.lds;
        LAS float* red = (LAS float*)(F.lds + 32768);
        for (int idx = F.tid; idx < 5 * 1024; idx += NTHR) { const int r = idx >> 10, k = idx & 1023; const float v = r == 0 ? F.in[I_CCTX][k] : F.in[I_C][(r - 1) * 1024 + k]; sc[idx] = siluf(v); }
        __syncthreads();
        const float* wada = F.in[I_WADA]; const float* bada = F.in[I_BADA]; float* mod = WSP(float, WS_MOD);
        for (int cg = F.bid; cg < 256; cg += F.G) {
            const int col = F.tid % 24, kq = F.tid / 24;
            if (F.tid < 504) {
                float a0 = 0.f, a1 = 0.f, a2 = 0.f, a3 = 0.f, a4 = 0.f;
                const float* wp = wada + 24 * cg + col;
                for (int k = kq; k < 1024; k += 21) { const float w = wp[(size_t)k * 6144]; a0 += sc[k] * w; a1 += sc[1024 + k] * w; a2 += sc[2048 + k] * w; a3 += sc[3072 + k] * w; a4 += sc[4096 + k] * w; }
                LAS float* rp = red + (kq * 24 + col) * 5; rp[0] = a0; rp[1] = a1; rp[2] = a2; rp[3] = a3; rp[4] = a4;
            }
            __syncthreads();
            if (F.tid < 120) { const int c2 = F.tid % 24, r = F.tid / 24; float s = 0.f; for (int q = 0; q < 21; ++q) s += red[(q * 24 + c2) * 5 + r]; mod[r * 6144 + 24 * cg + c2] = s + bada[24 * cg + c2]; }
            __syncthreads();
        }
    }
}

__device__ __forceinline__ void modnorm_rows(Frame& F, const float* x0, const float* x1, const float* nw, int sh_off, int sc_off, bf16* H) {
    const int gw = F.bid * NWAVES + F.wave, NGW = F.G * NWAVES;
    const float* mod = WSP(float, WS_MOD);
    for (int m = gw; m < NT; m += NGW) {
        const float* xr = m < NCTX ? x0 + (size_t)m * DM : x1 + (size_t)(m - NCTX) * DM;
        const int mr = m < NCTX ? 0 : 1 + ((m - NCTX) >> 12);
        const float* mp = mod + (size_t)mr * 6144;
        f32x4 v[4]; float s = 0.f;
#pragma unroll
        for (int j = 0; j < 4; ++j) { v[j] = *(const f32x4*)(xr + 4 * F.lane + 256 * j); s += (v[j].x * v[j].x + v[j].y * v[j].y) + (v[j].z * v[j].z + v[j].w * v[j].w); }
        const float rstd = 1.f / sqrtf(wave_sum(s) * (1.f / DM) + EPS);
#pragma unroll
        for (int j = 0; j < 4; ++j) {
            const int c = 4 * F.lane + 256 * j;
            const f32x4 w = *(const f32x4*)(nw + c), sc = *(const f32x4*)(mp + sc_off + c), sh = *(const f32x4*)(mp + sh_off + c);
            const f32x4 h = (v[j] * rstd * w) * (sc + 1.f) + sh;
            u32x2 o; o.x = pk2(h.x, h.y); o.y = pk2(h.z, h.w);
            *(u32x2*)(H + (size_t)m * DM + c) = o;
        }
    }
}

__device__ __forceinline__ void final_norm(Frame& F) {
    const int gw = F.bid * NWAVES + F.wave, NGW = F.G * NWAVES;
    const float* nf = F.in[I_NF];
    for (int m = gw; m < NT; m += NGW) {
        float* xr = F.out + (size_t)m * DM;
        f32x4 v[4]; float s = 0.f;
#pragma unroll
        for (int j = 0; j < 4; ++j) { v[j] = *(const f32x4*)(xr + 4 * F.lane + 256 * j); s += (v[j].x * v[j].x + v[j].y * v[j].y) + (v[j].z * v[j].z + v[j].w * v[j].w); }
        const float rstd = 1.f / sqrtf(wave_sum(s) * (1.f / DM) + EPS);
#pragma unroll
        for (int j = 0; j < 4; ++j) { const int c = 4 * F.lane + 256 * j; const f32x4 w = *(const f32x4*)(nf + c); *(f32x4*)(xr + c) = v[j] * rstd * w; }
    }
}

__device__ __forceinline__ void p5_headnorm(Frame& F) {
    const int gw = F.bid * NWAVES + F.wave, NGW = F.G * NWAVES;
    {
        LAS float* scr = (LAS float*)(F.lds + F.wave * 8704);
        constexpr int I_O = 16 * 32, I_G = 16 * 88, I_D = 44 * 32, NITEMS = I_O + 2 * I_G + I_D;
        for (int it = gw; it < NITEMS; it += NGW) {
            int r = it;
            if (r < I_O) { const int kb = r / 32, nb = r % 32; transpose_item(F.in[I_WOUT], 1024, 1024, WSP(bf16, WS_WOUT), 32 * nb, 64 * kb, 32 * nb, scr, F.lane); continue; } r -= I_O;
            if (r < I_G) { const int kb = r / 88, nb = r % 88, n0 = 32 * nb; transpose_item(F.in[I_WGATE], 1024, DFF, WSP(bf16, WS_WGU), 256 * (n0 >> 7) + (n0 & 127), 64 * kb, n0, scr, F.lane); continue; } r -= I_G;
            if (r < I_G) { const int kb = r / 88, nb = r % 88, n0 = 32 * nb; transpose_item(F.in[I_WUP], 1024, DFF, WSP(bf16, WS_WGU), 256 * (n0 >> 7) + 128 + (n0 & 127), 64 * kb, n0, scr, F.lane); continue; } r -= I_G;
            { const int kb = r / 32, nb = r % 32; transpose_item(F.in[I_WDOWN], DFF, 1024, WSP(bf16, WS_WDN), 32 * nb, 64 * kb, 32 * nb, scr, F.lane); }
        }
    }
    const bf16* OA0 = OUTB(bf16, OUT_OA); const bf16* OA1 = OUTB(bf16, OUT_OA + 20 * MiB);
    const bf16* OB0 = WSP(bf16, WS_OB);   const bf16* OB1 = WSP(bf16, WS_OB + 20 * MiB);
    const bf16* AG = WSP(bf16, WS_AG);    const bf16* BZ = WSP(bf16, WS_BZ);
    bf16* Y = WSP(bf16, WS_YIN);
    for (int m = gw; m < NT; m += NGW) {
        const int half = F.lane >> 5, c = 16 * (F.lane & 31);
        const bf16* o0 = (half ? OB0 : OA0) + (size_t)m * 512 + c; const bf16* o1 = (half ? OB1 : OA1) + (size_t)m * 512 + c;
        const bf16* gt = (half ? BZ : AG) + (size_t)m * 512 + c;
        const float* nw = (half ? F.in[I_GNORM] : F.in[I_HNORM]) + c;
        float o[16]; float ss = 0.f;
#pragma unroll
        for (int q = 0; q < 2; ++q) {
            const u32x4 a = *(const u32x4*)(o0 + 8 * q), b = *(const u32x4*)(o1 + 8 * q);
#pragma unroll
            for (int e = 0; e < 4; ++e) { o[8 * q + 2 * e] = bflo(a[e]) + bflo(b[e]); o[8 * q + 2 * e + 1] = bfhi(a[e]) + bfhi(b[e]); }
        }
#pragma unroll
        for (int e = 0; e < 16; ++e) ss += o[e] * o[e];
        ss += __shfl_xor(ss, 1); ss += __shfl_xor(ss, 2); ss += __shfl_xor(ss, 4);
        const float rstd = 1.f / sqrtf(ss * (1.f / 128.f) + EPS);
#pragma unroll
        for (int q = 0; q < 2; ++q) {
            const u32x4 g = *(const u32x4*)(gt + 8 * q);
            const f32x4 w0 = *(const f32x4*)(nw + 8 * q), w1 = *(const f32x4*)(nw + 8 * q + 4);
            float y[8];
#pragma unroll
            for (int e = 0; e < 4; ++e) { y[2 * e] = o[8 * q + 2 * e] * rstd * (e < 2 ? w0[2 * e] : w1[2 * e - 4]) * bflo(g[e]); y[2 * e + 1] = o[8 * q + 2 * e + 1] * rstd * (e < 2 ? w0[2 * e + 1] : w1[2 * e - 3]) * bfhi(g[e]); }
            u32x4 w; w.x = pk2(y[0], y[1]); w.y = pk2(y[2], y[3]); w.z = pk2(y[4], y[5]); w.w = pk2(y[6], y[7]);
            *(u32x4*)(Y + (size_t)m * DM + half * 512 + c + 8 * q) = w;
        }
    }
}

__device__ __forceinline__ int uc_index(int s, int n, int h, int dir) { return ((chunk_base(s) + n) * 4 + h) * 2 + dir; }
__device__ __forceinline__ unsigned char* grec_ptr(Frame& F, int uc) { return uc < N1G ? F.ws + WS_I + (size_t)uc * GREC : (unsigned char*)F.out + OUT_GOVF + (size_t)(uc - N1G) * GREC; }
__device__ __forceinline__ unsigned char* hrec_ptr(Frame& F, int uc) { return F.ws + WS_I + (size_t)uc * HREC; }
__device__ __forceinline__ bool allowed(int dir, int t, int s) { return dir ? (s >= t) : (s <= t); }

__device__ __forceinline__ void write_qd_image(Frame& F, const LAS bf16* X, int pitch, const LAS float* rowscale, unsigned char* dst) {
    const int r = F.lane & 15, g = F.lane >> 4, mt = F.wave >> 1;
#pragma unroll
    for (int q = 0; q < 2; ++q) {
        const int ks = 2 * (F.wave & 1) + q, row = 16 * mt + r;
        const u32x2 a = *(const LAS u32x2*)(X + row * pitch + 32 * ks + 4 * g), b = *(const LAS u32x2*)(X + row * pitch + 32 * ks + 16 + 4 * g);
        u32x4 o;
        if (rowscale) { const float sc = rowscale[row];
            o.x = pk2(bflo(a.x) * sc, bfhi(a.x) * sc); o.y = pk2(bflo(a.y) * sc, bfhi(a.y) * sc); o.z = pk2(bflo(b.x) * sc, bfhi(b.x) * sc); o.w = pk2(bflo(b.y) * sc, bfhi(b.y) * sc);
        } else { o.x = a.x; o.y = a.y; o.z = b.x; o.w = b.y; }
        *(u32x4*)(dst + ((mt * 4 + ks) * 64 + F.lane) * 16) = o;
    }
}
__device__ __forceinline__ void write_at_image(Frame& F, const LAS bf16* KA, const LAS bf16* QB, int pitch, const LAS float* Cs, int dir, unsigned char* dst) {
    const int r = F.lane & 15, g = F.lane >> 4, mt = F.wave >> 1, ks2 = F.wave & 1;
    f32x4 a0 = {0.f, 0.f, 0.f, 0.f}, a1 = {0.f, 0.f, 0.f, 0.f};
#pragma unroll
    for (int kd = 0; kd < 4; ++kd) {
        const bf16x8 bq = as_frag(*(const LAS u32x4*)(QB + (16 * mt + r) * pitch + 32 * kd + 8 * g));
        const bf16x8 k0 = as_frag(*(const LAS u32x4*)(KA + (32 * ks2 + r) * pitch + 32 * kd + 8 * g));
        const bf16x8 k1 = as_frag(*(const LAS u32x4*)(KA + (32 * ks2 + 16 + r) * pitch + 32 * kd + 8 * g));
        a0 = mfma16(k0, bq, a0); a1 = mfma16(k1, bq, a1);
    }
    const int t = 16 * mt + r; const float ct = Cs ? Cs[t] : 0.f;
    float v[8];
#pragma unroll
    for (int j = 0; j < 8; ++j) {
        const int s = 32 * ks2 + kperm(g, j); const bool ok = allowed(dir, t, s);
        float x = (j < 4) ? a0[j & 3] : a1[j & 3];
        if (Cs) { const float e = __expf(ok ? ct - Cs[s] : 0.f); x *= e; }
        v[j] = ok ? x : 0.f;
    }
    u32x4 o; o.x = pk2(v[0], v[1]); o.y = pk2(v[2], v[3]); o.z = pk2(v[4], v[5]); o.w = pk2(v[6], v[7]);
    *(u32x4*)(dst + ((mt * 2 + ks2) * 64 + F.lane) * 16) = o;
}

__device__ __forceinline__ void p3_hgrn(Frame& F) {
    constexpr int PITCH = 136;
    LAS bf16* QDb = (LAS bf16*)(F.lds);
    LAS bf16* KDb = (LAS bf16*)(F.lds + 17408);
    LAS unsigned char* KTi = F.lds + 34816;
    LAS float* part = (LAS float*)(F.lds + 51200);
    LAS float* etot = (LAS float*)(F.lds + 55296);
    const bf16* QA = OUTB(bf16, OUT_QA); const bf16* VA = OUTB(bf16, OUT_VA);
    for (int task = F.bid; task < NUC; task += F.G) {
        const int dir = task & 1, h = (task >> 1) & 3, cidx = task >> 3;
        int s, n; if (cidx < 64) { s = cidx >> 2; n = cidx & 3; } else { s = 16 + ((cidx - 64) >> 6); n = (cidx - 64) & 63; }
        const bf16* Gd = OUTB(bf16, dir ? OUT_GB : OUT_GF);
        unsigned char* rec = hrec_ptr(F, task);
        const int cp = F.tid & 63, re = F.tid >> 6, c0 = 2 * cp;
        float f0[8], f1[8], q0[8], q1[8], p0[8], p1[8];
#pragma unroll
        for (int e = 0; e < 8; ++e) {
            const size_t off = (size_t)tok_a(s, n, 8 * re + e) * 512 + h * 128 + c0;
            const unsigned gw = *(const unsigned*)(Gd + off), qw = *(const unsigned*)(QA + off);
            f0[e] = __expf(bflo(gw)); f1[e] = __expf(bfhi(gw)); q0[e] = bflo(qw); q1[e] = bfhi(qw);
        }
        if (dir == 0) { float a = 1.f, b = 1.f;
#pragma unroll
            for (int e = 0; e < 8; ++e) { a *= f0[e]; b *= f1[e]; p0[e] = a; p1[e] = b; }
            part[re * 128 + c0] = a; part[re * 128 + c0 + 1] = b;
        } else { float a = 1.f, b = 1.f;
#pragma unroll
            for (int e = 7; e >= 0; --e) { a *= f0[e]; b *= f1[e]; p0[e] = a; p1[e] = b; }
            part[re * 128 + c0] = a; part[re * 128 + c0 + 1] = b;
        }
        __syncthreads();
        float o0 = 1.f, o1 = 1.f, t0 = 1.f, t1 = 1.f;
#pragma unroll
        for (int r2 = 0; r2 < 8; ++r2) { const float a = part[r2 * 128 + c0], b = part[r2 * 128 + c0 + 1]; t0 *= a; t1 *= b; const bool pre = dir ? (r2 > re) : (r2 < re); if (pre) { o0 *= a; o1 *= b; } }
        if (re == 0) { etot[c0] = t0; etot[c0 + 1] = t1; }
        float kt0[8], kt1[8];
#pragma unroll
        for (int e = 0; e < 8; ++e) {
            const float E0 = o0 * p0[e], E1 = o1 * p1[e];
            const float k0 = 1.f - f0[e], k1 = 1.f - f1[e];
            const float kd0 = k0 / E0, kd1 = k1 / E1;
            const int row = 8 * re + e;
            *(LAS unsigned*)(QDb + row * PITCH + c0) = pk2(q0[e] * E0, q1[e] * E1);
            *(LAS unsigned*)(KDb + row * PITCH + c0) = pk2(kd0, kd1);
            kt0[e] = kd0 * t0; kt1[e] = kd1 * t1;
        }
        {
            const int ks = re >> 2, hf = (re >> 1) & 1;
#pragma unroll
            for (int cc = 0; cc < 2; ++cc) {
                const int c = c0 + cc, kt = c >> 4, r = c & 15; const float* kv = cc ? kt1 : kt0;
#pragma unroll
                for (int p = 0; p < 2; ++p) {
                    const int g = 2 * (re & 1) + p;
                    u32x2 w; w.x = pk2(kv[4 * p], kv[4 * p + 1]); w.y = pk2(kv[4 * p + 2], kv[4 * p + 3]);
                    *(LAS u32x2*)(KTi + ((kt * 2 + ks) * 64 + g * 16 + r) * 16 + 8 * hf) = w;
                }
            }
        }
        __syncthreads();
        write_qd_image(F, QDb, PITCH, nullptr, rec);
        write_at_image(F, KDb, QDb, PITCH, nullptr, dir, rec + 16384);
        for (int i = F.tid; i < 1024; i += NTHR) *(u32x4*)(rec + 24576 + i * 16) = *(const LAS u32x4*)(KTi + i * 16);
        if (F.tid < 32) *(f32x4*)(rec + 40960 + F.tid * 16) = *(const LAS f32x4*)((LAS unsigned char*)etot + F.tid * 16);
        if (dir == 0) {
            unsigned char* vb = F.ws + WS_HVB + (size_t)(task >> 1) * 16384;
            const int c = F.lane & 15, g = F.lane >> 4, w = F.wave;
#pragma unroll
            for (int ks2 = 0; ks2 < 2; ++ks2) {
                unsigned short x[8];
#pragma unroll
                for (int j = 0; j < 8; ++j) x[j] = VA[(size_t)tok_a(s, n, 32 * ks2 + kperm(g, j)) * 512 + h * 128 + 16 * w + c];
                u32x4 o; o.x = x[0] | ((unsigned)x[1] << 16); o.y = x[2] | ((unsigned)x[3] << 16); o.z = x[4] | ((unsigned)x[5] << 16); o.w = x[6] | ((unsigned)x[7] << 16);
                *(u32x4*)(vb + ((w * 2 + ks2) * 64 + F.lane) * 16) = o;
            }
        }
        __syncthreads();
    }
}

__device__ __forceinline__ int lp_rowoff(int a) { if (a == 0) return 0; const int A = a - 1, m = A >> 2, r = A & 3; return 8 * m * (m + 1) + 4 * r * (m + 1); }

__device__ __forceinline__ void p3g_invert(LAS float* Lp, int dir, int lane) {
    float T[64];
    const int j = lane;
#pragma unroll
    for (int t = 0; t < 64; ++t) {
        float a0 = 0.f, a1 = 0.f, a2 = 0.f, a3 = 0.f;
        const LAS float* lrow = Lp + lp_rowoff(t);
#pragma unroll
        for (int s4 = 0; s4 < (t + 3) / 4; ++s4) {
            const f32x4 l = *(const LAS f32x4*)(lrow + 4 * s4);
            if (4 * s4 + 0 < t) a0 += l[0] * T[4 * s4 + 0];
            if (4 * s4 + 1 < t) a1 += l[1] * T[4 * s4 + 1];
            if (4 * s4 + 2 < t) a2 += l[2] * T[4 * s4 + 2];
            if (4 * s4 + 3 < t) a3 += l[3] * T[4 * s4 + 3];
        }
        int jj = j; asm volatile("" : "+v"(jj));
        T[t] = (t == jj ? 1.f : 0.f) - ((a0 + a1) + (a2 + a3));
        asm volatile("" ::: "memory");
    }
    LAS bf16* Tb = (LAS bf16*)Lp;
    if (dir == 0) { LAS bf16* tp = Tb + j;
#pragma unroll
        for (int t = 0; t < 64; ++t) tp[t * 64] = (bf16)f2bf(T[t]);
    } else { LAS bf16* tp = Tb + (63 - j);
#pragma unroll
        for (int t = 0; t < 64; ++t) tp[(63 - t) * 64] = (bf16)f2bf(T[t]);
    }
}

__device__ __forceinline__ void p3g_load(Frame& F, int task, const bf16* BQ, const bf16* BK, const bf16* BV, const float* BETA, const float* GGp, u32x4 (&raw)[18], float& gbeta, float& ggate) {
    const int dir = task & 1, h = (task >> 1) & 3, cidx = task >> 3;
    int s, n; if (cidx < 64) { s = cidx >> 2; n = cidx & 3; } else { s = 16 + ((cidx - 64) >> 6); n = (cidx - 64) & 63; }
    const int i = F.tid >> 3, m = tok_b(s, n, i);
    int pos, len, dlt; if (s < 16) { pos = 64 * n + i; len = 256; dlt = 1; } else { pos = i; len = 64; dlt = 64; }
    const bool hasp = pos > 0, hasn = pos + 1 < len; const u32x4 zz = {0u, 0u, 0u, 0u};
#pragma unroll
    for (int a = 0; a < 3; ++a) {
        const bf16* src = (a == 0 ? BQ : (a == 1 ? BK : BV)) + (size_t)m * 512 + h * 128 + 16 * (F.tid & 7);
#pragma unroll
        for (int q = 0; q < 2; ++q) {
            raw[a * 6 + q * 3 + 0] = hasp ? *(const u32x4*)(src - (ptrdiff_t)dlt * 512 + 8 * q) : zz;
            raw[a * 6 + q * 3 + 1] = *(const u32x4*)(src + 8 * q);
            raw[a * 6 + q * 3 + 2] = hasn ? *(const u32x4*)(src + (ptrdiff_t)dlt * 512 + 8 * q) : zz;
        }
    }
    if (F.wave == 0) { const int mg = tok_b(s, n, F.lane); gbeta = BETA[(size_t)mg * 8 + dir * 4 + h]; ggate = GGp[(size_t)mg * 8 + dir * 4 + h]; }
}

__device__ __forceinline__ void p3_gdn(Frame& F) {
    constexpr int PITCH = 136, TP = 72, NBMAX = 10, LSLOT = 8448;
    LAS unsigned char* slots = F.lds + 40960;
    LAS float* Cs = (LAS float*)(F.lds + 512);
    LAS float* Bs = Cs + 64;
    LAS float* Es = Cs + 128;
    LAS float* Ets = Cs + 192;
    LAS float* Sc = Cs + 256;
    LAS bf16* Qb = (LAS bf16*)(F.lds + 2048);
    LAS bf16* Kb = (LAS bf16*)(F.lds + 19456);
    LAS bf16* VT = (LAS bf16*)(F.lds + 2048);
    LAS bf16* KGT = (LAS bf16*)(F.lds + 20480);
    LAS float* Wc = (LAS float*)(F.lds + 125952);
    int wc_head = -1;
    const bf16* BQ = WSP(bf16, WS_BQ); const bf16* BK = WSP(bf16, WS_BK); const bf16* BV = WSP(bf16, WS_BV);
    const float* BETA = WSP(float, WS_BETA); const float* GGp = WSP(float, WS_GG);
    const float* convw = F.in[I_CONV];
    const int ntask = (NUC - F.bid + F.G - 1) / F.G;
    for (int b0 = 0; b0 < ntask; b0 += NBMAX) {
      const int nb = ntask - b0 < NBMAX ? ntask - b0 : NBMAX;
      PROBE_BEGIN(51);
      u32x4 raw[18]; float gbeta = 0.f, ggate = 0.f;
#define P3G_LOAD(JT) p3g_load(F, F.bid + (b0 + (JT)) * F.G, BQ, BK, BV, BETA, GGp, raw, gbeta, ggate)
      P3G_LOAD(0);
      for (int jt = 0; jt < nb; ++jt) {
        const int task = F.bid + (b0 + jt) * F.G;
        const int dir = task & 1, h = (task >> 1) & 3, cidx = task >> 3;
        int s, n; if (cidx < 64) { s = cidx >> 2; n = cidx & 3; } else { s = 16 + ((cidx - 64) >> 6); n = (cidx - 64) & 63; }
        unsigned char* rec = grec_ptr(F, task);
        LAS float* Lp = (LAS float*)(slots + jt * LSLOT);
        if (h != wc_head) {
            __syncthreads();
            for (int idx = F.tid; idx < 1152; idx += NTHR) { const int a = idx / 384, r2 = idx % 384, tap = r2 >> 7, ch = r2 & 127; Wc[idx] = convw[tap * 1536 + a * 512 + h * 128 + ch]; }
            wc_head = h;
        }
        PROBE_BEGIN(54);
        if (F.wave == 0) {
            const float beta = gbeta;
            float c = ggate;
#pragma unroll
            for (int d = 1; d < 64; d <<= 1) { const float o = dir ? __shfl_down(c, d) : __shfl_up(c, d); const bool ok = dir ? (F.lane + d < 64) : (F.lane >= d); c += ok ? o : 0.f; }
            const float ctot = __shfl(c, dir ? 0 : 63);
            Cs[F.lane] = c; Bs[F.lane] = beta; Es[F.lane] = __expf(c); Ets[F.lane] = __expf(ctot - c);
            if (F.lane == 0) Sc[0] = __expf(ctot);
        }
        __syncthreads();
        PROBE_END(54); PROBE_BEGIN(55);
        {
            const int i = F.tid >> 3, seg = F.tid & 7, ch0 = 16 * seg;
            const float beta = Bs[i], kg = -beta * Es[i];
#pragma unroll
            for (int a = 0; a < 3; ++a) {
                float val[16];
                const LAS float* wc = Wc + a * 384 + ch0;
#pragma unroll
                for (int q = 0; q < 2; ++q) {
                    const u32x4 xm = raw[a * 6 + q * 3 + 0], x0 = raw[a * 6 + q * 3 + 1], xp = raw[a * 6 + q * 3 + 2];
                    f32x4 w0[2], w1[2], w2[2];
#pragma unroll
                    for (int hh = 0; hh < 2; ++hh) { w0[hh] = *(const LAS f32x4*)(wc + 8 * q + 4 * hh); w1[hh] = *(const LAS f32x4*)(wc + 128 + 8 * q + 4 * hh); w2[hh] = *(const LAS f32x4*)(wc + 256 + 8 * q + 4 * hh); }
#pragma unroll
                    for (int e = 0; e < 4; ++e) {
                        const int ch = 8 * q + 2 * e, hh = e >> 1, ee = 2 * (e & 1);
                        const float y0 = bflo(xm[e]) * w0[hh][ee] + bflo(x0[e]) * w1[hh][ee] + bflo(xp[e]) * w2[hh][ee];
                        const float y1 = bfhi(xm[e]) * w0[hh][ee + 1] + bfhi(x0[e]) * w1[hh][ee + 1] + bfhi(xp[e]) * w2[hh][ee + 1];
                        val[ch] = siluf(y0); val[ch + 1] = siluf(y1);
                    }
                }
                if (a < 2) {
                    float ss = 0.f;
#pragma unroll
                    for (int e = 0; e < 16; ++e) ss += val[e] * val[e];
                    ss += __shfl_xor(ss, 1); ss += __shfl_xor(ss, 2); ss += __shfl_xor(ss, 4);
                    const float rn = __builtin_amdgcn_rsqf(ss + EPS) * (a == 0 ? 0.08838834764831845f : 1.f);
                    unsigned pw[8];
#pragma unroll
                    for (int e = 0; e < 8; ++e) pw[e] = pk2(val[2 * e] * rn, val[2 * e + 1] * rn);
                    LAS bf16* dstp = (a == 0 ? Qb : Kb) + i * PITCH + ch0;
                    *(LAS u32x4*)(dstp) = (u32x4){pw[0], pw[1], pw[2], pw[3]}; *(LAS u32x4*)(dstp + 8) = (u32x4){pw[4], pw[5], pw[6], pw[7]};
                    if (a == 1) {
                        unsigned gw[8];
#pragma unroll
                        for (int e = 0; e < 8; ++e) gw[e] = pk2(kg * val[2 * e] * rn, kg * val[2 * e + 1] * rn);
                        u32x4* gp = (u32x4*)(rec + L_WN + (i * 128 + ch0) * 2);
                        gp[0] = (u32x4){gw[0], gw[1], gw[2], gw[3]}; gp[1] = (u32x4){gw[4], gw[5], gw[6], gw[7]};
                    }
                } else {
                    unsigned vw[8];
#pragma unroll
                    for (int e = 0; e < 8; ++e) vw[e] = pk2(beta * val[2 * e], beta * val[2 * e + 1]);
                    u32x4* vp = (u32x4*)(rec + L_U + (i * 128 + ch0) * 2);
                    vp[0] = (u32x4){vw[0], vw[1], vw[2], vw[3]}; vp[1] = (u32x4){vw[4], vw[5], vw[6], vw[7]};
                }
                asm volatile("" ::: "memory");
            }
            if (jt + 1 < nb) P3G_LOAD(jt + 1);
        }
        PROBE_END(55); PROBE_BEGIN(56);
        __syncthreads();
        {
            const int r = F.lane & 15, g = F.lane >> 4, tt = F.wave >> 1, sp = F.wave & 1;
            f32x4 a0 = {0.f, 0.f, 0.f, 0.f}, a1 = {0.f, 0.f, 0.f, 0.f};
#pragma unroll
            for (int kd = 0; kd < 4; ++kd) {
                const bf16x8 at = as_frag(*(const LAS u32x4*)(Kb + (16 * tt + r) * PITCH + 32 * kd + 8 * g));
                const bf16x8 b0 = as_frag(*(const LAS u32x4*)(Kb + (32 * sp + r) * PITCH + 32 * kd + 8 * g));
                const bf16x8 b1 = as_frag(*(const LAS u32x4*)(Kb + (32 * sp + 16 + r) * PITCH + 32 * kd + 8 * g));
                a0 = mfma16(at, b0, a0); a1 = mfma16(at, b1, a1);
            }
#pragma unroll
            for (int q = 0; q < 2; ++q)
#pragma unroll
                for (int i = 0; i < 4; ++i) {
                    const int t = 16 * tt + 4 * g + i, sx = 32 * sp + 16 * q + r;
                    const bool ok = dir ? (sx > t) : (sx < t);
                    if (ok) {
                        const float v = Bs[t] * (q ? a1[i] : a0[i]) * __expf(Cs[t] - Cs[sx]);
                        const int a = dir ? 63 - t : t, b = dir ? 63 - sx : sx;
                        Lp[lp_rowoff(a) + b] = v;
                    }
                }
        }
        write_at_image(F, Kb, Qb, PITCH, Cs, dir, rec + L_AT);
        write_qd_image(F, Qb, PITCH, Es, rec + L_QD);
        {
            const int r = F.lane & 15, g = F.lane >> 4, kt = F.wave;
#pragma unroll
            for (int ks2 = 0; ks2 < 2; ++ks2) {
                float v[8];
#pragma unroll
                for (int j = 0; j < 8; ++j) { const int sx = 32 * ks2 + kperm(g, j); v[j] = bf2f(Kb[sx * PITCH + 16 * kt + r]) * Ets[sx]; }
                u32x4 o; o.x = pk2(v[0], v[1]); o.y = pk2(v[2], v[3]); o.z = pk2(v[4], v[5]); o.w = pk2(v[6], v[7]);
                *(u32x4*)(rec + L_KT + ((kt * 2 + ks2) * 64 + F.lane) * 16) = o;
            }
        }
        if (F.tid == 0) *(float*)(rec + L_SC) = Sc[0];
        __syncthreads();
        PROBE_END(56);
      }
#undef P3G_LOAD
      PROBE_END(51); PROBE_BEGIN(52);
      asm volatile("s_waitcnt vmcnt(0)" ::: "memory");
      for (int jt = F.wave; jt < nb; jt += NWAVES) { const int task = F.bid + (b0 + jt) * F.G; p3g_invert((LAS float*)(slots + jt * LSLOT), task & 1, F.lane); }
      __syncthreads();
      PROBE_END(52); PROBE_BEGIN(53);
      u32x4 pv[2], pk[2];
      { unsigned char* rec0 = grec_ptr(F, F.bid + b0 * F.G);
#pragma unroll
        for (int q = 0; q < 2; ++q) { const int p = F.lane * 16 + F.wave + 8 * q; pv[q] = *(const u32x4*)(rec0 + L_U + p * 16); pk[q] = *(const u32x4*)(rec0 + L_WN + p * 16); } }
      for (int jt = 0; jt < nb; ++jt) {
        const int task = F.bid + (b0 + jt) * F.G;
        unsigned char* rec = grec_ptr(F, task);
        const LAS bf16* Tm = (const LAS bf16*)(slots + jt * LSLOT);
#pragma unroll
        for (int q = 0; q < 2; ++q) {
            const int i = F.lane, c8 = (F.wave + 8 * q) * 8;
            const u32x4 vv = pv[q], kk = pk[q];
            LAS bf16* vt = VT + c8 * TP + i; LAS bf16* kt = KGT + c8 * TP + i;
#pragma unroll
            for (int e = 0; e < 4; ++e) { vt[(2 * e) * TP] = (bf16)(vv[e] & 0xffffu); vt[(2 * e + 1) * TP] = (bf16)(vv[e] >> 16); kt[(2 * e) * TP] = (bf16)(kk[e] & 0xffffu); kt[(2 * e + 1) * TP] = (bf16)(kk[e] >> 16); }
        }
        if (jt + 1 < nb) { unsigned char* rec1 = grec_ptr(F, task + F.G);
#pragma unroll
            for (int q = 0; q < 2; ++q) { const int p = F.lane * 16 + F.wave + 8 * q; pv[q] = *(const u32x4*)(rec1 + L_U + p * 16); pk[q] = *(const u32x4*)(rec1 + L_WN + p * 16); } }
        __syncthreads();
        {
            const int r = F.lane & 15, g = F.lane >> 4;
            {
                const int w = F.wave;
                bf16x8 bv[2];
#pragma unroll
                for (int ks2 = 0; ks2 < 2; ++ks2) bv[ks2] = as_frag(*(const LAS u32x4*)(VT + (16 * w + r) * TP + 32 * ks2 + 8 * g));
#pragma unroll
                for (int mt = 0; mt < 4; ++mt) {
                    f32x4 a = {0.f, 0.f, 0.f, 0.f};
#pragma unroll
                    for (int ks2 = 0; ks2 < 2; ++ks2) a = mfma16(as_frag(*(const LAS u32x4*)(Tm + (16 * mt + r) * 64 + 32 * ks2 + 8 * g)), bv[ks2], a);
                    u32x2 o; o.x = pk2(a[0], a[1]); o.y = pk2(a[2], a[3]);
                    *(u32x2*)(rec + L_U + ((w * 4 + mt) * 64 + F.lane) * 8) = o;
                }
            }
            {
                const int mt = F.wave >> 1;
                bf16x8 bt[2];
#pragma unroll
                for (int ks2 = 0; ks2 < 2; ++ks2) bt[ks2] = as_frag(*(const LAS u32x4*)(Tm + (16 * mt + r) * 64 + 32 * ks2 + 8 * g));
#pragma unroll
                for (int q = 0; q < 2; ++q) {
                    const int ks = 2 * (F.wave & 1) + q;
                    f32x4 a0 = {0.f, 0.f, 0.f, 0.f}, a1 = {0.f, 0.f, 0.f, 0.f};
#pragma unroll
                    for (int ks2 = 0; ks2 < 2; ++ks2) {
                        a0 = mfma16(as_frag(*(const LAS u32x4*)(KGT + (32 * ks + r) * TP + 32 * ks2 + 8 * g)), bt[ks2], a0);
                        a1 = mfma16(as_frag(*(const LAS u32x4*)(KGT + (32 * ks + 16 + r) * TP + 32 * ks2 + 8 * g)), bt[ks2], a1);
                    }
                    u32x4 o; o.x = pk2(a0[0], a0[1]); o.y = pk2(a0[2], a0[3]); o.z = pk2(a1[0], a1[1]); o.w = pk2(a1[2], a1[3]);
                    *(u32x4*)(rec + L_WN + ((mt * 4 + ks) * 64 + F.lane) * 16) = o;
                }
            }
        }
        __syncthreads();
      }
      PROBE_END(53);
    }
}

template <bool GDN>
__device__ __forceinline__ void p4_chain(Frame& F) {
    LAS unsigned char* img = F.lds;
    const int c = F.lane & 15, g = F.lane >> 4;
    const float* st_in = F.in[GDN ? I_SG : I_SH];
    float* st_out = F.out + OUT_Y_FLOATS + (GDN ? STATE_FLOATS : 0);
    bf16* Obase = GDN ? WSP(bf16, WS_OB) : OUTB(bf16, OUT_OA);
    constexpr int N16 = GDN ? GREC / 16 : HREC / 16;
    constexpr int NPC = ((GDN ? GREC : HREC) + 1023) / 1024;
    gu32* prog = (gu32*)(F.ws + WS_CTL) + (GDN ? CW_PROG_G : CW_PROG_H);
    const bool roles = (F.G == 256);
    if (roles && F.bid >= 64 && F.bid < 128) {
        const int hb = F.bid - 64, u = hb & 31, j0 = hb >> 5;
        const int s = 16 + (u >> 3), h = (u >> 1) & 3, dir = u & 1, N = 64;
        u32x4 dummy = {0u, 0u, 0u, 0u};
        for (int st = j0; st < N; st += 2) {
            for (unsigned sp = 0; sp < (1u << 15); ++sp) { const unsigned p = __hip_atomic_load(prog + 64 * u, RLX_AGENT); if ((int)p + P4_PD > st) break; __builtin_amdgcn_s_sleep(8); }
            const int n = dir ? N - 1 - st : st; const int uc = uc_index(s, n, h, dir);
            const unsigned char* rec = GDN ? grec_ptr(F, uc) : hrec_ptr(F, uc);
            for (int idx = F.tid; idx < N16; idx += NTHR) { const unsigned char* p = rec + (size_t)idx * 16; asm volatile("global_load_dwordx4 %0, %1, off" : "+v"(dummy) : "v"(p) : "memory"); }
            if (!GDN) { const unsigned char* vb = F.ws + WS_HVB + (size_t)(uc >> 1) * 16384;
                for (int idx = F.tid; idx < 1024; idx += NTHR) { const unsigned char* p = vb + (size_t)idx * 16; asm volatile("global_load_dwordx4 %0, %1, off" : "+v"(dummy) : "v"(p) : "memory"); } }
        }
        asm volatile("s_waitcnt vmcnt(0)" : "+v"(dummy) :: "memory");
        return;
    }
    for (int uidx0 = F.bid; uidx0 < (roles ? 256 : 160); uidx0 += F.G) {
        int uidx = uidx0, ncw = 8, sl0 = 0;
        if (roles) { if (uidx0 >= 128) uidx = uidx0 - 96; else { uidx = uidx0 & 31; ncw = 4; sl0 = 4 * (uidx0 >> 5); } }
        const bool lead = roles && uidx0 < 32;
        const int w = sl0 + F.wave; const bool comp = F.wave < ncw;
        const int dwn = ncw < 8 ? 8 - ncw : 8, dw0 = ncw < 8 ? F.wave - ncw : F.wave;
        int s, h, dir;
        if (uidx < 32) { s = 16 + (uidx >> 3); h = (uidx >> 1) & 3; dir = uidx & 1; } else { const int j = uidx - 32; s = j >> 3; h = (j >> 1) & 3; dir = j & 1; }
        const int N = seq_nchunk(s), bq = s < 16 ? s : s - 16;
        f32x4 S[8];
        if (!comp) {
#pragma unroll
            for (int kt = 0; kt < 8; ++kt) S[kt] = (f32x4){0.f, 0.f, 0.f, 0.f};
        } else if (s >= 16) {
            const float* sp = st_in + (size_t)((bq * 2 + dir) * 4 + h) * 16384 + 16 * w + c;
#pragma unroll
            for (int kt = 0; kt < 8; ++kt)
#pragma unroll
                for (int i = 0; i < 4; ++i) S[kt][i] = sp[(16 * kt + 4 * g + i) * 128];
        } else {
#pragma unroll
            for (int kt = 0; kt < 8; ++kt) S[kt] = (f32x4){0.f, 0.f, 0.f, 0.f};
        }
#define P4_DMA(STEP, BUF) do { \
            const int n_ = dir ? N - 1 - (STEP) : (STEP); const int uc_ = uc_index(s, n_, h, dir); \
            const unsigned char* rec_ = (GDN ? grec_ptr(F, uc_) : hrec_ptr(F, uc_)) + F.lane * 16; \
            LAS unsigned char* dst_ = F.lds + (BUF) * P4_BUF + (GDN ? 0 : L_QD); \
            for (int p = dw0; p < NPC; p += dwn) __builtin_amdgcn_global_load_lds((const unsigned*)(rec_ + (size_t)p * 1024), (LAS unsigned*)(dst_ + p * 1024), 16, 0, 0); \
            if (!GDN) { const unsigned char* vb_ = F.ws + WS_HVB + (size_t)(uc_ >> 1) * 16384 + F.lane * 16; LAS unsigned char* dv_ = F.lds + (BUF) * P4_BUF + L_WN; \
                for (int p = dw0; p < 16; p += dwn) __builtin_amdgcn_global_load_lds((const unsigned*)(vb_ + (size_t)p * 1024), (LAS unsigned*)(dv_ + p * 1024), 16, 0, 0); } \
        } while (0)
#define FRAG(off, idx) (*(const LAS u32x4*)(img + (off) + ((idx) * 64 + F.lane) * 16))
        if (dw0 >= 0) P4_DMA(0, 0);
        asm volatile("s_waitcnt vmcnt(0)" ::: "memory");
        __syncthreads();
        for (int step = 0; step < N; ++step) {
            PROBE_BEGIN(GDN ? 2 : 12);
            const int cur = step & 1;
            LAS unsigned char* img = F.lds + cur * P4_BUF;
            if (lead && F.tid == 0) __hip_atomic_store(prog + 64 * uidx, (unsigned)(step + 1), RLX_AGENT);
            PROBE_BEGIN(GDN ? 21 : 31);
            if (step + 1 < N && dw0 >= 0) P4_DMA(step + 1, cur ^ 1);
            PROBE_END(GDN ? 21 : 31);
            const int n = dir ? N - 1 - step : step;
            if (comp) {
            PROBE_BEGIN(GDN ? 22 : 32);
            bf16x8 Sb[4];
#pragma unroll
            for (int ks = 0; ks < 4; ++ks) { u32x4 o; o.x = pk2(S[2 * ks][0], S[2 * ks][1]); o.y = pk2(S[2 * ks][2], S[2 * ks][3]); o.z = pk2(S[2 * ks + 1][0], S[2 * ks + 1][1]); o.w = pk2(S[2 * ks + 1][2], S[2 * ks + 1][3]); Sb[ks] = as_frag(o); }
            bf16x8 Xb[2];
            u32x4 fa[8], fb[8];
            f32x4 O[4];
            if (GDN) {
                f32x4 X[4];
#pragma unroll
                for (int mt = 0; mt < 4; ++mt)
#pragma unroll
                    for (int k = 0; k < 2; ++k) fa[mt * 2 + k] = FRAG(L_WN, mt * 4 + k);
#pragma unroll
                for (int mt = 0; mt < 4; ++mt)
#pragma unroll
                    for (int k = 0; k < 2; ++k) fb[mt * 2 + k] = FRAG(L_WN, mt * 4 + 2 + k);
#pragma unroll
                for (int mt = 0; mt < 4; ++mt) { const u32x2 uu = *(const LAS u32x2*)(img + L_U + ((w * 4 + mt) * 64 + F.lane) * 8); X[mt] = (f32x4){bflo(uu.x), bfhi(uu.x), bflo(uu.y), bfhi(uu.y)}; }
#pragma unroll
                for (int k = 0; k < 2; ++k)
#pragma unroll
                    for (int mt = 0; mt < 4; ++mt) X[mt] = mfma16(as_frag(fa[mt * 2 + k]), Sb[k], X[mt]);
#pragma unroll
                for (int mt = 0; mt < 4; ++mt)
#pragma unroll
                    for (int k = 0; k < 2; ++k) fa[mt * 2 + k] = FRAG(L_QD, mt * 4 + k);
#pragma unroll
                for (int k = 0; k < 2; ++k)
#pragma unroll
                    for (int mt = 0; mt < 4; ++mt) X[mt] = mfma16(as_frag(fb[mt * 2 + k]), Sb[2 + k], X[mt]);
#pragma unroll
                for (int k2 = 0; k2 < 2; ++k2) { u32x4 o; o.x = pk2(X[2 * k2][0], X[2 * k2][1]); o.y = pk2(X[2 * k2][2], X[2 * k2][3]); o.z = pk2(X[2 * k2 + 1][0], X[2 * k2 + 1][1]); o.w = pk2(X[2 * k2 + 1][2], X[2 * k2 + 1][3]); Xb[k2] = as_frag(o); }
            } else {
#pragma unroll
                for (int k2 = 0; k2 < 2; ++k2) Xb[k2] = as_frag(FRAG(L_WN, w * 2 + k2));
#pragma unroll
                for (int mt = 0; mt < 4; ++mt)
#pragma unroll
                    for (int k = 0; k < 2; ++k) fa[mt * 2 + k] = FRAG(L_QD, mt * 4 + k);
            }
            PROBE_END(GDN ? 22 : 32); PROBE_BEGIN(GDN ? 23 : 33);
#pragma unroll
            for (int mt = 0; mt < 4; ++mt)
#pragma unroll
                for (int k = 0; k < 2; ++k) fb[mt * 2 + k] = FRAG(L_QD, mt * 4 + 2 + k);
#pragma unroll
            for (int mt = 0; mt < 4; ++mt) O[mt] = (f32x4){0.f, 0.f, 0.f, 0.f};
#pragma unroll
            for (int k = 0; k < 2; ++k)
#pragma unroll
                for (int mt = 0; mt < 4; ++mt) O[mt] = mfma16(Sb[k], as_frag(fa[mt * 2 + k]), O[mt]);
#pragma unroll
            for (int i = 0; i < 8; ++i) fa[i] = FRAG(L_AT, i);
#pragma unroll
            for (int k = 0; k < 2; ++k)
#pragma unroll
                for (int mt = 0; mt < 4; ++mt) O[mt] = mfma16(Sb[2 + k], as_frag(fb[mt * 2 + k]), O[mt]);
#pragma unroll
            for (int i = 0; i < 8; ++i) fb[i] = FRAG(L_KT, i);
#pragma unroll
            for (int k2 = 0; k2 < 2; ++k2)
#pragma unroll
                for (int mt = 0; mt < 4; ++mt) O[mt] = mfma16(Xb[k2], as_frag(fa[mt * 2 + k2]), O[mt]);
#pragma unroll
            for (int i = 0; i < 8; ++i) fa[i] = FRAG(L_KT, 8 + i);
            PROBE_END(GDN ? 23 : 33); PROBE_BEGIN(GDN ? 24 : 34);
            {
                f32x4 d[8];
                if (GDN) { const float ds = *(const LAS float*)(img + L_SC);
#pragma unroll
                    for (int kt = 0; kt < 8; ++kt) d[kt] = (f32x4){ds, ds, ds, ds}; }
                else {
#pragma unroll
                    for (int kt = 0; kt < 8; ++kt) d[kt] = *(const LAS f32x4*)(img + L_U + (16 * kt + 4 * g) * 4); }
#pragma unroll
                for (int kt = 0; kt < 8; ++kt) S[kt] = S[kt] * d[kt];
            }
#pragma unroll
            for (int k2 = 0; k2 < 2; ++k2)
#pragma unroll
                for (int kt = 0; kt < 4; ++kt) S[kt] = mfma16(as_frag(fb[kt * 2 + k2]), Xb[k2], S[kt]);
#pragma unroll
            for (int k2 = 0; k2 < 2; ++k2)
#pragma unroll
                for (int kt = 0; kt < 4; ++kt) S[4 + kt] = mfma16(as_frag(fa[kt * 2 + k2]), Xb[k2], S[4 + kt]);
            PROBE_END(GDN ? 24 : 34); PROBE_BEGIN(GDN ? 25 : 35);
#pragma unroll
            for (int mt = 0; mt < 4; ++mt) {
                const int li = 16 * mt + c;
                const int m = GDN ? tok_b(s, n, li) : tok_a(s, n, li);
                u32x2 o; o.x = pk2(O[mt][0], O[mt][1]); o.y = pk2(O[mt][2], O[mt][3]);
                *(u32x2*)(Obase + (size_t)dir * (10 * MiB) + (size_t)m * 512 + h * 128 + 16 * w + 4 * g) = o;
            }
            PROBE_END(GDN ? 25 : 35);
            }
            PROBE_END(GDN ? 2 : 12); PROBE_BEGIN(GDN ? 3 : 13);
            asm volatile("s_waitcnt vmcnt(0)" ::: "memory");
            __syncthreads();
            PROBE_END(GDN ? 3 : 13);
        }
#undef P4_DMA
#undef FRAG
        if (s < 16 && comp) {
            float* sp = st_out + (size_t)((bq * 2 + dir) * 4 + h) * 16384 + 16 * w + c;
#pragma unroll
            for (int kt = 0; kt < 8; ++kt)
#pragma unroll
                for (int i = 0; i < 4; ++i) sp[(16 * kt + 4 * g + i) * 128] = S[kt][i];
        }
    }
}

constexpr int NPHASE = 13;
__global__ void __launch_bounds__(NTHR, 2) mk_fwd(Args args) {
    extern __shared__ __attribute__((aligned(16))) unsigned char lds_raw[];
    Frame F;
    F.lds = (LAS unsigned char*)lds_raw;
    F.tid = threadIdx.x; F.lane = F.tid & 63; F.wave = __builtin_amdgcn_readfirstlane(F.tid >> 6);
    F.bid = blockIdx.x; F.G = gridDim.x;
#pragma unroll
    for (int i = 0; i < N_IN; ++i) F.in[i] = args.in[i];
    F.out = args.out; F.ws = args.ws; F.pacc = 0ull; F.pt0 = 0ull;
    volatile LAS unsigned* MISC = (volatile LAS unsigned*)(F.lds + MISC_OFF);
    for (int u = F.tid; u < (LDS_BYTES - LDSCTL_OFF) / 4; u += NTHR) ((LAS unsigned*)(F.lds + LDSCTL_OFF))[u] = 0u;
    __syncthreads();
    const int lo = args.ph_lo, hi = args.ph_hi;
    const bool multi = (hi - lo) > 1;
    XcdBarrier bar; bar.bar = (unsigned*)(F.ws + WS_CTL) + CW_BAR; bar.x = 0; bar.st = nullptr;
    if (multi) bar = xcd_barrier_post((unsigned*)(F.ws + WS_CTL) + CW_BAR, MISC + 8);
#ifndef PH_MASK
#define PH_MASK 0x1fff
#endif
#define IN(k) (((PH_MASK >> (k)) & 1) && lo <= (k) && (k) < hi)
#define SEAM(k) do { if (IN(k) && IN((k) + 1)) xcd_barrier(bar); } while (0)
#define NREP(k) ((((REP_MASK) >> (k)) & 1) ? 2 : 1)
#define REPSYNC(k) do { if (((REP_MASK) >> (k)) & 1) xcd_barrier(bar); } while (0)

    PROBE_BEGIN(100);
    if (IN(0)) for (int rep = 0; rep < NREP(0); ++rep) { if (rep) REPSYNC(0); p0_prologue(F); } SEAM(0); PROBE_END(100);
    PROBE_BEGIN(101);
    if (IN(1)) for (int rep = 0; rep < NREP(1); ++rep) { if (rep) REPSYNC(1); modnorm_rows(F, F.in[I_XP], F.in[I_XS], F.in[I_N1], 0, 1024, WSP(bf16, WS_H)); } SEAM(1); PROBE_END(101);
    PROBE_BEGIN(102);
    if (IN(2)) for (int rep = 0; rep < NREP(2); ++rep) { if (rep) REPSYNC(2);
        pg8::Gemm g{WSP(bf16, WS_H), WSP(bf16, WS_WIN), NT, NPAD, DM}; pg8::StaticOrder S; S.init(NT, NPAD, F.G, F.bid);
        pg8::EpiProj E;
        E.d0 = OUTB(bf16, OUT_QA); E.d1 = OUTB(bf16, OUT_GF); E.d2 = OUTB(bf16, OUT_GB); E.d3 = OUTB(bf16, OUT_VA); E.d4 = WSP(bf16, WS_AG);
        E.d5 = WSP(bf16, WS_BQ); E.d6 = WSP(bf16, WS_BK); E.d7 = WSP(bf16, WS_BV); E.d8 = WSP(bf16, WS_BZ);
        E.BETA = WSP(float, WS_BETA); E.GG = WSP(float, WS_GG); E.lbraw = F.in[I_LB]; E.Alog = F.in[I_ALOG]; E.dtb = F.in[I_DTB];
        pg8::gemm_phase<pg8::EpiProj, pg8::StaticOrder, true, true>(F.lds, g, S, E);
    } SEAM(2); PROBE_END(102);
    PROBE_BEGIN(103);
    if (IN(3)) for (int rep = 0; rep < NREP(3); ++rep) { if (rep) REPSYNC(3); p3_hgrn(F); } SEAM(3); PROBE_END(103);
    PROBE_BEGIN(104);
    if (IN(4)) for (int rep = 0; rep < NREP(4); ++rep) { if (rep) REPSYNC(4); p4_chain<false>(F); } SEAM(4); PROBE_END(104);
    PROBE_BEGIN(105);
    if (IN(5)) for (int rep = 0; rep < NREP(5); ++rep) { if (rep) REPSYNC(5); p3_gdn(F); } SEAM(5); PROBE_END(105);
    PROBE_BEGIN(106);
    if (IN(6)) for (int rep = 0; rep < NREP(6); ++rep) { if (rep) REPSYNC(6); p4_chain<true>(F); } SEAM(6); PROBE_END(106);
    PROBE_BEGIN(107);
    if (IN(7)) for (int rep = 0; rep < NREP(7); ++rep) { if (rep) REPSYNC(7); p5_headnorm(F); } SEAM(7); PROBE_END(107);
    PROBE_BEGIN(108);
    if (IN(8)) for (int rep = 0; rep < NREP(8); ++rep) { if (rep) REPSYNC(8);
        pg8::Gemm g{WSP(bf16, WS_YIN), WSP(bf16, WS_WOUT), NT, DM, DM}; pg8::StaticOrder S; S.init(NT, DM, F.G, F.bid);
        pg8::EpiRes E{F.in[I_XP], F.in[I_XS], F.out, WSP(float, WS_MOD), 2048};
        pg8::gemm_phase<pg8::EpiRes, pg8::StaticOrder, true, true>(F.lds, g, S, E);
    } SEAM(8); PROBE_END(108);
    PROBE_BEGIN(109);
    if (IN(9)) for (int rep = 0; rep < NREP(9); ++rep) { if (rep) REPSYNC(9); modnorm_rows(F, F.out, F.out + (size_t)NCTX * DM, F.in[I_N2], 3072, 4096, WSP(bf16, WS_H2)); } SEAM(9); PROBE_END(109);
    PROBE_BEGIN(110);
    if (IN(10)) for (int rep = 0; rep < NREP(10); ++rep) { if (rep) REPSYNC(10);
        pg8::Gemm g{WSP(bf16, WS_H2), WSP(bf16, WS_WGU), NT, 2 * DFF, DM}; pg8::StaticOrder S; S.init(NT, 2 * DFF, F.G, F.bid);
        pg8::EpiGU E{WSP(bf16, WS_GU)};
        pg8::gemm_phase<pg8::EpiGU, pg8::StaticOrder, true, true>(F.lds, g, S, E);
    } SEAM(10); PROBE_END(110);
    PROBE_BEGIN(111);
    if (IN(11)) for (int rep = 0; rep < NREP(11); ++rep) { if (rep) REPSYNC(11);
        pg8::Gemm g{WSP(bf16, WS_GU), WSP(bf16, WS_WDN), NT, DM, DFF}; pg8::StaticOrder S; S.init(NT, DM, F.G, F.bid);
        pg8::EpiRes E{F.out, F.out + (size_t)NCTX * DM, F.out, WSP(float, WS_MOD), 5120};
        pg8::gemm_phase<pg8::EpiRes, pg8::StaticOrder, true, true>(F.lds, g, S, E);
    } SEAM(11); PROBE_END(111);
    PROBE_BEGIN(112);
    if (IN(12)) for (int rep = 0; rep < NREP(12); ++rep) { if (rep) REPSYNC(12); final_norm(F); }
    PROBE_END(112);
    if (PROBE_ID != 0 && blockIdx.x == 0 && threadIdx.x == 0) { const unsigned long long t0 = __builtin_amdgcn_s_memrealtime(), dt = F.pacc * PROBE_K; while (__builtin_amdgcn_s_memrealtime() - t0 < dt) __builtin_amdgcn_s_sleep(16); }
#undef IN
#undef SEAM
}

extern "C" void kernel_launch(void* const* d_in, const int* in_sizes, int n_in, void* d_out, int out_size, void* d_ws, size_t ws_size, hipStream_t stream) {
    static int grid = 0;
    if (grid == 0) {
        if (n_in != N_IN || ws_size < WS_END) { fprintf(stderr, "kernel_launch: unexpected n_in %d / ws %zu\n", n_in, ws_size); grid = -1; return; }
        int dev = 0, cus = 0;
        if (hipGetDevice(&dev) != hipSuccess || hipDeviceGetAttribute(&cus, hipDeviceAttributeMultiprocessorCount, dev) != hipSuccess) { grid = -1; return; }
        if (hipFuncSetAttribute((const void*)mk_fwd, hipFuncAttributeMaxDynamicSharedMemorySize, LDS_BYTES) != hipSuccess) { fprintf(stderr, "kernel_launch: hipFuncSetAttribute failed\n"); grid = -1; return; }
        int per_cu = 0;
        if (hipOccupancyMaxActiveBlocksPerMultiprocessor(&per_cu, (const void*)mk_fwd, NTHR, LDS_BYTES) != hipSuccess || per_cu < 1) { fprintf(stderr, "kernel_launch: occupancy query reports %d\n", per_cu); }
        (void)hipGetLastError();
        grid = cus;
    }
    if (grid < 0) return;
    (void)hipMemsetAsync((char*)d_ws + WS_CTL, 0, CTL_ZERO_BYTES, stream);
    Args a{};
    for (int i = 0; i < N_IN; ++i) a.in[i] = (const float*)d_in[i];
    a.out = (float*)d_out; a.ws = (unsigned char*)d_ws;
#if MK_ONE_LAUNCH
    a.ph_lo = 0; a.ph_hi = NPHASE;
    hipLaunchKernelGGL(mk_fwd, dim3(grid), dim3(NTHR), LDS_BYTES, stream, a);
#else
    for (int k = 0; k < NPHASE; ++k) { a.ph_lo = k; a.ph_hi = k + 1; hipLaunchKernelGGL(mk_fwd, dim3(grid), dim3(NTHR), LDS_BYTES, stream, a); }
#endif
}
```

```cpp
#include <hip/hip_runtime.h>
#include <cstdio>
#include <cstdint>

#ifndef REP_MASK
#define REP_MASK 0x0
#endif
#ifndef PROBE_ID
#define PROBE_ID 0
#endif
#define PROBE_K 1
#ifndef PROBE_BLK
#define PROBE_BLK 0
#endif
#ifndef MK_ONE_LAUNCH
#define MK_ONE_LAUNCH 1
#endif

#define LAS __attribute__((address_space(3)))
#define GAS __attribute__((address_space(1)))
typedef unsigned short bf16;
typedef short bf16x8 __attribute__((ext_vector_type(8)));
typedef float f32x4 __attribute__((ext_vector_type(4)));
typedef float f32x2 __attribute__((ext_vector_type(2)));
typedef unsigned u32x4 __attribute__((ext_vector_type(4)));
typedef unsigned u32x2 __attribute__((ext_vector_type(2)));
typedef GAS unsigned gu32;

constexpr int NT = 20480, NCTX = 4096, DM = 1024, DPROJ = 4624, NPAD = 4864, DFF = 2816, NSEQ = 20;
constexpr float EPS = 1e-6f;
constexpr int NWAVES = 8, NTHR = 512;
enum { I_XP = 0, I_XS, I_C, I_SH, I_SG, I_CCTX, I_WADA, I_BADA, I_N1, I_N2, I_WIN, I_CONV, I_LB, I_ALOG, I_DTB, I_HNORM, I_GNORM, I_WOUT, I_WGATE, I_WUP, I_WDOWN, I_NF, N_IN };

constexpr size_t MiB = 1u << 20;
constexpr size_t WS_CTL = 0, CTL_ZERO_BYTES = 2 * MiB;
constexpr size_t WS_MOD = 1 * MiB;
constexpr size_t WS_BETA = 2 * MiB, WS_GG = 3 * MiB;
constexpr size_t WS_BQ = 4 * MiB, WS_BK = 24 * MiB, WS_BV = 44 * MiB;
constexpr size_t WS_OB = 4 * MiB;
constexpr size_t WS_AG = 64 * MiB, WS_BZ = 84 * MiB;
constexpr size_t WS_I = 104 * MiB;
constexpr size_t WS_H = 104 * MiB;
constexpr size_t WS_WIN = 144 * MiB;
constexpr size_t WS_YIN = 104 * MiB;
constexpr size_t WS_WOUT = 44 * MiB, WS_WGU = 46 * MiB, WS_WDN = 57 * MiB;
constexpr size_t WS_H2 = 4 * MiB;
constexpr size_t WS_GU = 64 * MiB;
constexpr size_t WS_SLAB = 160 * MiB;
constexpr size_t WS_END = 256 * MiB;
constexpr size_t OUT_QA = 0, OUT_VA = 20 * MiB, OUT_GF = 40 * MiB, OUT_GB = 60 * MiB, OUT_OA = 0, OUT_GOVF = 40 * MiB;
constexpr size_t OUT_Y_FLOATS = (size_t)NT * DM, STATE_FLOATS = (size_t)16 * 2 * 4 * 128 * 128;
constexpr int HREC = 41472;
constexpr int GREC = 73984;
constexpr int NUC = 2560, NVB = 1280;
constexpr size_t WS_HVB = WS_I + (size_t)NUC * HREC;
constexpr int N1G = 2154;
static_assert((size_t)N1G * GREC <= 152 * MiB && (size_t)(NUC - N1G) * GREC <= 40 * MiB, "GDN image split");
constexpr int NR_EARLY = 768;
static_assert(WS_I + (size_t)(NUC - NR_EARLY) * GREC >= WS_I + (size_t)NUC * HREC + (size_t)NVB * 16384, "early GDN records must not touch the HGRN images");
static_assert(WS_HVB + (size_t)NVB * 16384 <= WS_END, "HGRN images fit");
constexpr int L_WN = 0, L_QD = 16384, L_AT = 32768, L_KT = 40960, L_U = 57344, L_SC = 73728;

constexpr int CW_BAR = 4096;
constexpr int CW_PROG_H = 16384, CW_PROG_G = 16384 + 64 * 32;
constexpr int P4_PD = 4;
constexpr int CW_SPLIT6 = 32768, CW_SPLIT9 = 32768 + 64 * 64;
constexpr int P4_BUF = 74752;
constexpr int RING_BYTES = 2 * P4_BUF, LDSCTL_OFF = RING_BYTES, MISC_OFF = LDSCTL_OFF + 320, LDS_BYTES = RING_BYTES + 1024;
static_assert(RING_BYTES >= 131072 && LDS_BYTES <= 163840, "LDS map");

#define PROBE_BEGIN(id) do { if (PROBE_ID == (id) && blockIdx.x == PROBE_BLK && threadIdx.x == 0) probe_t0 = __builtin_amdgcn_s_memrealtime(); } while (0)
#define PROBE_END(id) do { if (PROBE_ID == (id) && blockIdx.x == PROBE_BLK && threadIdx.x == 0) probe_acc += __builtin_amdgcn_s_memrealtime() - probe_t0; } while (0)
#define LDS_WAIT() asm volatile("s_waitcnt lgkmcnt(0)" ::: "memory")
#define VM_WAIT() asm volatile("s_waitcnt vmcnt(0)" ::: "memory")
#define RLX_AGENT __ATOMIC_RELAXED, __HIP_MEMORY_SCOPE_AGENT
__device__ __forceinline__ unsigned f2bf(float f) { unsigned u = __builtin_bit_cast(unsigned, f); return (u + 0x7fffu + ((u >> 16) & 1u)) >> 16; }
__device__ __forceinline__ unsigned pk2(float lo, float hi) { return f2bf(lo) | (f2bf(hi) << 16); }
__device__ __forceinline__ float bflo(unsigned w) { return __builtin_bit_cast(float, w << 16); }
__device__ __forceinline__ float bfhi(unsigned w) { return __builtin_bit_cast(float, w & 0xffff0000u); }
__device__ __forceinline__ float bf2f(unsigned short h) { return __builtin_bit_cast(float, (unsigned)h << 16); }
__device__ __forceinline__ float siluf(float x) { return x * __builtin_amdgcn_rcpf(1.f + __expf(-x)); }
__device__ __forceinline__ float sigmf(float x) { return __builtin_amdgcn_rcpf(1.f + __expf(-x)); }
__device__ __forceinline__ f32x4 mfma16(bf16x8 a, bf16x8 b, f32x4 c) { return __builtin_amdgcn_mfma_f32_16x16x32_bf16(a, b, c, 0, 0, 0); }
__device__ __forceinline__ bf16x8 as_frag(u32x4 v) { return __builtin_bit_cast(bf16x8, v); }
__device__ __forceinline__ float wave_sum(float v) {
#pragma unroll
    for (int o = 1; o < 64; o <<= 1) v += __shfl_xor(v, o);
    return v;
}
__device__ __forceinline__ int seq_base(int s) { return s < 16 ? s * 256 : NCTX + (s - 16) * 4096; }
__device__ __forceinline__ int seq_nchunk(int s) { return s < 16 ? 4 : 64; }
__device__ __forceinline__ int chunk_base(int s) { return s < 16 ? 4 * s : 64 + 64 * (s - 16); }
__device__ __forceinline__ int tok_a(int s, int n, int i) { return seq_base(s) + 64 * n + i; }
__device__ __forceinline__ int tok_b(int s, int n, int i) { return s < 16 ? s * 256 + 64 * n + i : NCTX + (s - 16) * 4096 + 64 * i + n; }
__device__ __forceinline__ int kperm(int g, int j) { return 16 * (j >> 2) + 4 * g + (j & 3); }

namespace pg8 {
#define PG8_LAS __attribute__((address_space(3)))
typedef unsigned short bf16_t;
typedef short bf16x8 __attribute__((ext_vector_type(8)));
typedef float f32x4 __attribute__((ext_vector_type(4)));
typedef unsigned u32x4 __attribute__((ext_vector_type(4)));
constexpr int BM = 256, BK = 64, HALF = 128, HTB = HALF * BK * 2  , STAGE_BYTES = 8 * HTB, NXCD = 8, WGM = 8;

__host__ __device__ __forceinline__ int lds_byte(int r, int c) { const int st = (r >> 4) * 2 + (c >> 5), rr = r & 15, cc = c & 31, ob = rr * 64 + cc * 2; return st * 1024 + (ob ^ (((ob >> 9) & 1) << 5)); }
__host__ __device__ __forceinline__ void stage_rc(int b, int& R, int& C) { const int st = b / 1024, sb = b % 1024, swz = sb ^ (((sb >> 9) & 1) << 5); R = (st >> 1) * 16 + swz / 64; C = (st & 1) * 32 + (swz % 64) / 2; }
__host__ __device__ __forceinline__ int perm32(int rho) { const int n = rho >> 4, i = rho & 15; return 8 * (i >> 2) + 4 * n + (i & 3); }

struct Unit { int pm, pn, k0, nt, ns, su, sl; };
struct Gemm { const bf16_t* A; const bf16_t* Bt; int M, N, K; };

struct StaticOrder {
    int nM, nN, nwg, G, c, K;
    __host__ __device__ void init(int M, int N, int K_, int G_, int c_) { nM = M / BM; nN = N / BM; nwg = nM * nN; G = G_; c = c_; K = K_; }
    __host__ __device__ bool next(int i, Unit& u) const {
        const long L = (long)i * G + c; if (L >= nwg) return false;
        int wgid = (int)L; { const int q = nwg / NXCD, r = nwg % NXCD, xcd = wgid % NXCD, off = wgid / NXCD; wgid = (xcd < r ? xcd * (q + 1) : r * (q + 1) + (xcd - r) * q) + off; }
        const int nig = WGM * nN, gid = wgid / nig, fm = gid * WGM, gsz = (nM - fm) < WGM ? (nM - fm) : WGM;
        u.pm = fm + ((wgid % nig) % gsz); u.pn = (wgid % nig) / gsz; u.k0 = 0; u.nt = K / BK; u.ns = 1; u.su = 0; u.sl = 0; return true;
    }
    __device__ __forceinline__ void a_ready(const Unit&) const {}
    __device__ __forceinline__ void done(const Unit&) const {}
};

struct SplitOrder {
    StaticOrder so; bool split;
    __host__ __device__ void init(int M, int N, int K_, int G_, int c_) { so.init(M, N, K_, G_, c_); split = false && (G_ == 256 && so.nwg == 320); }
    __host__ __device__ bool next(int i, Unit& u) const {
        if (!split) return so.next(i, u);
        if (i == 0) return so.next(0, u);
        if (i > 1) return false;
        StaticOrder t = so; t.c = 256 + (so.c >> 2); t.G = 1 << 20; if (!t.next(0, u)) return false;
        const int ntt = so.K / BK, sl = so.c & 3, q = ((ntt / 4) + 1) & ~1;
        const int big = (ntt - 4 * (q - 2)) / 2;
        const int t0 = sl < big ? sl * q : big * q + (sl - big) * (q - 2), tn = sl < big ? q : q - 2;
        u.k0 = t0 * BK; u.nt = tn; u.ns = 4; u.su = so.c >> 2; u.sl = sl; return true;
    }
    __device__ __forceinline__ void a_ready(const Unit&) const {}
    __device__ __forceinline__ void done(const Unit&) const {}
};

__device__ __forceinline__ unsigned pkbf(float lo, float hi) { return ::pk2(lo, hi); }

struct EpiProj {
    static constexpr bool PERM = true, AFTER_DRAIN = false;
    bf16_t *d0, *d1, *d2, *d3, *d4, *d5, *d6, *d7, *d8;
    float* BETA; float* GG;
    const float* lbraw;
    const float* Alog; const float* dtb;
    __device__ __forceinline__ void operator()(const f32x4 (&acc)[2][2][4][2], const Unit& u, int wr, int wc, int fr, int fq) const {
        const int pn = u.pn, row0 = u.pm * BM + wr * 64 + fr;
        if (pn < 18) {
            const int seg = pn >> 1;
            bf16_t* base = seg == 0 ? d0 : seg == 1 ? d1 : seg == 2 ? d2 : seg == 3 ? d3 : seg == 4 ? d4 : seg == 5 ? d5 : seg == 6 ? d6 : seg == 7 ? d7 : d8;
            const int mode = (seg == 0 || seg == 4 || seg == 8) ? 1 : ((seg == 1 || seg == 2) ? 2 : 0);
#pragma unroll
            for (int bj = 0; bj < 2; ++bj) {
                const int c0 = (pn & 1) * 256 + bj * HALF + wc * 32 + 8 * fq;
                float lb[8];
                if (mode == 2) {
                    const int dir = seg - 1;
#pragma unroll
                    for (int e = 0; e < 8; ++e) { const float x0 = lbraw[dir * 512 + c0 + e], x1 = lbraw[1024 + dir * 512 + c0 + e]; lb[e] = 1.f / (1.f + __expf(x1 - x0)); }
                }
#pragma unroll
                for (int ai = 0; ai < 2; ++ai)
#pragma unroll
                    for (int m = 0; m < 4; ++m) {
                        float v[8];
#pragma unroll
                        for (int e = 0; e < 4; ++e) { v[e] = acc[ai][bj][m][0][e]; v[4 + e] = acc[ai][bj][m][1][e]; }
                        if (mode == 1) {
#pragma unroll
                            for (int e = 0; e < 8; ++e) v[e] = ::siluf(v[e]);
                        } else if (mode == 2) {
#pragma unroll
                            for (int e = 0; e < 8; ++e) { const float f = lb[e] + (1.f - lb[e]) * ::sigmf(v[e]); v[e] = __logf(f); }
                        }
                        u32x4 w; w.x = pkbf(v[0], v[1]); w.y = pkbf(v[2], v[3]); w.z = pkbf(v[4], v[5]); w.w = pkbf(v[6], v[7]);
                        *(u32x4*)(base + (size_t)(row0 + ai * HALF + m * 16) * 512 + c0) = w;
                    }
            }
        } else {
            if (wc == 0 && fq < 2) {
                float al[8], db[8];
                if (fq == 1) {
#pragma unroll
                    for (int e = 0; e < 8; ++e) { al[e] = -__expf(Alog[e]); db[e] = dtb[e]; }
                }
#pragma unroll
                for (int ai = 0; ai < 2; ++ai)
#pragma unroll
                    for (int m = 0; m < 4; ++m) {
                        const int row = row0 + ai * HALF + m * 16;
                        float v[8];
#pragma unroll
                        for (int e = 0; e < 4; ++e) { v[e] = acc[ai][0][m][0][e]; v[4 + e] = acc[ai][0][m][1][e]; }
                        if (fq == 0) {
#pragma unroll
                            for (int e = 0; e < 8; ++e) v[e] = ::sigmf(v[e]);
                            *(f32x4*)(BETA + (size_t)row * 8) = (f32x4){v[0], v[1], v[2], v[3]};
                            *(f32x4*)(BETA + (size_t)row * 8 + 4) = (f32x4){v[4], v[5], v[6], v[7]};
                        } else {
#pragma unroll
                            for (int e = 0; e < 8; ++e) { const float x = v[e] + db[e]; const float sp = x > 15.f ? x : log1pf(__expf(x)); v[e] = al[e] * sp; }
                            *(f32x4*)(GG + (size_t)row * 8) = (f32x4){v[0], v[1], v[2], v[3]};
                            *(f32x4*)(GG + (size_t)row * 8 + 4) = (f32x4){v[4], v[5], v[6], v[7]};
                        }
                    }
            }
        }
    }
};

struct EpiRes {
    static constexpr bool PERM = true, AFTER_DRAIN = false;
    const float* base0; const float* base1;
    float* out; const float* mod; int goff;
    const float *p1 = nullptr, *p2 = nullptr, *p3 = nullptr;
    __device__ __forceinline__ void operator()(const f32x4 (&acc)[2][2][4][2], const Unit& u, int wr, int wc, int fr, int fq) const {
        const int row0 = u.pm * BM + wr * 64 + fr;
        const int mr = u.pm < 16 ? 0 : 1 + ((u.pm - 16) >> 4);
        const float* gp = mod + (size_t)mr * 6144 + goff;
#pragma unroll
        for (int bj = 0; bj < 2; ++bj) {
            const int c0 = u.pn * BM + bj * HALF + wc * 32 + 8 * fq;
            const f32x4 g0 = *(const f32x4*)(gp + c0), g1 = *(const f32x4*)(gp + c0 + 4);
#pragma unroll
            for (int ai = 0; ai < 2; ++ai)
#pragma unroll
                for (int m = 0; m < 4; ++m) {
                    const int row = row0 + ai * HALF + m * 16;
                    const float* bp = (row < 4096 ? base0 + (size_t)row * 1024 : base1 + (size_t)(row - 4096) * 1024) + c0;
                    const f32x4 b0 = *(const f32x4*)bp, b1 = *(const f32x4*)(bp + 4);
                    float* op = out + (size_t)row * 1024 + c0;
                    f32x4 a0 = acc[ai][bj][m][0], a1 = acc[ai][bj][m][1];
                    if (p1) { const float *q1 = p1 + threadIdx.x * 4, *q2 = p2 + threadIdx.x * 4, *q3 = p3 + threadIdx.x * 4; asm volatile("" : "+v"(q1), "+v"(q2), "+v"(q3));
                        const int i0 = (((ai * 2 + bj) * 4 + m) * 2) * 2048, i1 = i0 + 2048;
                        a0 = a0 + (*(const f32x4*)(q1 + i0) + *(const f32x4*)(q2 + i0)) + *(const f32x4*)(q3 + i0); a1 = a1 + (*(const f32x4*)(q1 + i1) + *(const f32x4*)(q2 + i1)) + *(const f32x4*)(q3 + i1); }
                    *(f32x4*)op = b0 + g0 * a0;
                    *(f32x4*)(op + 4) = b1 + g1 * a1;
                }
        }
    }
};

struct EpiGU {
    static constexpr bool PERM = true, AFTER_DRAIN = false;
    bf16_t* GU;
    __device__ __forceinline__ void operator()(const f32x4 (&acc)[2][2][4][2], const Unit& u, int wr, int wc, int fr, int fq) const {
        const int row0 = u.pm * BM + wr * 64 + fr, c0 = u.pn * HALF + wc * 32 + 8 * fq;
#pragma unroll
        for (int ai = 0; ai < 2; ++ai)
#pragma unroll
            for (int m = 0; m < 4; ++m) {
                float v[8];
#pragma unroll
                for (int e = 0; e < 4; ++e) { v[e] = ::siluf(acc[ai][0][m][0][e]) * acc[ai][1][m][0][e]; v[4 + e] = ::siluf(acc[ai][0][m][1][e]) * acc[ai][1][m][1][e]; }
                u32x4 w; w.x = pkbf(v[0], v[1]); w.y = pkbf(v[2], v[3]); w.z = pkbf(v[4], v[5]); w.w = pkbf(v[6], v[7]);
                *(u32x4*)(GU + (size_t)(row0 + ai * HALF + m * 16) * 2816 + c0) = w;
            }
    }
};

template <class Inner> struct EpiSplit {
    static constexpr bool PERM = Inner::PERM, AFTER_DRAIN = false;
    Inner in; float* slab; unsigned* cnt; PG8_LAS unsigned* flag;
    __device__ __forceinline__ void operator()(const f32x4 (&acc)[2][2][4][2], const Unit& u, int wr, int wc, int fr, int fq) const {
        if (u.ns == 1) { in(acc, u, wr, wc, fr, fq); return; }
        const int tid = threadIdx.x;
        float* my = slab + (size_t)(u.su * 4 + u.sl) * 65536;
        const __amdgpu_buffer_rsrc_t rs = __builtin_amdgcn_make_buffer_rsrc(my, 0, 262144, 0x00020000);
#pragma unroll
        for (int ai = 0; ai < 2; ++ai)
#pragma unroll
            for (int bj = 0; bj < 2; ++bj)
#pragma unroll
                for (int m = 0; m < 4; ++m)
#pragma unroll
                    for (int n = 0; n < 2; ++n) __builtin_amdgcn_raw_buffer_store_b128(__builtin_bit_cast(u32x4, acc[ai][bj][m][n]), rs, (unsigned)(tid * 16), (unsigned)((((ai * 2 + bj) * 4 + m) * 2 + n) * 8192), 16);
        asm volatile("s_waitcnt vmcnt(0)" ::: "memory");
        __builtin_amdgcn_s_barrier();
        if (tid == 0) {
            const unsigned old = __hip_atomic_fetch_add(cnt + 64 * u.su, 1u, __ATOMIC_RELAXED, __HIP_MEMORY_SCOPE_AGENT);
            const unsigned last = (old == 3u) ? 1u : 0u;
            if (last) { __builtin_amdgcn_fence(__ATOMIC_ACQUIRE, "agent"); asm volatile("s_waitcnt vmcnt(0)" ::: "memory"); }
            *flag = last;
        }
        asm volatile("s_waitcnt lgkmcnt(0)" ::: "memory");
        __builtin_amdgcn_s_barrier();
        const unsigned last = *flag;
        if (last) {
            Inner in2 = in;
            in2.p1 = slab + (size_t)(u.su * 4 + ((u.sl + 1) & 3)) * 65536; in2.p2 = slab + (size_t)(u.su * 4 + ((u.sl + 2) & 3)) * 65536; in2.p3 = slab + (size_t)(u.su * 4 + ((u.sl + 3) & 3)) * 65536;
            in2(acc, u, wr, wc, fr, fq);
        }
    }
};
template <class Epi, class Sched, bool ALIGN_EPI = false, bool SP2 = false>
__device__ __forceinline__ void gemm_phase(PG8_LAS unsigned char* lds, const Gemm g, const Sched& S, const Epi& E) {
    const int tid = threadIdx.x, wid = __builtin_amdgcn_readfirstlane(tid >> 6), lane = tid & 63, wr = wid >> 2, wc = wid & 3, fr = lane & 15, fq = lane >> 4;
    const int K = g.K;
    unsigned voffA[2], voffB[2];
#pragma unroll
    for (int i = 0; i < 2; ++i) { int R, C; stage_rc(tid * 16 + i * 8192, R, C); const int Rb = Epi::PERM ? ((R & ~31) + perm32(R & 31)) : R;
        voffA[i] = (unsigned)(R * K + C) * 2u; voffB[i] = (unsigned)(Rb * K + C) * 2u; }
    const size_t kstep = (size_t)(BK * 2);
    const size_t hstep = (size_t)HALF * K * 2;
    const size_t tstep = 2 * hstep;
    const unsigned ldsw = (unsigned)wid * 1024u;
    const int aoff = lds_byte(wr * 64 + fr, fq * 8), boff = lds_byte(wc * 32 + fr, fq * 8);
#define PG8_SA(b, h) (((b) * 2 + (h)) * HTB)
#define PG8_SB(b, h) ((4 + (b) * 2 + (h)) * HTB)
#define PG8_STAGE(bufoff, gbase, voff) do { _Pragma("unroll") for (int _i = 0; _i < 2; ++_i) \
        __builtin_amdgcn_global_load_lds((const unsigned*)((const char*)(gbase) + (voff)[_i]), (PG8_LAS unsigned*)(lds + (bufoff) + ldsw + _i * 8192), 16, 0, 0); } while (0)
#define PG8_LDA(dst, b, h) do { _Pragma("unroll") for (int m = 0; m < 4; ++m) _Pragma("unroll") for (int k = 0; k < 2; ++k) dst[m][k] = *(const PG8_LAS bf16x8*)(lds + PG8_SA(b, h) + aoff + m * 2048 + k * 1024); } while (0)
#define PG8_LDB(dst, b, h) do { _Pragma("unroll") for (int n = 0; n < 2; ++n) _Pragma("unroll") for (int k = 0; k < 2; ++k) dst[n][k] = *(const PG8_LAS bf16x8*)(lds + PG8_SB(b, h) + boff + n * 2048 + k * 1024); } while (0)
#define PG8_MMA(ai, bj, At, Bt) do { __builtin_amdgcn_s_setprio(1); _Pragma("unroll") for (int m = 0; m < 4; ++m) _Pragma("unroll") for (int n = 0; n < 2; ++n) _Pragma("unroll") for (int k = 0; k < 2; ++k) \
        acc[ai][bj][m][n] = __builtin_amdgcn_mfma_f32_16x16x32_bf16(Bt[n][k], At[m][k], acc[ai][bj][m][n], 0, 0, 0); __builtin_amdgcn_s_setprio(0); } while (0)
#define PG8_WAIT_V(n) asm volatile("s_waitcnt vmcnt(" #n ")" ::: "memory")
#define PG8_WAIT_L(n) asm volatile("s_waitcnt lgkmcnt(" #n ")" ::: "memory")
#define PG8_BAR __builtin_amdgcn_s_barrier()
#define PG8_SCHED __builtin_amdgcn_sched_barrier(0)
    Unit cur, nxt; int ui = 0;
    if (!S.next(0, cur)) return;
    f32x4 acc[2][2][4][2];
#pragma unroll
    for (int a = 0; a < 2; ++a)
#pragma unroll
        for (int b = 0; b < 2; ++b)
#pragma unroll
            for (int m = 0; m < 4; ++m)
#pragma unroll
                for (int n = 0; n < 2; ++n) acc[a][b][m][n] = (f32x4){0.f, 0.f, 0.f, 0.f};
    bf16x8 At[4][2], B0[2][2], B1[2][2];
    const char* cA = (const char*)g.A + (size_t)cur.pm * tstep + (size_t)cur.k0 * 2; const char* cB = (const char*)g.Bt + (size_t)cur.pn * tstep + (size_t)cur.k0 * 2;
    S.a_ready(cur);
    if constexpr (SP2) {
        PG8_STAGE(PG8_SB(0, 0), cB, voffB); PG8_STAGE(PG8_SB(0, 1), cB + hstep, voffB); PG8_STAGE(PG8_SA(0, 0), cA, voffA); PG8_STAGE(PG8_SA(0, 1), cA + hstep, voffA);
        if (wr == 1) PG8_BAR;
        PG8_WAIT_V(2); PG8_BAR;
        PG8_STAGE(PG8_SB(1, 0), cB + kstep, voffB); PG8_STAGE(PG8_SA(1, 0), cA + kstep, voffA); PG8_STAGE(PG8_SB(1, 1), cB + hstep + kstep, voffB);
        PG8_WAIT_V(6); PG8_BAR;
    } else {
        PG8_STAGE(PG8_SB(0, 0), cB, voffB); PG8_STAGE(PG8_SA(0, 0), cA, voffA); PG8_STAGE(PG8_SB(0, 1), cB + hstep, voffB); PG8_STAGE(PG8_SA(0, 1), cA + hstep, voffA);
        if (wr == 1) PG8_BAR;
        PG8_WAIT_V(4); PG8_BAR;
        PG8_STAGE(PG8_SB(1, 0), cB + kstep, voffB); PG8_STAGE(PG8_SA(1, 0), cA + kstep, voffA); PG8_STAGE(PG8_SB(1, 1), cB + hstep + kstep, voffB);
        PG8_WAIT_V(6); PG8_BAR;
    }
    for (;;) {
        const bool has_next = S.next(ui + 1, nxt);
        const char* nA = has_next ? (const char*)g.A + (size_t)nxt.pm * tstep + (size_t)nxt.k0 * 2 : cA; const char* nB = has_next ? (const char*)g.Bt + (size_t)nxt.pn * tstep + (size_t)nxt.k0 * 2 : cB;
        const int nt = cur.nt;
        for (int t = 0; t < nt; t += 2) {
            const bool last = (t == nt - 2);
            const char* a1 = cA + (size_t)(t + 1) * kstep;
            const char* a2 = last ? nA : cA + (size_t)(t + 2) * kstep; const char* b2 = last ? nB : cB + (size_t)(t + 2) * kstep;
            const char* a3 = a2 + kstep; const char* b3 = b2 + kstep;
            if (last && has_next) S.a_ready(nxt);
            if constexpr (SP2) {
            PG8_LDB(B0, 0, 0); PG8_LDB(B1, 0, 1); PG8_SCHED; PG8_LDA(At, 0, 0); PG8_STAGE(PG8_SA(1, 1), a1 + hstep, voffA);
            PG8_WAIT_V(8); PG8_WAIT_L(0); PG8_BAR; PG8_MMA(0, 0, At, B0); PG8_MMA(0, 1, At, B1); PG8_BAR; PG8_SCHED;
            PG8_LDA(At, 0, 1); PG8_STAGE(PG8_SB(0, 0), b2, voffB); PG8_STAGE(PG8_SB(0, 1), b2 + hstep, voffB); PG8_STAGE(PG8_SA(0, 0), a2, voffA);
            PG8_WAIT_V(8); PG8_WAIT_L(0); PG8_BAR; PG8_MMA(1, 0, At, B0); PG8_MMA(1, 1, At, B1); PG8_BAR; PG8_SCHED;
            PG8_LDB(B0, 1, 0); PG8_LDB(B1, 1, 1); PG8_SCHED; PG8_LDA(At, 1, 0); PG8_STAGE(PG8_SA(0, 1), a2 + hstep, voffA);
            PG8_WAIT_V(8); PG8_WAIT_L(0); PG8_BAR; PG8_MMA(0, 0, At, B0); PG8_MMA(0, 1, At, B1); PG8_BAR; PG8_SCHED;
            PG8_LDA(At, 1, 1); PG8_STAGE(PG8_SB(1, 0), b3, voffB); PG8_STAGE(PG8_SB(1, 1), b3 + hstep, voffB); PG8_STAGE(PG8_SA(1, 0), a3, voffA);
            PG8_WAIT_V(8); PG8_WAIT_L(0); PG8_BAR; PG8_MMA(1, 0, At, B0); PG8_MMA(1, 1, At, B1); PG8_BAR; PG8_SCHED;
            } else {
            PG8_LDB(B0, 0, 0); PG8_SCHED; PG8_LDA(At, 0, 0); PG8_STAGE(PG8_SA(1, 1), a1 + hstep, voffA);
            PG8_WAIT_L(8); PG8_BAR; PG8_WAIT_L(0); PG8_MMA(0, 0, At, B0); PG8_BAR; PG8_SCHED;
            PG8_LDB(B1, 0, 1); PG8_STAGE(PG8_SB(0, 0), b2, voffB);
            PG8_BAR; PG8_WAIT_L(0); PG8_MMA(0, 1, At, B1); PG8_BAR;
            PG8_LDA(At, 0, 1); PG8_STAGE(PG8_SA(0, 0), a2, voffA);
            PG8_BAR; PG8_WAIT_L(0); PG8_MMA(1, 0, At, B0); PG8_BAR; PG8_SCHED;
            PG8_STAGE(PG8_SB(0, 1), b2 + hstep, voffB);
            PG8_WAIT_V(6); PG8_BAR; PG8_MMA(1, 1, At, B1); PG8_BAR;
            PG8_LDB(B0, 1, 0); PG8_SCHED; PG8_LDA(At, 1, 0); PG8_STAGE(PG8_SA(0, 1), a2 + hstep, voffA);
            PG8_WAIT_L(8); PG8_BAR; PG8_WAIT_L(0); PG8_MMA(0, 0, At, B0); PG8_BAR; PG8_SCHED;
            PG8_LDB(B1, 1, 1); PG8_STAGE(PG8_SB(1, 0), b3, voffB);
            PG8_BAR; PG8_WAIT_L(0); PG8_MMA(0, 1, At, B1); PG8_BAR;
            PG8_LDA(At, 1, 1); PG8_STAGE(PG8_SA(1, 0), a3, voffA);
            PG8_BAR; PG8_WAIT_L(0); PG8_MMA(1, 0, At, B0); PG8_BAR; PG8_SCHED;
            PG8_STAGE(PG8_SB(1, 1), b3 + hstep, voffB);
            PG8_WAIT_V(6); PG8_BAR; PG8_MMA(1, 1, At, B1); PG8_BAR;
            }
        }
        if constexpr (ALIGN_EPI) { if (wr == 0) PG8_BAR; }
        if constexpr (!Epi::AFTER_DRAIN) { E(acc, cur, wr, wc, fr, fq); S.done(cur); }
        if (!has_next) break;
#pragma unroll
        for (int a = 0; a < 2; ++a)
#pragma unroll
            for (int b = 0; b < 2; ++b)
#pragma unroll
                for (int m = 0; m < 4; ++m)
#pragma unroll
                    for (int n = 0; n < 2; ++n) acc[a][b][m][n] = (f32x4){0.f, 0.f, 0.f, 0.f};
        cur = nxt; cA = nA; cB = nB; ++ui;
        if constexpr (ALIGN_EPI) { if (wr == 1) PG8_BAR; }
    }
    PG8_WAIT_V(0);
    if constexpr (!ALIGN_EPI) { if (wr == 0) PG8_BAR; }
    PG8_BAR;
    if constexpr (Epi::AFTER_DRAIN) { E.fused(acc, cur, wr, wc, fr, fq, lds, wid, lane); S.done(cur); }
#undef PG8_SA
#undef PG8_SB
#undef PG8_STAGE
#undef PG8_LDA
#undef PG8_LDB
#undef PG8_MMA
#undef PG8_WAIT_V
#undef PG8_WAIT_L
#undef PG8_BAR
#undef PG8_SCHED
}
}

#define XB_TMO      128
#define XB_XCNT(j)  (256  + 64 * (j))
#define XB_XSUB(j)  (1280 + 64 * (j))
#define XB_XGEN(j)  (2304 + 64 * (j))
#define XB_TOP      3328
#define XB_TOPGEN   3392
#define XCD_BAR_WORDS 3456
#define XB_SPIN_CAP (1u << 18)

__device__ __forceinline__ unsigned xb_ld(unsigned* p)              { return __hip_atomic_load(p, __ATOMIC_RELAXED, __HIP_MEMORY_SCOPE_AGENT); }
__device__ __forceinline__ unsigned xb_add(unsigned* p, unsigned v) { return __hip_atomic_fetch_add(p, v, __ATOMIC_RELAXED, __HIP_MEMORY_SCOPE_AGENT); }
__device__ __forceinline__ unsigned xb_xcc_id() { return (unsigned)__builtin_amdgcn_s_getreg((3 << 11) | 20) & 0xFu; }
#define XB_SPIN(cond, bar) do { unsigned _sp = 0; while (cond) { __builtin_amdgcn_s_sleep(1); \
    if ((++_sp & 255u) == 0u) { if (xb_ld(&(bar)[XB_TMO])) break; if (_sp > XB_SPIN_CAP) { atomicAdd(&(bar)[XB_TMO], 1u); break; } } } } while (0)

struct XcdBarrier {
    unsigned* bar; unsigned x;
    volatile LAS unsigned* st;
};

__device__ __forceinline__ XcdBarrier xcd_barrier_post(unsigned* bar, volatile LAS unsigned* st) {
    XcdBarrier b; b.bar = bar; b.x = xb_xcc_id(); b.st = st;
    if (threadIdx.x == 0) (void)xb_add(&bar[XB_XCNT(b.x)], 1u);
    return b;
}
__device__ __forceinline__ void xcd_barrier_complete(unsigned* bar, unsigned x, unsigned& nloc, unsigned& nx) {
    const unsigned G = gridDim.x * gridDim.y * gridDim.z;
    unsigned sum, cnt, mine, sp = 0u;
    for (;;) {
        sum = 0u; cnt = 0u; mine = 0u;
#pragma unroll
        for (unsigned j = 0; j < 16; ++j) { const unsigned c = xb_ld(&bar[XB_XCNT(j)]); sum += c; cnt += (c > 0u) ? 1u : 0u; mine = (j == x) ? c : mine; }
        if (sum == G) break;
        __builtin_amdgcn_s_sleep(1);
        if ((++sp & 255u) == 0u) { if (xb_ld(&bar[XB_TMO])) break; if (sp > XB_SPIN_CAP) { atomicAdd(&bar[XB_TMO], 1u); break; } }
    }
    nloc = mine > 0u ? mine : 1u; nx = cnt > 0u ? cnt : 1u;
}

__device__ __forceinline__ void xcd_barrier(const XcdBarrier& b) {
    asm volatile("s_waitcnt vmcnt(0)" ::: "memory");
    __syncthreads();
    if (threadIdx.x == 0) {
        unsigned* bar = b.bar;
        __builtin_amdgcn_s_waitcnt(0);
        unsigned nloc = b.st[0], nx = b.st[1];
        if (nloc == 0u) { xcd_barrier_complete(bar, b.x, nloc, nx); b.st[0] = nloc; b.st[1] = nx; }
        const unsigned old = xb_add(&bar[XB_XSUB(b.x)], 1u);
        const unsigned gen = old / nloc;
        if (old + 1u == (gen + 1u) * nloc) {
            __builtin_amdgcn_fence(__ATOMIC_RELEASE, "agent");
            asm volatile("s_waitcnt vmcnt(0)" ::: "memory");
            const unsigned og = xb_add(&bar[XB_TOP], 1u);
            const unsigned tg = og / nx;
            if (og + 1u == (tg + 1u) * nx) xb_add(&bar[XB_TOPGEN], 1u);
            else XB_SPIN(xb_ld(&bar[XB_TOPGEN]) == tg, bar);
            __builtin_amdgcn_fence(__ATOMIC_ACQUIRE, "agent");
            xb_add(&bar[XB_XGEN(b.x)], 1u);
            asm volatile("s_waitcnt vmcnt(0)" ::: "memory");
        } else {
            XB_SPIN(xb_ld(&bar[XB_XGEN(b.x)]) == gen, bar);
            __builtin_amdgcn_fence(__ATOMIC_ACQUIRE, "agent");
            asm volatile("s_waitcnt vmcnt(0)" ::: "memory");
        }
    }
    __syncthreads();
}

struct Args { const float* in[N_IN]; float* out; unsigned char* ws; int ph_lo, ph_hi; };
struct Frame {
    LAS unsigned char* lds;
    int tid, lane, wave, bid, G;
    unsigned long long pacc, pt0;
    const float* in[N_IN];
    float* out; unsigned char* ws;
};
#define probe_acc F.pacc
#define probe_t0 F.pt0
#define WSP(T, off) ((T*)(F.ws + (off)))
#define OUTB(T, off) ((T*)((unsigned char*)F.out + (off)))

__device__ __forceinline__ void transpose_item(const float* W, int K, int N, bf16* WT, int dst_row0, int k0, int n0, LAS float* scr, int lane) {
    float wv[32];
#pragma unroll
    for (int i = 0; i < 32; ++i) { const int kk = 2 * i + (lane >> 5), n = n0 + (lane & 31); wv[i] = n < N ? W[(size_t)(k0 + kk) * N + n] : 0.f; }
#pragma unroll
    for (int i = 0; i < 32; ++i) { const int kk = 2 * i + (lane >> 5); scr[kk * 33 + (lane & 31)] = wv[i]; }
    LDS_WAIT(); asm volatile("" ::: "memory");
    const int c = lane & 7;
#pragma unroll
    for (int j = 0; j < 4; ++j) { const int n = (lane >> 3) + 8 * j; const LAS float* s = scr + (8 * c) * 33 + n;
        u32x4 o; o.x = pk2(s[0 * 33], s[1 * 33]); o.y = pk2(s[2 * 33], s[3 * 33]); o.z = pk2(s[4 * 33], s[5 * 33]); o.w = pk2(s[6 * 33], s[7 * 33]);
        *(u32x4*)(WT + (size_t)(dst_row0 + n) * K + k0 + 8 * c) = o; }
    LDS_WAIT(); asm volatile("" ::: "memory");
}

__device__ __forceinline__ void p0_prologue(Frame& F) {
    const int gw = F.bid * NWAVES + F.wave, NGW = F.G * NWAVES;
    {
        LAS float* scr = (LAS float*)(F.lds + 49152 + F.wave * 8704);
        constexpr int NB = NPAD / 32, NITEMS = 16 * NB;
        for (int it = gw; it < NITEMS; it += NGW) { const int kb = it / NB, nb = it % NB; transpose_item(F.in[I_WIN], 1024, DPROJ, WSP(bf16, WS_WIN), 32 * nb, 64 * kb, 32 * nb, scr, F.lane); }
    }
    {
        LAS float* sc = (LAS float*)F.lds;
        LAS float* red = (LAS float*)(F.lds + 20480);
        for (int idx = F.tid; idx < 5 * 1024; idx += NTHR) { const int r = idx >> 10, k = idx & 1023; const float v = r == 0 ? F.in[I_CCTX][k] : F.in[I_C][(r - 1) * 1024 + k]; sc[idx] = siluf(v); }
        __syncthreads();
        const float* wada = F.in[I_WADA]; const float* bada = F.in[I_BADA]; float* mod = WSP(float, WS_MOD);
        for (int it = F.bid; it < 256; it += F.G) {
            const int kg = it >> 3, cg = it & 7, c4 = F.tid % 192, rh = F.tid / 192;
            float acc[5][4];
#pragma unroll
            for (int r = 0; r < 5; ++r)
#pragma unroll
                for (int e = 0; e < 4; ++e) acc[r][e] = 0.f;
            if (rh < 2) {
                const float* wp = wada + (size_t)(32 * kg + 16 * rh) * 6144 + 768 * cg + 4 * c4;
                f32x4 wr[16];
#pragma unroll
                for (int kk = 0; kk < 16; ++kk) wr[kk] = *(const f32x4*)(wp + (size_t)kk * 6144);
#pragma unroll
                for (int kk = 0; kk < 16; ++kk) {
                    const f32x4 w = wr[kk];
                    const int k = 32 * kg + 16 * rh + kk;
#pragma unroll
                    for (int r = 0; r < 5; ++r) { const float s = sc[r * 1024 + k]; acc[r][0] += s * w.x; acc[r][1] += s * w.y; acc[r][2] += s * w.z; acc[r][3] += s * w.w; }
                }
            }
            if (rh == 1) {
#pragma unroll
                for (int r = 0; r < 5; ++r)
#pragma unroll
                    for (int e = 0; e < 4; ++e) red[c4 * 20 + r * 4 + e] = acc[r][e];
            }
            __syncthreads();
            if (rh == 0) {
                const int col = 768 * cg + 4 * c4;
#pragma unroll
                for (int r = 0; r < 5; ++r)
#pragma unroll
                    for (int e = 0; e < 4; ++e) { float v = acc[r][e] + red[c4 * 20 + r * 4 + e]; if (kg == 0) v += bada[col + e]; atomicAdd(mod + r * 6144 + col + e, v); }
            }
            __syncthreads();
        }
    }
}

__device__ __forceinline__ void modnorm_rows(Frame& F, const float* x0, const float* x1, const float* nw, int sh_off, int sc_off, bf16* H) {
    const int gw = F.bid * NWAVES + F.wave, NGW = F.G * NWAVES;
    const float* mod = WSP(float, WS_MOD);
    f32x4 v[2][4], vn[2][4];
#define MN_LOAD(dst, M0) do { _Pragma("unroll") for (int u = 0; u < 2; ++u) { const int m_ = (M0) + u * NGW; if (m_ < NT) { const float* xr_ = m_ < NCTX ? x0 + (size_t)m_ * DM : x1 + (size_t)(m_ - NCTX) * DM; \
        _Pragma("unroll") for (int j = 0; j < 4; ++j) dst[u][j] = *(const f32x4*)(xr_ + 4 * F.lane + 256 * j); } } } while (0)
    MN_LOAD(vn, gw);
    for (int m0 = gw; m0 < NT; m0 += 2 * NGW) {
#pragma unroll
        for (int u = 0; u < 2; ++u)
#pragma unroll
            for (int j = 0; j < 4; ++j) v[u][j] = vn[u][j];
        if (m0 + 2 * NGW < NT) MN_LOAD(vn, m0 + 2 * NGW);
#pragma unroll
        for (int u = 0; u < 2; ++u) { const int m = m0 + u * NGW; if (m < NT) {
            const int mr = m < NCTX ? 0 : 1 + ((m - NCTX) >> 12);
            const float* mp = mod + (size_t)mr * 6144;
            float s = 0.f;
#pragma unroll
            for (int j = 0; j < 4; ++j) s += (v[u][j].x * v[u][j].x + v[u][j].y * v[u][j].y) + (v[u][j].z * v[u][j].z + v[u][j].w * v[u][j].w);
            const float rstd = __builtin_amdgcn_rsqf(wave_sum(s) * (1.f / DM) + EPS);
#pragma unroll
            for (int j = 0; j < 4; ++j) {
                const int c = 4 * F.lane + 256 * j;
                const f32x4 w = *(const f32x4*)(nw + c), sc = *(const f32x4*)(mp + sc_off + c), sh = *(const f32x4*)(mp + sh_off + c);
                const f32x4 h = (v[u][j] * rstd * w) * (sc + 1.f) + sh;
                u32x2 o; o.x = pk2(h.x, h.y); o.y = pk2(h.z, h.w);
                *(u32x2*)(H + (size_t)m * DM + c) = o;
            } } }
    }
#undef MN_LOAD
}

__device__ __forceinline__ void final_norm(Frame& F) {
    const int gw = F.bid * NWAVES + F.wave, NGW = F.G * NWAVES;
    const float* nf = F.in[I_NF];
    f32x4 w[4];
#pragma unroll
    for (int j = 0; j < 4; ++j) w[j] = *(const f32x4*)(nf + 4 * F.lane + 256 * j);
    for (int m0 = gw; m0 < NT; m0 += 2 * NGW) {
        f32x4 v[2][4];
#pragma unroll
        for (int u = 0; u < 2; ++u) { const int m = m0 + u * NGW; if (m < NT) {
#pragma unroll
            for (int j = 0; j < 4; ++j) v[u][j] = *(const f32x4*)(F.out + (size_t)m * DM + 4 * F.lane + 256 * j); } }
#pragma unroll
        for (int u = 0; u < 2; ++u) { const int m = m0 + u * NGW; if (m < NT) {
            float s = 0.f;
#pragma unroll
            for (int j = 0; j < 4; ++j) s += (v[u][j].x * v[u][j].x + v[u][j].y * v[u][j].y) + (v[u][j].z * v[u][j].z + v[u][j].w * v[u][j].w);
            const float rstd = __builtin_amdgcn_rsqf(wave_sum(s) * (1.f / DM) + EPS);
#pragma unroll
            for (int j = 0; j < 4; ++j) *(f32x4*)(F.out + (size_t)m * DM + 4 * F.lane + 256 * j) = v[u][j] * rstd * w[j]; } }
    }
}

__device__ __forceinline__ void late_weights(Frame& F, const int gw, const int NGW) {
    {
        LAS float* scr = (LAS float*)(F.lds + F.wave * 8704);
        constexpr int I_O = 16 * 32, I_G = 16 * 88, I_D = 44 * 32, NITEMS = I_O + 2 * I_G + I_D;
        for (int it = gw; it < NITEMS; it += NGW) {
            int r = it;
            if (r < I_O) { const int kb = r / 32, nb = r % 32; transpose_item(F.in[I_WOUT], 1024, 1024, WSP(bf16, WS_WOUT), 32 * nb, 64 * kb, 32 * nb, scr, F.lane); continue; } r -= I_O;
            if (r < I_G) { const int kb = r / 88, nb = r % 88, n0 = 32 * nb; transpose_item(F.in[I_WGATE], 1024, DFF, WSP(bf16, WS_WGU), 256 * (n0 >> 7) + (n0 & 127), 64 * kb, n0, scr, F.lane); continue; } r -= I_G;
            if (r < I_G) { const int kb = r / 88, nb = r % 88, n0 = 32 * nb; transpose_item(F.in[I_WUP], 1024, DFF, WSP(bf16, WS_WGU), 256 * (n0 >> 7) + 128 + (n0 & 127), 64 * kb, n0, scr, F.lane); continue; } r -= I_G;
            { const int kb = r / 32, nb = r % 32; transpose_item(F.in[I_WDOWN], DFF, 1024, WSP(bf16, WS_WDN), 32 * nb, 64 * kb, 32 * nb, scr, F.lane); }
        }
    }
}

__device__ __forceinline__ void p5_headnorm(Frame& F) {
    const int gw = F.bid * NWAVES + F.wave, NGW = F.G * NWAVES;
    const bf16* OA0 = OUTB(bf16, OUT_OA); const bf16* OA1 = OUTB(bf16, OUT_OA + 20 * MiB);
    const bf16* OB0 = WSP(bf16, WS_OB);   const bf16* OB1 = WSP(bf16, WS_OB + 20 * MiB);
    const bf16* AG = WSP(bf16, WS_AG);    const bf16* BZ = WSP(bf16, WS_BZ);
    bf16* Y = WSP(bf16, WS_YIN);
    const int half = F.lane >> 5, c = 16 * (F.lane & 31);
    const float* nw = (half ? F.in[I_GNORM] : F.in[I_HNORM]) + c;
    f32x4 wn[4];
#pragma unroll
    for (int q = 0; q < 4; ++q) wn[q] = *(const f32x4*)(nw + 4 * q);
    u32x4 ra[2], rb[2], rg[2], na[2], nb2[2], ng[2];
#define P5_LOAD(A, B, Gt, M) do { const size_t off_ = (size_t)(M) * 512 + c; \
        _Pragma("unroll") for (int q = 0; q < 2; ++q) { A[q] = *(const u32x4*)((half ? OB0 : OA0) + off_ + 8 * q); B[q] = *(const u32x4*)((half ? OB1 : OA1) + off_ + 8 * q); Gt[q] = *(const u32x4*)((half ? BZ : AG) + off_ + 8 * q); } } while (0)
    if (gw < NT) P5_LOAD(na, nb2, ng, gw);
    for (int m = gw; m < NT; m += NGW) {
#pragma unroll
        for (int q = 0; q < 2; ++q) { ra[q] = na[q]; rb[q] = nb2[q]; rg[q] = ng[q]; }
        if (m + NGW < NT) P5_LOAD(na, nb2, ng, m + NGW);
        float o[16]; float ss = 0.f;
#pragma unroll
        for (int q = 0; q < 2; ++q)
#pragma unroll
            for (int e = 0; e < 4; ++e) { o[8 * q + 2 * e] = bflo(ra[q][e]) + bflo(rb[q][e]); o[8 * q + 2 * e + 1] = bfhi(ra[q][e]) + bfhi(rb[q][e]); }
#pragma unroll
        for (int e = 0; e < 16; ++e) ss += o[e] * o[e];
        ss += __shfl_xor(ss, 1); ss += __shfl_xor(ss, 2); ss += __shfl_xor(ss, 4);
        const float rstd = __builtin_amdgcn_rsqf(ss * (1.f / 128.f) + EPS);
#pragma unroll
        for (int q = 0; q < 2; ++q) {
            float y[8];
#pragma unroll
            for (int e = 0; e < 4; ++e) { y[2 * e] = o[8 * q + 2 * e] * rstd * wn[2 * q + (e >> 1)][2 * (e & 1)] * bflo(rg[q][e]); y[2 * e + 1] = o[8 * q + 2 * e + 1] * rstd * wn[2 * q + (e >> 1)][2 * (e & 1) + 1] * bfhi(rg[q][e]); }
            u32x4 w; w.x = pk2(y[0], y[1]); w.y = pk2(y[2], y[3]); w.z = pk2(y[4], y[5]); w.w = pk2(y[6], y[7]);
            *(u32x4*)(Y + (size_t)m * DM + half * 512 + c + 8 * q) = w;
        }
    }
#undef P5_LOAD
}

__device__ __forceinline__ int uc_index(int s, int n, int h, int dir) { return ((chunk_base(s) + n) * 4 + h) * 2 + dir; }
__device__ __forceinline__ unsigned char* grec_ptr(Frame& F, int uc) { return uc < N1G ? F.ws + WS_I + (size_t)uc * GREC : (unsigned char*)F.out + OUT_GOVF + (size_t)(uc - N1G) * GREC; }
__device__ __forceinline__ unsigned char* hrec_ptr(Frame& F, int uc) { return F.ws + WS_I + (size_t)uc * HREC; }
__device__ __forceinline__ bool allowed(int dir, int t, int s) { return dir ? (s >= t) : (s <= t); }

__device__ __forceinline__ void write_qd_image(Frame& F, const LAS bf16* X, int pitch, const LAS float* rowscale, unsigned char* dst) {
    const int r = F.lane & 15, g = F.lane >> 4, mt = F.wave >> 1;
#pragma unroll
    for (int q = 0; q < 2; ++q) {
        const int ks = 2 * (F.wave & 1) + q, row = 16 * mt + r;
        const u32x2 a = *(const LAS u32x2*)(X + row * pitch + 32 * ks + 4 * g), b = *(const LAS u32x2*)(X + row * pitch + 32 * ks + 16 + 4 * g);
        u32x4 o;
        if (rowscale) { const float sc = rowscale[row];
            o.x = pk2(bflo(a.x) * sc, bfhi(a.x) * sc); o.y = pk2(bflo(a.y) * sc, bfhi(a.y) * sc); o.z = pk2(bflo(b.x) * sc, bfhi(b.x) * sc); o.w = pk2(bflo(b.y) * sc, bfhi(b.y) * sc);
        } else { o.x = a.x; o.y = a.y; o.z = b.x; o.w = b.y; }
        *(u32x4*)(dst + ((mt * 4 + ks) * 64 + F.lane) * 16) = o;
    }
}
__device__ __forceinline__ void write_at_image(Frame& F, const LAS bf16* KA, const LAS bf16* QB, int pitch, const LAS float* Cs, int dir, unsigned char* dst) {
    const int r = F.lane & 15, g = F.lane >> 4, mt = F.wave >> 1, ks2 = F.wave & 1;
    f32x4 a0 = {0.f, 0.f, 0.f, 0.f}, a1 = {0.f, 0.f, 0.f, 0.f};
#pragma unroll
    for (int kd = 0; kd < 4; ++kd) {
        const bf16x8 bq = as_frag(*(const LAS u32x4*)(QB + (16 * mt + r) * pitch + 32 * kd + 8 * g));
        const bf16x8 k0 = as_frag(*(const LAS u32x4*)(KA + (32 * ks2 + r) * pitch + 32 * kd + 8 * g));
        const bf16x8 k1 = as_frag(*(const LAS u32x4*)(KA + (32 * ks2 + 16 + r) * pitch + 32 * kd + 8 * g));
        a0 = mfma16(k0, bq, a0); a1 = mfma16(k1, bq, a1);
    }
    const int t = 16 * mt + r; const float ct = Cs ? Cs[t] : 0.f;
    f32x4 cs0 = {0.f, 0.f, 0.f, 0.f}, cs1 = {0.f, 0.f, 0.f, 0.f};
    if (Cs) { cs0 = *(const LAS f32x4*)(Cs + 32 * ks2 + 4 * g); cs1 = *(const LAS f32x4*)(Cs + 32 * ks2 + 16 + 4 * g); }
    float v[8];
#pragma unroll
    for (int j = 0; j < 8; ++j) {
        const int s = 32 * ks2 + kperm(g, j); const bool ok = allowed(dir, t, s);
        float x = (j < 4) ? a0[j & 3] : a1[j & 3];
        if (Cs) { const float e = __expf(ok ? ct - ((j < 4) ? cs0[j & 3] : cs1[j & 3]) : 0.f); x *= e; }
        v[j] = ok ? x : 0.f;
    }
    u32x4 o; o.x = pk2(v[0], v[1]); o.y = pk2(v[2], v[3]); o.z = pk2(v[4], v[5]); o.w = pk2(v[6], v[7]);
    *(u32x4*)(dst + ((mt * 2 + ks2) * 64 + F.lane) * 16) = o;
}

__device__ __forceinline__ void p3h_load(Frame& F, int task, unsigned (&gw)[8], unsigned (&qw)[8], unsigned (&vw)[8]) {
    const int dir = task & 1, h = (task >> 1) & 3, cidx = task >> 3;
    int s, n; if (cidx < 64) { s = cidx >> 2; n = cidx & 3; } else { s = 16 + ((cidx - 64) >> 6); n = (cidx - 64) & 63; }
    const bf16* Gd = OUTB(bf16, dir ? OUT_GB : OUT_GF); const bf16* QA = OUTB(bf16, OUT_QA); const bf16* VA = OUTB(bf16, OUT_VA);
    const int c0 = 2 * (F.tid & 63), re = F.tid >> 6;
#pragma unroll
    for (int e = 0; e < 8; ++e) {
        const size_t off = (size_t)tok_a(s, n, 8 * re + e) * 512 + h * 128 + c0;
        gw[e] = *(const unsigned*)(Gd + off); qw[e] = *(const unsigned*)(QA + off);
        if (dir == 0) vw[e] = *(const unsigned*)(VA + off);
    }
}
__device__ __forceinline__ void p3_hgrn(Frame& F) {
    constexpr int PITCH = 136;
    LAS bf16* QDb = (LAS bf16*)(F.lds);
    LAS bf16* KDb = (LAS bf16*)(F.lds + 17408);
    LAS unsigned char* KTi = F.lds + 34816;
    LAS float* part = (LAS float*)(F.lds + 51200);
    LAS float* etot = (LAS float*)(F.lds + 55296);
    LAS bf16* Vb = (LAS bf16*)(F.lds + 56320);
    unsigned ngw[8], nqw[8], nvw[8];
    if (F.bid < NUC) p3h_load(F, F.bid, ngw, nqw, nvw);
    for (int task = F.bid; task < NUC; task += F.G) {
        const int dir = task & 1, h = (task >> 1) & 3, cidx = task >> 3;
        int s, n; if (cidx < 64) { s = cidx >> 2; n = cidx & 3; } else { s = 16 + ((cidx - 64) >> 6); n = (cidx - 64) & 63; }
        PROBE_BEGIN(61);
        unsigned char* rec = hrec_ptr(F, task);
        const int cp = F.tid & 63, re = F.tid >> 6, c0 = 2 * cp;
        float f0[8], f1[8], q0[8], q1[8], p0[8], p1[8];
#pragma unroll
        for (int e = 0; e < 8; ++e) {
            f0[e] = __expf(bflo(ngw[e])); f1[e] = __expf(bfhi(ngw[e])); q0[e] = bflo(nqw[e]); q1[e] = bfhi(nqw[e]);
            if (dir == 0) *(LAS unsigned*)(Vb + (8 * re + e) * PITCH + c0) = nvw[e];
        }
        if (task + F.G < NUC) p3h_load(F, task + F.G, ngw, nqw, nvw);
        if (dir == 0) { float a = 1.f, b = 1.f;
#pragma unroll
            for (int e = 0; e < 8; ++e) { a *= f0[e]; b *= f1[e]; p0[e] = a; p1[e] = b; }
            part[re * 128 + c0] = a; part[re * 128 + c0 + 1] = b;
        } else { float a = 1.f, b = 1.f;
#pragma unroll
            for (int e = 7; e >= 0; --e) { a *= f0[e]; b *= f1[e]; p0[e] = a; p1[e] = b; }
            part[re * 128 + c0] = a; part[re * 128 + c0 + 1] = b;
        }
        __syncthreads();
        PROBE_END(61); PROBE_BEGIN(62);
        float o0 = 1.f, o1 = 1.f, t0 = 1.f, t1 = 1.f;
#pragma unroll
        for (int r2 = 0; r2 < 8; ++r2) { const float a = part[r2 * 128 + c0], b = part[r2 * 128 + c0 + 1]; t0 *= a; t1 *= b; const bool pre = dir ? (r2 > re) : (r2 < re); if (pre) { o0 *= a; o1 *= b; } }
        if (re == 0) { etot[c0] = t0; etot[c0 + 1] = t1; }
        float kt0[8], kt1[8];
#pragma unroll
        for (int e = 0; e < 8; ++e) {
            const float E0 = o0 * p0[e], E1 = o1 * p1[e];
            const float k0 = 1.f - f0[e], k1 = 1.f - f1[e];
            const float kd0 = k0 * __builtin_amdgcn_rcpf(E0), kd1 = k1 * __builtin_amdgcn_rcpf(E1);
            const int row = 8 * re + e;
            *(LAS unsigned*)(QDb + row * PITCH + c0) = pk2(q0[e] * E0, q1[e] * E1);
            *(LAS unsigned*)(KDb + row * PITCH + c0) = pk2(kd0, kd1);
            kt0[e] = kd0 * t0; kt1[e] = kd1 * t1;
        }
        {
            const int ks = re >> 2, hf = (re >> 1) & 1;
#pragma unroll
            for (int cc = 0; cc < 2; ++cc) {
                const int c = c0 + cc, kt = c >> 4, r = c & 15;
#pragma unroll
                for (int p = 0; p < 2; ++p) {
                    const int g = 2 * (re & 1) + p;
                    u32x2 w;
                    if (cc == 0) { w.x = pk2(kt0[4 * p], kt0[4 * p + 1]); w.y = pk2(kt0[4 * p + 2], kt0[4 * p + 3]); } else { w.x = pk2(kt1[4 * p], kt1[4 * p + 1]); w.y = pk2(kt1[4 * p + 2], kt1[4 * p + 3]); }
                    *(LAS u32x2*)(KTi + ((kt * 2 + ks) * 64 + g * 16 + r) * 16 + 8 * hf) = w;
                }
            }
        }
        __syncthreads();
        PROBE_END(62); PROBE_BEGIN(63);
        write_qd_image(F, QDb, PITCH, nullptr, rec);
        write_at_image(F, KDb, QDb, PITCH, nullptr, dir, rec + 16384);
        for (int i = F.tid; i < 1024; i += NTHR) *(u32x4*)(rec + 24576 + i * 16) = *(const LAS u32x4*)(KTi + i * 16);
        if (F.tid < 32) *(f32x4*)(rec + 40960 + F.tid * 16) = *(const LAS f32x4*)((LAS unsigned char*)etot + F.tid * 16);
        if (dir == 0) {
            unsigned char* vb = F.ws + WS_HVB + (size_t)(task >> 1) * 16384;
            const int c = F.lane & 15, g = F.lane >> 4, w = F.wave;
#pragma unroll
            for (int ks2 = 0; ks2 < 2; ++ks2) {
                unsigned short x[8];
#pragma unroll
                for (int j = 0; j < 8; ++j) x[j] = Vb[(32 * ks2 + kperm(g, j)) * PITCH + 16 * w + c];
                u32x4 o; o.x = x[0] | ((unsigned)x[1] << 16); o.y = x[2] | ((unsigned)x[3] << 16); o.z = x[4] | ((unsigned)x[5] << 16); o.w = x[6] | ((unsigned)x[7] << 16);
                *(u32x4*)(vb + ((w * 2 + ks2) * 64 + F.lane) * 16) = o;
            }
        }
        __syncthreads();
        PROBE_END(63);
    }
}

__device__ __forceinline__ int lp_rowoff(int a) { if (a == 0) return 0; const int A = a - 1, m = A >> 2, r = A & 3; return 8 * m * (m + 1) + 4 * r * (m + 1); }

__device__ __forceinline__ void p3g_invert(LAS float* Lp, int dir, int lane) {
    float T[64];
    const int j = lane;
#pragma unroll
    for (int t = 0; t < 64; ++t) {
        float a0 = 0.f, a1 = 0.f, a2 = 0.f, a3 = 0.f;
        const LAS float* lrow = Lp + lp_rowoff(t);
#pragma unroll
        for (int s4 = 0; s4 < (t + 3) / 4; ++s4) {
            const f32x4 l = *(const LAS f32x4*)(lrow + 4 * s4);
            if (4 * s4 + 0 < t) a0 += l[0] * T[4 * s4 + 0];
            if (4 * s4 + 1 < t) a1 += l[1] * T[4 * s4 + 1];
            if (4 * s4 + 2 < t) a2 += l[2] * T[4 * s4 + 2];
            if (4 * s4 + 3 < t) a3 += l[3] * T[4 * s4 + 3];
        }
        int jj = j; asm volatile("" : "+v"(jj));
        T[t] = (t == jj ? 1.f : 0.f) - ((a0 + a1) + (a2 + a3));
        asm volatile("" ::: "memory");
    }
    LAS bf16* Tb = (LAS bf16*)Lp;
    if (dir == 0) { LAS bf16* tp = Tb + j;
#pragma unroll
        for (int t = 0; t < 64; ++t) tp[t * 72] = (bf16)f2bf(T[t]);
    } else { LAS bf16* tp = Tb + (63 - j);
#pragma unroll
        for (int t = 0; t < 64; ++t) tp[(63 - t) * 72] = (bf16)f2bf(T[t]);
    }
}

__device__ __forceinline__ void p3g_load(Frame& F, int task, const bf16* BQ, const bf16* BK, const bf16* BV, const float* BETA, const float* GGp, u32x4 (&raw)[18], float& gbeta, float& ggate) {
    const int dir = task & 1, h = (task >> 1) & 3, cidx = task >> 3;
    int s, n; if (cidx < 64) { s = cidx >> 2; n = cidx & 3; } else { s = 16 + ((cidx - 64) >> 6); n = (cidx - 64) & 63; }
    const int i = F.tid >> 3, m = tok_b(s, n, i);
    int pos, len, dlt; if (s < 16) { pos = 64 * n + i; len = 256; dlt = 1; } else { pos = i; len = 64; dlt = 64; }
    const bool hasp = pos > 0, hasn = pos + 1 < len; const u32x4 zz = {0u, 0u, 0u, 0u};
#pragma unroll
    for (int a = 0; a < 3; ++a) {
        const bf16* src = (a == 0 ? BQ : (a == 1 ? BK : BV)) + (size_t)m * 512 + h * 128 + 16 * (F.tid & 7);
#pragma unroll
        for (int q = 0; q < 2; ++q) {
            raw[a * 6 + q * 3 + 0] = hasp ? *(const u32x4*)(src - (ptrdiff_t)dlt * 512 + 8 * q) : zz;
            raw[a * 6 + q * 3 + 1] = *(const u32x4*)(src + 8 * q);
            raw[a * 6 + q * 3 + 2] = hasn ? *(const u32x4*)(src + (ptrdiff_t)dlt * 512 + 8 * q) : zz;
        }
    }
    if (F.wave == 0) { const int mg = tok_b(s, n, F.lane); gbeta = BETA[(size_t)mg * 8 + dir * 4 + h]; ggate = GGp[(size_t)mg * 8 + dir * 4 + h]; }
}

__device__ __forceinline__ void p3_gdn(Frame& F, const int t0, const int tn, const int rank, const int nranks) {
    constexpr int PITCH = 136, TP = 72, NBMAX = 10, LSLOT = 9216;
    LAS unsigned char* slots = F.lds + 40960;
    LAS float* Cs = (LAS float*)(F.lds + 512);
    LAS float* Bs = Cs + 64;
    LAS float* Es = Cs + 128;
    LAS float* Ets = Cs + 192;
    LAS float* Sc = Cs + 256;
    LAS bf16* Qb = (LAS bf16*)(F.lds + 2048);
    LAS bf16* Kb = (LAS bf16*)(F.lds + 19456);
    LAS bf16* VT = (LAS bf16*)(F.lds + 2048);
    LAS bf16* KGT = (LAS bf16*)(F.lds + 20480);
    LAS float* Wc = (LAS float*)(F.lds + 133120);
    int wc_head = -1;
    const bf16* BQ = WSP(bf16, WS_BQ); const bf16* BK = WSP(bf16, WS_BK); const bf16* BV = WSP(bf16, WS_BV);
    const float* BETA = WSP(float, WS_BETA); const float* GGp = WSP(float, WS_GG);
    const float* convw = F.in[I_CONV];
    const int ntask = rank < tn ? (tn - rank + nranks - 1) / nranks : 0;
    for (int b0 = 0; b0 < ntask; b0 += NBMAX) {
      const int nb = ntask - b0 < NBMAX ? ntask - b0 : NBMAX;
      PROBE_BEGIN(51);
      u32x4 raw[18]; float gbeta = 0.f, ggate = 0.f;
#define P3G_LOAD(JT) p3g_load(F, t0 + rank + (b0 + (JT)) * nranks, BQ, BK, BV, BETA, GGp, raw, gbeta, ggate)
      if (nb > 0) P3G_LOAD(0);
      for (int jt = 0; jt < nb; ++jt) {
        const int task = t0 + rank + (b0 + jt) * nranks;
        const int dir = task & 1, h = (task >> 1) & 3, cidx = task >> 3;
        int s, n; if (cidx < 64) { s = cidx >> 2; n = cidx & 3; } else { s = 16 + ((cidx - 64) >> 6); n = (cidx - 64) & 63; }
        unsigned char* rec = grec_ptr(F, task);
        LAS float* Lp = (LAS float*)(slots + jt * LSLOT);
        if (h != wc_head) {
            __syncthreads();
            for (int idx = F.tid; idx < 1152; idx += NTHR) { const int a = idx / 384, r2 = idx % 384, tap = r2 >> 7, ch = r2 & 127; Wc[idx] = convw[tap * 1536 + a * 512 + h * 128 + ch]; }
            wc_head = h;
        }
        PROBE_BEGIN(54);
        if (F.wave == 0) {
            const float beta = gbeta;
            float c = ggate;
#pragma unroll
            for (int d = 1; d < 64; d <<= 1) { const float o = dir ? __shfl_down(c, d) : __shfl_up(c, d); const bool ok = dir ? (F.lane + d < 64) : (F.lane >= d); c += ok ? o : 0.f; }
            const float ctot = __shfl(c, dir ? 0 : 63);
            Cs[F.lane] = c; Bs[F.lane] = beta; Es[F.lane] = __expf(c); Ets[F.lane] = __expf(ctot - c);
            if (F.lane == 0) Sc[0] = __expf(ctot);
        }
        __syncthreads();
        PROBE_END(54); PROBE_BEGIN(55);
        {
            const int i = F.tid >> 3, seg = F.tid & 7, ch0 = 16 * seg;
            const float beta = Bs[i], kg = -beta * Es[i];
#pragma unroll
            for (int a = 0; a < 3; ++a) {
                float val[16];
                const LAS float* wc = Wc + a * 384 + ch0;
#pragma unroll
                for (int q = 0; q < 2; ++q) {
                    const u32x4 xm = raw[a * 6 + q * 3 + 0], x0 = raw[a * 6 + q * 3 + 1], xp = raw[a * 6 + q * 3 + 2];
                    f32x4 w0[2], w1[2], w2[2];
#pragma unroll
                    for (int hh = 0; hh < 2; ++hh) { w0[hh] = *(const LAS f32x4*)(wc + 8 * q + 4 * hh); w1[hh] = *(const LAS f32x4*)(wc + 128 + 8 * q + 4 * hh); w2[hh] = *(const LAS f32x4*)(wc + 256 + 8 * q + 4 * hh); }
#pragma unroll
                    for (int e = 0; e < 4; ++e) {
                        const int ch = 8 * q + 2 * e, hh = e >> 1, ee = 2 * (e & 1);
                        const float y0 = bflo(xm[e]) * w0[hh][ee] + bflo(x0[e]) * w1[hh][ee] + bflo(xp[e]) * w2[hh][ee];
                        const float y1 = bfhi(xm[e]) * w0[hh][ee + 1] + bfhi(x0[e]) * w1[hh][ee + 1] + bfhi(xp[e]) * w2[hh][ee + 1];
                        val[ch] = siluf(y0); val[ch + 1] = siluf(y1);
                    }
                }
                if (a < 2) {
                    float ss = 0.f;
#pragma unroll
                    for (int e = 0; e < 16; ++e) ss += val[e] * val[e];
                    ss += __shfl_xor(ss, 1); ss += __shfl_xor(ss, 2); ss += __shfl_xor(ss, 4);
                    const float rn = __builtin_amdgcn_rsqf(ss + EPS) * (a == 0 ? 0.08838834764831845f : 1.f);
                    unsigned pw[8];
#pragma unroll
                    for (int e = 0; e < 8; ++e) pw[e] = pk2(val[2 * e] * rn, val[2 * e + 1] * rn);
                    LAS bf16* dstp = (a == 0 ? Qb : Kb) + i * PITCH + ch0;
                    *(LAS u32x4*)(dstp) = (u32x4){pw[0], pw[1], pw[2], pw[3]}; *(LAS u32x4*)(dstp + 8) = (u32x4){pw[4], pw[5], pw[6], pw[7]};
                    if (a == 1) {
                        unsigned gw[8];
#pragma unroll
                        for (int e = 0; e < 8; ++e) gw[e] = pk2(kg * val[2 * e] * rn, kg * val[2 * e + 1] * rn);
                        u32x4* gp = (u32x4*)(rec + L_WN + (i * 128 + ch0) * 2);
                        gp[0] = (u32x4){gw[0], gw[1], gw[2], gw[3]}; gp[1] = (u32x4){gw[4], gw[5], gw[6], gw[7]};
                    }
                } else {
                    unsigned vw[8];
#pragma unroll
                    for (int e = 0; e < 8; ++e) vw[e] = pk2(beta * val[2 * e], beta * val[2 * e + 1]);
                    u32x4* vp = (u32x4*)(rec + L_U + (i * 128 + ch0) * 2);
                    vp[0] = (u32x4){vw[0], vw[1], vw[2], vw[3]}; vp[1] = (u32x4){vw[4], vw[5], vw[6], vw[7]};
                }
                asm volatile("" ::: "memory");
            }
            if (jt + 1 < nb) P3G_LOAD(jt + 1);
        }
        PROBE_END(55); PROBE_BEGIN(56);
        __syncthreads();
        {
            const int r = F.lane & 15, g = F.lane >> 4, tt = F.wave >> 1, sp = F.wave & 1;
            f32x4 a0 = {0.f, 0.f, 0.f, 0.f}, a1 = {0.f, 0.f, 0.f, 0.f};
#pragma unroll
            for (int kd = 0; kd < 4; ++kd) {
                const bf16x8 at = as_frag(*(const LAS u32x4*)(Kb + (16 * tt + r) * PITCH + 32 * kd + 8 * g));
                const bf16x8 b0 = as_frag(*(const LAS u32x4*)(Kb + (32 * sp + r) * PITCH + 32 * kd + 8 * g));
                const bf16x8 b1 = as_frag(*(const LAS u32x4*)(Kb + (32 * sp + 16 + r) * PITCH + 32 * kd + 8 * g));
                a0 = mfma16(at, b0, a0); a1 = mfma16(at, b1, a1);
            }
            const f32x4 ct4 = *(const LAS f32x4*)(Cs + 16 * tt + 4 * g), bt4 = *(const LAS f32x4*)(Bs + 16 * tt + 4 * g);
            const float csx0 = Cs[32 * sp + r], csx1 = Cs[32 * sp + 16 + r];
#pragma unroll
            for (int q = 0; q < 2; ++q)
#pragma unroll
                for (int i = 0; i < 4; ++i) {
                    const int t = 16 * tt + 4 * g + i, sx = 32 * sp + 16 * q + r;
                    const bool ok = dir ? (sx > t) : (sx < t);
                    const float v = bt4[i] * (q ? a1[i] : a0[i]) * __expf(ok ? ct4[i] - (q ? csx1 : csx0) : 0.f);
                    const int a = dir ? 63 - t : t, b = dir ? 63 - sx : sx;
                    if (ok) Lp[lp_rowoff(a) + b] = v;
                }
        }
        write_at_image(F, Kb, Qb, PITCH, Cs, dir, rec + L_AT);
        write_qd_image(F, Qb, PITCH, Es, rec + L_QD);
        {
            const int r = F.lane & 15, g = F.lane >> 4, kt = F.wave;
#pragma unroll
            for (int ks2 = 0; ks2 < 2; ++ks2) {
                float v[8];
                const f32x4 e0 = *(const LAS f32x4*)(Ets + 32 * ks2 + 4 * g), e1 = *(const LAS f32x4*)(Ets + 32 * ks2 + 16 + 4 * g);
#pragma unroll
                for (int j = 0; j < 8; ++j) { const int sx = 32 * ks2 + kperm(g, j); v[j] = bf2f(Kb[sx * PITCH + 16 * kt + r]) * ((j < 4) ? e0[j & 3] : e1[j & 3]); }
                u32x4 o; o.x = pk2(v[0], v[1]); o.y = pk2(v[2], v[3]); o.z = pk2(v[4], v[5]); o.w = pk2(v[6], v[7]);
                *(u32x4*)(rec + L_KT + ((kt * 2 + ks2) * 64 + F.lane) * 16) = o;
            }
        }
        if (F.tid == 0) *(float*)(rec + L_SC) = Sc[0];
        __syncthreads();
        PROBE_END(56);
      }
#undef P3G_LOAD
      PROBE_END(51); PROBE_BEGIN(52);
      asm volatile("s_waitcnt vmcnt(0)" ::: "memory");
      for (int jt = F.wave; jt < nb; jt += NWAVES) { const int task = t0 + rank + (b0 + jt) * nranks; p3g_invert((LAS float*)(slots + jt * LSLOT), task & 1, F.lane); }
      __syncthreads();
      PROBE_END(52); PROBE_BEGIN(53);
      u32x4 pv[2], pk[2];
      { unsigned char* rec0 = grec_ptr(F, t0 + rank + b0 * nranks);
#pragma unroll
        for (int q = 0; q < 2; ++q) { const int p = F.lane * 16 + F.wave + 8 * q; pv[q] = *(const u32x4*)(rec0 + L_U + p * 16); pk[q] = *(const u32x4*)(rec0 + L_WN + p * 16); } }
      for (int jt = 0; jt < nb; ++jt) {
        const int task = t0 + rank + (b0 + jt) * nranks;
        unsigned char* rec = grec_ptr(F, task);
        const LAS bf16* Tm = (const LAS bf16*)(slots + jt * LSLOT);
        PROBE_BEGIN(57);
#pragma unroll
        for (int q = 0; q < 2; ++q) {
            const int i = F.lane, c8 = (F.wave + 8 * q) * 8;
            const u32x4 vv = pv[q], kk = pk[q];
            LAS bf16* vt = VT + c8 * TP + i; LAS bf16* kt = KGT + c8 * TP + i;
#pragma unroll
            for (int e = 0; e < 4; ++e) { vt[(2 * e) * TP] = (bf16)(vv[e] & 0xffffu); vt[(2 * e + 1) * TP] = (bf16)(vv[e] >> 16); kt[(2 * e) * TP] = (bf16)(kk[e] & 0xffffu); kt[(2 * e + 1) * TP] = (bf16)(kk[e] >> 16); }
        }
        if (jt + 1 < nb) { unsigned char* rec1 = grec_ptr(F, task + nranks);
#pragma unroll
            for (int q = 0; q < 2; ++q) { const int p = F.lane * 16 + F.wave + 8 * q; pv[q] = *(const u32x4*)(rec1 + L_U + p * 16); pk[q] = *(const u32x4*)(rec1 + L_WN + p * 16); } }
        __syncthreads();
        PROBE_END(57); PROBE_BEGIN(58);
        {
            const int r = F.lane & 15, g = F.lane >> 4;
            {
                const int w = F.wave;
                bf16x8 bv[2];
#pragma unroll
                for (int ks2 = 0; ks2 < 2; ++ks2) bv[ks2] = as_frag(*(const LAS u32x4*)(VT + (16 * w + r) * TP + 32 * ks2 + 8 * g));
#pragma unroll
                for (int mt = 0; mt < 4; ++mt) {
                    f32x4 a = {0.f, 0.f, 0.f, 0.f};
#pragma unroll
                    for (int ks2 = 0; ks2 < 2; ++ks2) a = mfma16(as_frag(*(const LAS u32x4*)(Tm + (16 * mt + r) * TP + 32 * ks2 + 8 * g)), bv[ks2], a);
                    u32x2 o; o.x = pk2(a[0], a[1]); o.y = pk2(a[2], a[3]);
                    *(u32x2*)(rec + L_U + ((w * 4 + mt) * 64 + F.lane) * 8) = o;
                }
            }
            {
                const int mt = F.wave >> 1;
                bf16x8 bt[2];
#pragma unroll
                for (int ks2 = 0; ks2 < 2; ++ks2) bt[ks2] = as_frag(*(const LAS u32x4*)(Tm + (16 * mt + r) * TP + 32 * ks2 + 8 * g));
#pragma unroll
                for (int q = 0; q < 2; ++q) {
                    const int ks = 2 * (F.wave & 1) + q;
                    f32x4 a0 = {0.f, 0.f, 0.f, 0.f}, a1 = {0.f, 0.f, 0.f, 0.f};
#pragma unroll
                    for (int ks2 = 0; ks2 < 2; ++ks2) {
                        a0 = mfma16(as_frag(*(const LAS u32x4*)(KGT + (32 * ks + r) * TP + 32 * ks2 + 8 * g)), bt[ks2], a0);
                        a1 = mfma16(as_frag(*(const LAS u32x4*)(KGT + (32 * ks + 16 + r) * TP + 32 * ks2 + 8 * g)), bt[ks2], a1);
                    }
                    u32x4 o; o.x = pk2(a0[0], a0[1]); o.y = pk2(a0[2], a0[3]); o.z = pk2(a1[0], a1[1]); o.w = pk2(a1[2], a1[3]);
                    *(u32x4*)(rec + L_WN + ((mt * 4 + ks) * 64 + F.lane) * 16) = o;
                }
            }
        }
        __syncthreads();
        PROBE_END(58);
      }
      PROBE_END(53);
    }
}

template <bool GDN>
__device__ __forceinline__ void p4_chain(Frame& F) {
    LAS unsigned char* img = F.lds;
    const int c = F.lane & 15, g = F.lane >> 4;
    const float* st_in = F.in[GDN ? I_SG : I_SH];
    float* st_out = F.out + OUT_Y_FLOATS + (GDN ? STATE_FLOATS : 0);
    bf16* Obase = GDN ? WSP(bf16, WS_OB) : OUTB(bf16, OUT_OA);
    constexpr int N16 = GDN ? GREC / 16 : HREC / 16;
    constexpr int NPC = ((GDN ? GREC : HREC) + 1023) / 1024;
    gu32* prog = (gu32*)(F.ws + WS_CTL) + (GDN ? CW_PROG_G : CW_PROG_H);
    const bool roles = (F.G == 256);
    if (roles && F.bid >= 64 && F.bid < 128) {
        const int hb = F.bid - 64, u = hb & 31, j0 = hb >> 5;
        const int s = 16 + (u >> 3), h = (u >> 1) & 3, dir = u & 1, N = 64;
        u32x4 dummy = {0u, 0u, 0u, 0u};
        for (int st = j0; st < N; st += 2) {
            for (unsigned sp = 0; sp < (1u << 15); ++sp) { const unsigned p = __hip_atomic_load(prog + 64 * u, RLX_AGENT); if ((int)p + P4_PD > st) break; __builtin_amdgcn_s_sleep(8); }
            const int n = dir ? N - 1 - st : st; const int uc = uc_index(s, n, h, dir);
            const unsigned char* rec = GDN ? grec_ptr(F, uc) : hrec_ptr(F, uc);
            for (int idx = F.tid; idx < N16; idx += NTHR) { const unsigned char* p = rec + (size_t)idx * 16; asm volatile("global_load_dwordx4 %0, %1, off" : "+v"(dummy) : "v"(p) : "memory"); }
            if (!GDN) { const unsigned char* vb = F.ws + WS_HVB + (size_t)(uc >> 1) * 16384;
                for (int idx = F.tid; idx < 1024; idx += NTHR) { const unsigned char* p = vb + (size_t)idx * 16; asm volatile("global_load_dwordx4 %0, %1, off" : "+v"(dummy) : "v"(p) : "memory"); } }
        }
        asm volatile("s_waitcnt vmcnt(0)" : "+v"(dummy) :: "memory");
        return;
    }
    for (int uidx0 = F.bid; uidx0 < (roles ? 256 : 160); uidx0 += F.G) {
        int uidx = uidx0, ncw = 8, sl0 = 0;
        if (roles) { if (uidx0 >= 128) uidx = uidx0 - 96; else { uidx = uidx0 & 31; ncw = 4; sl0 = 4 * (uidx0 >> 5); } }
        const bool lead = roles && uidx0 < 32;
        const int w = sl0 + F.wave; const bool comp = F.wave < ncw;
        const int dwn = ncw < 8 ? 8 - ncw : 8, dw0 = ncw < 8 ? F.wave - ncw : F.wave;
        int s, h, dir;
        if (uidx < 32) { s = 16 + (uidx >> 3); h = (uidx >> 1) & 3; dir = uidx & 1; } else { const int j = uidx - 32; s = j >> 3; h = (j >> 1) & 3; dir = j & 1; }
        const int N = seq_nchunk(s), bq = s < 16 ? s : s - 16;
        f32x4 S[8];
        if (!comp) {
#pragma unroll
            for (int kt = 0; kt < 8; ++kt) S[kt] = (f32x4){0.f, 0.f, 0.f, 0.f};
        } else if (s >= 16) {
            const float* sp = st_in + (size_t)((bq * 2 + dir) * 4 + h) * 16384 + 16 * w + c;
#pragma unroll
            for (int kt = 0; kt < 8; ++kt)
#pragma unroll
                for (int i = 0; i < 4; ++i) S[kt][i] = sp[(16 * kt + 4 * g + i) * 128];
        } else {
#pragma unroll
            for (int kt = 0; kt < 8; ++kt) S[kt] = (f32x4){0.f, 0.f, 0.f, 0.f};
        }
#define P4_DMA(STEP, BUF) do { \
            const int n_ = dir ? N - 1 - (STEP) : (STEP); const int uc_ = uc_index(s, n_, h, dir); \
            const unsigned char* rec_ = (GDN ? grec_ptr(F, uc_) : hrec_ptr(F, uc_)) + F.lane * 16; \
            LAS unsigned char* dst_ = F.lds + (BUF) * P4_BUF + (GDN ? 0 : L_QD); \
            for (int p = dw0; p < NPC; p += dwn) __builtin_amdgcn_global_load_lds((const unsigned*)(rec_ + (size_t)p * 1024), (LAS unsigned*)(dst_ + p * 1024), 16, 0, 0); \
            if (!GDN) { const unsigned char* vb_ = F.ws + WS_HVB + (size_t)(uc_ >> 1) * 16384 + F.lane * 16; LAS unsigned char* dv_ = F.lds + (BUF) * P4_BUF + L_WN; \
                for (int p = dw0; p < 16; p += dwn) __builtin_amdgcn_global_load_lds((const unsigned*)(vb_ + (size_t)p * 1024), (LAS unsigned*)(dv_ + p * 1024), 16, 0, 0); } \
        } while (0)
#define FRAG(off, idx) (*(const LAS u32x4*)(img + (off) + ((idx) * 64 + F.lane) * 16))
        if (dw0 >= 0) P4_DMA(0, 0);
        asm volatile("s_waitcnt vmcnt(0)" ::: "memory");
        __syncthreads();
        for (int step = 0; step < N; ++step) {
            PROBE_BEGIN(GDN ? 2 : 12);
            const int cur = step & 1;
            LAS unsigned char* img = F.lds + cur * P4_BUF;
            if (lead && F.tid == 0) __hip_atomic_store(prog + 64 * uidx, (unsigned)(step + 1), RLX_AGENT);
            PROBE_BEGIN(GDN ? 21 : 31);
            if (step + 1 < N && dw0 >= 0) P4_DMA(step + 1, cur ^ 1);
            PROBE_END(GDN ? 21 : 31);
            const int n = dir ? N - 1 - step : step;
            if (comp) {
            PROBE_BEGIN(GDN ? 22 : 32);
            bf16x8 Sb[4];
#pragma unroll
            for (int ks = 0; ks < 4; ++ks) { u32x4 o; o.x = pk2(S[2 * ks][0], S[2 * ks][1]); o.y = pk2(S[2 * ks][2], S[2 * ks][3]); o.z = pk2(S[2 * ks + 1][0], S[2 * ks + 1][1]); o.w = pk2(S[2 * ks + 1][2], S[2 * ks + 1][3]); Sb[ks] = as_frag(o); }
            bf16x8 Xb[2];
            u32x4 fa[8], fb[8];
            f32x4 O[4];
            if (GDN) {
                f32x4 X[4];
#pragma unroll
                for (int mt = 0; mt < 4; ++mt)
#pragma unroll
                    for (int k = 0; k < 2; ++k) fa[mt * 2 + k] = FRAG(L_WN, mt * 4 + k);
#pragma unroll
                for (int mt = 0; mt < 4; ++mt)
#pragma unroll
                    for (int k = 0; k < 2; ++k) fb[mt * 2 + k] = FRAG(L_WN, mt * 4 + 2 + k);
#pragma unroll
                for (int mt = 0; mt < 4; ++mt) { const u32x2 uu = *(const LAS u32x2*)(img + L_U + ((w * 4 + mt) * 64 + F.lane) * 8); X[mt] = (f32x4){bflo(uu.x), bfhi(uu.x), bflo(uu.y), bfhi(uu.y)}; }
#pragma unroll
                for (int k = 0; k < 2; ++k)
#pragma unroll
                    for (int mt = 0; mt < 4; ++mt) X[mt] = mfma16(as_frag(fa[mt * 2 + k]), Sb[k], X[mt]);
#pragma unroll
                for (int mt = 0; mt < 4; ++mt)
#pragma unroll
                    for (int k = 0; k < 2; ++k) fa[mt * 2 + k] = FRAG(L_QD, mt * 4 + k);
#pragma unroll
                for (int k = 0; k < 2; ++k)
#pragma unroll
                    for (int mt = 0; mt < 4; ++mt) X[mt] = mfma16(as_frag(fb[mt * 2 + k]), Sb[2 + k], X[mt]);
#pragma unroll
                for (int k2 = 0; k2 < 2; ++k2) { u32x4 o; o.x = pk2(X[2 * k2][0], X[2 * k2][1]); o.y = pk2(X[2 * k2][2], X[2 * k2][3]); o.z = pk2(X[2 * k2 + 1][0], X[2 * k2 + 1][1]); o.w = pk2(X[2 * k2 + 1][2], X[2 * k2 + 1][3]); Xb[k2] = as_frag(o); }
            } else {
#pragma unroll
                for (int k2 = 0; k2 < 2; ++k2) Xb[k2] = as_frag(FRAG(L_WN, w * 2 + k2));
#pragma unroll
                for (int mt = 0; mt < 4; ++mt)
#pragma unroll
                    for (int k = 0; k < 2; ++k) fa[mt * 2 + k] = FRAG(L_QD, mt * 4 + k);
            }
            PROBE_END(GDN ? 22 : 32); PROBE_BEGIN(GDN ? 23 : 33);
#pragma unroll
            for (int mt = 0; mt < 4; ++mt)
#pragma unroll
                for (int k = 0; k < 2; ++k) fb[mt * 2 + k] = FRAG(L_QD, mt * 4 + 2 + k);
#pragma unroll
            for (int mt = 0; mt < 4; ++mt) O[mt] = (f32x4){0.f, 0.f, 0.f, 0.f};
#pragma unroll
            for (int k = 0; k < 2; ++k)
#pragma unroll
                for (int mt = 0; mt < 4; ++mt) O[mt] = mfma16(Sb[k], as_frag(fa[mt * 2 + k]), O[mt]);
#pragma unroll
            for (int i = 0; i < 8; ++i) fa[i] = FRAG(L_AT, i);
#pragma unroll
            for (int k = 0; k < 2; ++k)
#pragma unroll
                for (int mt = 0; mt < 4; ++mt) O[mt] = mfma16(Sb[2 + k], as_frag(fb[mt * 2 + k]), O[mt]);
#pragma unroll
            for (int i = 0; i < 8; ++i) fb[i] = FRAG(L_KT, i);
#pragma unroll
            for (int k2 = 0; k2 < 2; ++k2)
#pragma unroll
                for (int mt = 0; mt < 4; ++mt) O[mt] = mfma16(Xb[k2], as_frag(fa[mt * 2 + k2]), O[mt]);
#pragma unroll
            for (int i = 0; i < 8; ++i) fa[i] = FRAG(L_KT, 8 + i);
            PROBE_END(GDN ? 23 : 33); PROBE_BEGIN(GDN ? 24 : 34);
            {
                f32x4 d[8];
                if (GDN) { const float ds = *(const LAS float*)(img + L_SC);
#pragma unroll
                    for (int kt = 0; kt < 8; ++kt) d[kt] = (f32x4){ds, ds, ds, ds}; }
                else {
#pragma unroll
                    for (int kt = 0; kt < 8; ++kt) d[kt] = *(const LAS f32x4*)(img + L_U + (16 * kt + 4 * g) * 4); }
#pragma unroll
                for (int kt = 0; kt < 8; ++kt) S[kt] = S[kt] * d[kt];
            }
#pragma unroll
            for (int k2 = 0; k2 < 2; ++k2)
#pragma unroll
                for (int kt = 0; kt < 4; ++kt) S[kt] = mfma16(as_frag(fb[kt * 2 + k2]), Xb[k2], S[kt]);
#pragma unroll
            for (int k2 = 0; k2 < 2; ++k2)
#pragma unroll
                for (int kt = 0; kt < 4; ++kt) S[4 + kt] = mfma16(as_frag(fa[kt * 2 + k2]), Xb[k2], S[4 + kt]);
            PROBE_END(GDN ? 24 : 34); PROBE_BEGIN(GDN ? 25 : 35);
#pragma unroll
            for (int mt = 0; mt < 4; ++mt) {
                const int li = 16 * mt + c;
                const int m = GDN ? tok_b(s, n, li) : tok_a(s, n, li);
                u32x2 o; o.x = pk2(O[mt][0], O[mt][1]); o.y = pk2(O[mt][2], O[mt][3]);
                *(u32x2*)(Obase + (size_t)dir * (10 * MiB) + (size_t)m * 512 + h * 128 + 16 * w + 4 * g) = o;
            }
            PROBE_END(GDN ? 25 : 35);
            }
            PROBE_END(GDN ? 2 : 12); PROBE_BEGIN(GDN ? 3 : 13);
            asm volatile("s_waitcnt vmcnt(0)" ::: "memory");
            __syncthreads();
            PROBE_END(GDN ? 3 : 13);
        }
#undef P4_DMA
#undef FRAG
        if (s < 16 && comp) {
            float* sp = st_out + (size_t)((bq * 2 + dir) * 4 + h) * 16384 + 16 * w + c;
#pragma unroll
            for (int kt = 0; kt < 8; ++kt)
#pragma unroll
                for (int i = 0; i < 4; ++i) sp[(16 * kt + 4 * g + i) * 128] = S[kt][i];
        }
    }
    if (GDN && roles && F.bid >= 128) { __syncthreads(); late_weights(F, (F.bid - 128) * NWAVES + F.wave, 128 * NWAVES); }
    if (!GDN && roles && F.bid >= 128) { __syncthreads(); p3_gdn(F, NUC - NR_EARLY, NR_EARLY, F.bid - 128, 128); }
}

constexpr int NPHASE = 13;
__global__ void __launch_bounds__(NTHR, 2) mk_fwd(Args args) {
    extern __shared__ __attribute__((aligned(16))) unsigned char lds_raw[];
    Frame F;
    F.lds = (LAS unsigned char*)lds_raw;
    F.tid = threadIdx.x; F.lane = F.tid & 63; F.wave = __builtin_amdgcn_readfirstlane(F.tid >> 6);
    F.bid = blockIdx.x; F.G = gridDim.x;
#pragma unroll
    for (int i = 0; i < N_IN; ++i) F.in[i] = args.in[i];
    F.out = args.out; F.ws = args.ws; F.pacc = 0ull; F.pt0 = 0ull;
    volatile LAS unsigned* MISC = (volatile LAS unsigned*)(F.lds + MISC_OFF);
    for (int u = F.tid; u < (LDS_BYTES - LDSCTL_OFF) / 4; u += NTHR) ((LAS unsigned*)(F.lds + LDSCTL_OFF))[u] = 0u;
    __syncthreads();
    const int lo = args.ph_lo, hi = args.ph_hi;
    const bool multi = (hi - lo) > 1;
    XcdBarrier bar; bar.bar = (unsigned*)(F.ws + WS_CTL) + CW_BAR; bar.x = 0; bar.st = nullptr;
    if (multi) bar = xcd_barrier_post((unsigned*)(F.ws + WS_CTL) + CW_BAR, MISC + 8);
#ifndef PH_MASK
#define PH_MASK 0x1fff
#endif
#define IN(k) (((PH_MASK >> (k)) & 1) && lo <= (k) && (k) < hi)
#define SEAM(k) do { if (IN(k) && IN((k) + 1)) xcd_barrier(bar); } while (0)
#define NREP(k) ((((REP_MASK) >> (k)) & 1) ? 2 : 1)
#define REPSYNC(k) do { if (((REP_MASK) >> (k)) & 1) xcd_barrier(bar); } while (0)

    PROBE_BEGIN(100);
    if (IN(0)) for (int rep = 0; rep < NREP(0); ++rep) { if (rep) REPSYNC(0); p0_prologue(F); } SEAM(0); PROBE_END(100);
    PROBE_BEGIN(101);
    if (IN(1)) for (int rep = 0; rep < NREP(1); ++rep) { if (rep) REPSYNC(1); modnorm_rows(F, F.in[I_XP], F.in[I_XS], F.in[I_N1], 0, 1024, WSP(bf16, WS_H)); } SEAM(1); PROBE_END(101);
    PROBE_BEGIN(102);
    if (IN(2)) for (int rep = 0; rep < NREP(2); ++rep) { if (rep) REPSYNC(2);
        pg8::Gemm g{WSP(bf16, WS_H), WSP(bf16, WS_WIN), NT, NPAD, DM}; pg8::StaticOrder S; S.init(NT, NPAD, DM, F.G, F.bid);
        pg8::EpiProj E;
        E.d0 = OUTB(bf16, OUT_QA); E.d1 = OUTB(bf16, OUT_GF); E.d2 = OUTB(bf16, OUT_GB); E.d3 = OUTB(bf16, OUT_VA); E.d4 = WSP(bf16, WS_AG);
        E.d5 = WSP(bf16, WS_BQ); E.d6 = WSP(bf16, WS_BK); E.d7 = WSP(bf16, WS_BV); E.d8 = WSP(bf16, WS_BZ);
        E.BETA = WSP(float, WS_BETA); E.GG = WSP(float, WS_GG); E.lbraw = F.in[I_LB]; E.Alog = F.in[I_ALOG]; E.dtb = F.in[I_DTB];
        pg8::gemm_phase<pg8::EpiProj, pg8::StaticOrder, true, true>(F.lds, g, S, E);
    } SEAM(2); PROBE_END(102);
    PROBE_BEGIN(103);
    if (IN(3)) for (int rep = 0; rep < NREP(3); ++rep) { if (rep) REPSYNC(3); p3_hgrn(F); } SEAM(3); PROBE_END(103);
    PROBE_BEGIN(104);
    if (IN(4)) for (int rep = 0; rep < NREP(4); ++rep) { if (rep) REPSYNC(4); p4_chain<false>(F); } SEAM(4); PROBE_END(104);
    PROBE_BEGIN(105);
    if (IN(5)) for (int rep = 0; rep < NREP(5); ++rep) { if (rep) REPSYNC(5); p3_gdn(F, 0, (F.G == 256) ? NUC - NR_EARLY : NUC, F.bid, F.G); } SEAM(5); PROBE_END(105);
    PROBE_BEGIN(106);
    if (IN(6)) for (int rep = 0; rep < NREP(6); ++rep) { if (rep) REPSYNC(6); p4_chain<true>(F); } SEAM(6); PROBE_END(106);
    PROBE_BEGIN(107);
    if (IN(7)) for (int rep = 0; rep < NREP(7); ++rep) { if (rep) REPSYNC(7); if (F.G != 256) late_weights(F, F.bid * NWAVES + F.wave, F.G * NWAVES); p5_headnorm(F); } SEAM(7); PROBE_END(107);
    PROBE_BEGIN(108);
    if (IN(8)) for (int rep = 0; rep < NREP(8); ++rep) { if (rep) REPSYNC(8);
        pg8::Gemm g{WSP(bf16, WS_YIN), WSP(bf16, WS_WOUT), NT, DM, DM}; pg8::SplitOrder S; S.init(NT, DM, DM, F.G, F.bid);
        pg8::EpiSplit<pg8::EpiRes> E{{F.in[I_XP], F.in[I_XS], F.out, WSP(float, WS_MOD), 2048, nullptr, nullptr, nullptr}, WSP(float, WS_SLAB), (unsigned*)(F.ws + WS_CTL) + CW_SPLIT6, (LAS unsigned*)(F.lds + MISC_OFF + 64)};
        pg8::gemm_phase<pg8::EpiSplit<pg8::EpiRes>, pg8::SplitOrder, true, true>(F.lds, g, S, E);
    } SEAM(8); PROBE_END(108);
    PROBE_BEGIN(109);
    if (IN(9)) for (int rep = 0; rep < NREP(9); ++rep) { if (rep) REPSYNC(9); modnorm_rows(F, F.out, F.out + (size_t)NCTX * DM, F.in[I_N2], 3072, 4096, WSP(bf16, WS_H2)); } SEAM(9); PROBE_END(109);
    PROBE_BEGIN(110);
    if (IN(10)) for (int rep = 0; rep < NREP(10); ++rep) { if (rep) REPSYNC(10);
        pg8::Gemm g{WSP(bf16, WS_H2), WSP(bf16, WS_WGU), NT, 2 * DFF, DM}; pg8::StaticOrder S; S.init(NT, 2 * DFF, DM, F.G, F.bid);
        pg8::EpiGU E{WSP(bf16, WS_GU)};
        pg8::gemm_phase<pg8::EpiGU, pg8::StaticOrder, true, true>(F.lds, g, S, E);
    } SEAM(10); PROBE_END(110);
    PROBE_BEGIN(111);
    if (IN(11)) for (int rep = 0; rep < NREP(11); ++rep) { if (rep) REPSYNC(11);
        pg8::Gemm g{WSP(bf16, WS_GU), WSP(bf16, WS_WDN), NT, DM, DFF}; pg8::SplitOrder S; S.init(NT, DM, DFF, F.G, F.bid);
        pg8::EpiSplit<pg8::EpiRes> E{{F.out, F.out + (size_t)NCTX * DM, F.out, WSP(float, WS_MOD), 5120, nullptr, nullptr, nullptr}, WSP(float, WS_SLAB), (unsigned*)(F.ws + WS_CTL) + CW_SPLIT9, (LAS unsigned*)(F.lds + MISC_OFF + 64)};
        pg8::gemm_phase<pg8::EpiSplit<pg8::EpiRes>, pg8::SplitOrder, true, true>(F.lds, g, S, E);
    } SEAM(11); PROBE_END(111);
    PROBE_BEGIN(112);
    if (IN(12)) for (int rep = 0; rep < NREP(12); ++rep) { if (rep) REPSYNC(12); final_norm(F); }
    PROBE_END(112);
    if (PROBE_ID != 0 && blockIdx.x == PROBE_BLK && threadIdx.x == 0) { const unsigned long long t0 = __builtin_amdgcn_s_memrealtime(), dt = F.pacc * PROBE_K; while (__builtin_amdgcn_s_memrealtime() - t0 < dt) __builtin_amdgcn_s_sleep(16); }
#undef IN
#undef SEAM
}

extern "C" void kernel_launch(void* const* d_in, const int* in_sizes, int n_in, void* d_out, int out_size, void* d_ws, size_t ws_size, hipStream_t stream) {
    static int grid = 0;
    if (grid == 0) {
        if (n_in != N_IN || ws_size < WS_END) { fprintf(stderr, "kernel_launch: unexpected n_in %d / ws %zu\n", n_in, ws_size); grid = -1; return; }
        int dev = 0, cus = 0;
        if (hipGetDevice(&dev) != hipSuccess || hipDeviceGetAttribute(&cus, hipDeviceAttributeMultiprocessorCount, dev) != hipSuccess) { grid = -1; return; }
        if (hipFuncSetAttribute((const void*)mk_fwd, hipFuncAttributeMaxDynamicSharedMemorySize, LDS_BYTES) != hipSuccess) { fprintf(stderr, "kernel_launch: hipFuncSetAttribute failed\n"); grid = -1; return; }
        int per_cu = 0;
        if (hipOccupancyMaxActiveBlocksPerMultiprocessor(&per_cu, (const void*)mk_fwd, NTHR, LDS_BYTES) != hipSuccess || per_cu < 1) { fprintf(stderr, "kernel_launch: occupancy query reports %d\n", per_cu); }
        (void)hipGetLastError();
        grid = cus;
    }
    if (grid < 0) return;
    (void)hipMemsetAsync((char*)d_ws + WS_CTL, 0, CTL_ZERO_BYTES, stream);
    Args a{};
    for (int i = 0; i < N_IN; ++i) a.in[i] = (const float*)d_in[i];
    a.out = (float*)d_out; a.ws = (unsigned char*)d_ws;
#if MK_ONE_LAUNCH
    a.ph_lo = 0; a.ph_hi = NPHASE;
    hipLaunchKernelGGL(mk_fwd, dim3(grid), dim3(NTHR), LDS_BYTES, stream, a);
#else
    for (int k = 0; k < NPHASE; ++k) { a.ph_lo = k; a.ph_hi = k + 1; hipLaunchKernelGGL(mk_fwd, dim3(grid), dim3(NTHR), LDS_BYTES, stream, a); }
#endif
}
```

```cpp
#include <hip/hip_runtime.h>
#include <cstdio>
#include <cstdint>

#ifndef REP_MASK
#define REP_MASK 0x0
#endif
#ifndef PROBE_ID
#define PROBE_ID 0
#endif
#define PROBE_K 1
#ifndef PROBE_BLK
#define PROBE_BLK 0
#endif
#ifndef MK_ONE_LAUNCH
#define MK_ONE_LAUNCH 1
#endif

#define LAS __attribute__((address_space(3)))
#define GAS __attribute__((address_space(1)))
typedef unsigned short bf16;
typedef short bf16x8 __attribute__((ext_vector_type(8)));
typedef float f32x4 __attribute__((ext_vector_type(4)));
typedef float f32x2 __attribute__((ext_vector_type(2)));
typedef unsigned u32x4 __attribute__((ext_vector_type(4)));
typedef unsigned u32x2 __attribute__((ext_vector_type(2)));
typedef GAS unsigned gu32;

constexpr int NT = 20480, NCTX = 4096, DM = 1024, DPROJ = 4624, NPAD = 4864, DFF = 2816, NSEQ = 20;
constexpr float EPS = 1e-6f;
constexpr int NWAVES = 8, NTHR = 512;
enum { I_XP = 0, I_XS, I_C, I_SH, I_SG, I_CCTX, I_WADA, I_BADA, I_N1, I_N2, I_WIN, I_CONV, I_LB, I_ALOG, I_DTB, I_HNORM, I_GNORM, I_WOUT, I_WGATE, I_WUP, I_WDOWN, I_NF, N_IN };

constexpr size_t MiB = 1u << 20;
constexpr size_t WS_CTL = 0, CTL_ZERO_BYTES = 2 * MiB;
constexpr size_t WS_MOD = 1 * MiB;
constexpr size_t WS_BETA = 2 * MiB, WS_GG = 3 * MiB;
constexpr size_t WS_BQ = 4 * MiB, WS_BK = 24 * MiB, WS_BV = 44 * MiB;
constexpr size_t WS_OB = 4 * MiB;
constexpr size_t WS_AG = 64 * MiB, WS_BZ = 84 * MiB;
constexpr size_t WS_I = 104 * MiB;
constexpr size_t WS_H = 104 * MiB;
constexpr size_t WS_WIN = 144 * MiB;
constexpr size_t WS_YIN = 104 * MiB;
constexpr size_t WS_WOUT = 44 * MiB, WS_WGU = 46 * MiB, WS_WDN = 57 * MiB;
constexpr size_t WS_H2 = 4 * MiB;
constexpr size_t WS_GU = 64 * MiB;
constexpr size_t WS_SLAB = 160 * MiB;
constexpr size_t WS_END = 256 * MiB;
constexpr size_t OUT_QA = 0, OUT_VA = 20 * MiB, OUT_GF = 40 * MiB, OUT_GB = 60 * MiB, OUT_OA = 0, OUT_GOVF = 40 * MiB;
constexpr size_t OUT_Y_FLOATS = (size_t)NT * DM, STATE_FLOATS = (size_t)16 * 2 * 4 * 128 * 128;
constexpr int HREC = 41472;
constexpr int GREC = 73984;
constexpr int NUC = 2560, NVB = 1280;
constexpr size_t WS_HVB = WS_I + (size_t)NUC * HREC;
constexpr int N1G = 2154;
static_assert((size_t)N1G * GREC <= 152 * MiB && (size_t)(NUC - N1G) * GREC <= 40 * MiB, "GDN image split");
constexpr int NR_EARLY = 768;
static_assert(WS_I + (size_t)(NUC - NR_EARLY) * GREC >= WS_I + (size_t)NUC * HREC + (size_t)NVB * 16384, "early GDN records must not touch the HGRN images");
static_assert(WS_HVB + (size_t)NVB * 16384 <= WS_END, "HGRN images fit");
constexpr int L_WN = 0, L_QD = 16384, L_AT = 32768, L_KT = 40960, L_U = 57344, L_SC = 73728;

constexpr int CW_BAR = 4096;
constexpr int CW_PROG_H = 16384, CW_PROG_G = 16384 + 64 * 32;
constexpr int P4_PD = 4;
constexpr int CW_SPLIT6 = 32768, CW_SPLIT9 = 32768 + 64 * 64;
constexpr int P4_BUF = 74752;
constexpr int RING_BYTES = 2 * P4_BUF, LDSCTL_OFF = RING_BYTES, MISC_OFF = LDSCTL_OFF + 320, LDS_BYTES = RING_BYTES + 1024;
static_assert(RING_BYTES >= 131072 && LDS_BYTES <= 163840, "LDS map");

#define PROBE_BEGIN(id) do { if (PROBE_ID == (id) && blockIdx.x == PROBE_BLK && threadIdx.x == 0) probe_t0 = __builtin_amdgcn_s_memrealtime(); } while (0)
#define PROBE_END(id) do { if (PROBE_ID == (id) && blockIdx.x == PROBE_BLK && threadIdx.x == 0) probe_acc += __builtin_amdgcn_s_memrealtime() - probe_t0; } while (0)
#define LDS_WAIT() asm volatile("s_waitcnt lgkmcnt(0)" ::: "memory")
#define VM_WAIT() asm volatile("s_waitcnt vmcnt(0)" ::: "memory")
#define RLX_AGENT __ATOMIC_RELAXED, __HIP_MEMORY_SCOPE_AGENT
__device__ __forceinline__ unsigned f2bf(float f) { unsigned u = __builtin_bit_cast(unsigned, f); return (u + 0x7fffu + ((u >> 16) & 1u)) >> 16; }
__device__ __forceinline__ unsigned pk2(float lo, float hi) { return f2bf(lo) | (f2bf(hi) << 16); }
__device__ __forceinline__ float bflo(unsigned w) { return __builtin_bit_cast(float, w << 16); }
__device__ __forceinline__ float bfhi(unsigned w) { return __builtin_bit_cast(float, w & 0xffff0000u); }
__device__ __forceinline__ float bf2f(unsigned short h) { return __builtin_bit_cast(float, (unsigned)h << 16); }
__device__ __forceinline__ float siluf(float x) { return x * __builtin_amdgcn_rcpf(1.f + __expf(-x)); }
__device__ __forceinline__ float sigmf(float x) { return __builtin_amdgcn_rcpf(1.f + __expf(-x)); }
__device__ __forceinline__ f32x4 mfma16(bf16x8 a, bf16x8 b, f32x4 c) { return __builtin_amdgcn_mfma_f32_16x16x32_bf16(a, b, c, 0, 0, 0); }
__device__ __forceinline__ bf16x8 as_frag(u32x4 v) { return __builtin_bit_cast(bf16x8, v); }
__device__ __forceinline__ float wave_sum(float v) {
#pragma unroll
    for (int o = 1; o < 64; o <<= 1) v += __shfl_xor(v, o);
    return v;
}
__device__ __forceinline__ int seq_base(int s) { return s < 16 ? s * 256 : NCTX + (s - 16) * 4096; }
__device__ __forceinline__ int seq_nchunk(int s) { return s < 16 ? 4 : 64; }
__device__ __forceinline__ int chunk_base(int s) { return s < 16 ? 4 * s : 64 + 64 * (s - 16); }
__device__ __forceinline__ int tok_a(int s, int n, int i) { return seq_base(s) + 64 * n + i; }
__device__ __forceinline__ int tok_b(int s, int n, int i) { return s < 16 ? s * 256 + 64 * n + i : NCTX + (s - 16) * 4096 + 64 * i + n; }
__device__ __forceinline__ int kperm(int g, int j) { return 16 * (j >> 2) + 4 * g + (j & 3); }

namespace pg8 {
#define PG8_LAS __attribute__((address_space(3)))
typedef unsigned short bf16_t;
typedef short bf16x8 __attribute__((ext_vector_type(8)));
typedef float f32x4 __attribute__((ext_vector_type(4)));
typedef unsigned u32x4 __attribute__((ext_vector_type(4)));
constexpr int BM = 256, BK = 64, HALF = 128, HTB = HALF * BK * 2  , STAGE_BYTES = 8 * HTB, NXCD = 8, WGM = 8;

__host__ __device__ __forceinline__ int lds_byte(int r, int c) { const int st = (r >> 4) * 2 + (c >> 5), rr = r & 15, cc = c & 31, ob = rr * 64 + cc * 2; return st * 1024 + (ob ^ (((ob >> 9) & 1) << 5)); }
__host__ __device__ __forceinline__ void stage_rc(int b, int& R, int& C) { const int st = b / 1024, sb = b % 1024, swz = sb ^ (((sb >> 9) & 1) << 5); R = (st >> 1) * 16 + swz / 64; C = (st & 1) * 32 + (swz % 64) / 2; }
__host__ __device__ __forceinline__ int perm32(int rho) { const int n = rho >> 4, i = rho & 15; return 8 * (i >> 2) + 4 * n + (i & 3); }

struct Unit { int pm, pn, k0, nt, ns, su, sl; };
struct Gemm { const bf16_t* A; const bf16_t* Bt; int M, N, K; };

struct StaticOrder {
    int nM, nN, nwg, G, c, K;
    __host__ __device__ void init(int M, int N, int K_, int G_, int c_) { nM = M / BM; nN = N / BM; nwg = nM * nN; G = G_; c = c_; K = K_; }
    __host__ __device__ bool next(int i, Unit& u) const {
        const long L = (long)i * G + c; if (L >= nwg) return false;
        int wgid = (int)L; { const int q = nwg / NXCD, r = nwg % NXCD, xcd = wgid % NXCD, off = wgid / NXCD; wgid = (xcd < r ? xcd * (q + 1) : r * (q + 1) + (xcd - r) * q) + off; }
        const int nig = WGM * nN, gid = wgid / nig, fm = gid * WGM, gsz = (nM - fm) < WGM ? (nM - fm) : WGM;
        u.pm = fm + ((wgid % nig) % gsz); u.pn = (wgid % nig) / gsz; u.k0 = 0; u.nt = K / BK; u.ns = 1; u.su = 0; u.sl = 0; return true;
    }
    __device__ __forceinline__ void a_ready(const Unit&) const {}
    __device__ __forceinline__ void done(const Unit&) const {}
};

struct SplitOrder {
    StaticOrder so; bool split;
    __host__ __device__ void init(int M, int N, int K_, int G_, int c_) { so.init(M, N, K_, G_, c_); split = false && (G_ == 256 && so.nwg == 320); }
    __host__ __device__ bool next(int i, Unit& u) const {
        if (!split) return so.next(i, u);
        if (i == 0) return so.next(0, u);
        if (i > 1) return false;
        StaticOrder t = so; t.c = 256 + (so.c >> 2); t.G = 1 << 20; if (!t.next(0, u)) return false;
        const int ntt = so.K / BK, sl = so.c & 3, q = ((ntt / 4) + 1) & ~1;
        const int big = (ntt - 4 * (q - 2)) / 2;
        const int t0 = sl < big ? sl * q : big * q + (sl - big) * (q - 2), tn = sl < big ? q : q - 2;
        u.k0 = t0 * BK; u.nt = tn; u.ns = 4; u.su = so.c >> 2; u.sl = sl; return true;
    }
    __device__ __forceinline__ void a_ready(const Unit&) const {}
    __device__ __forceinline__ void done(const Unit&) const {}
};

__device__ __forceinline__ unsigned pkbf(float lo, float hi) { return ::pk2(lo, hi); }

struct EpiProj {
    static constexpr bool PERM = true, AFTER_DRAIN = false;
    bf16_t *d0, *d1, *d2, *d3, *d4, *d5, *d6, *d7, *d8;
    float* BETA; float* GG;
    const float* lbraw;
    const float* Alog; const float* dtb;
    __device__ __forceinline__ void operator()(const f32x4 (&acc)[2][2][4][2], const Unit& u, int wr, int wc, int fr, int fq) const {
        const int pn = u.pn, row0 = u.pm * BM + wr * 64 + fr;
        if (pn < 18) {
            const int seg = pn >> 1;
            bf16_t* base = seg == 0 ? d0 : seg == 1 ? d1 : seg == 2 ? d2 : seg == 3 ? d3 : seg == 4 ? d4 : seg == 5 ? d5 : seg == 6 ? d6 : seg == 7 ? d7 : d8;
            const int mode = (seg == 0 || seg == 4 || seg == 8) ? 1 : ((seg == 1 || seg == 2) ? 2 : 0);
#pragma unroll
            for (int bj = 0; bj < 2; ++bj) {
                const int c0 = (pn & 1) * 256 + bj * HALF + wc * 32 + 8 * fq;
                float lb[8];
                if (mode == 2) {
                    const int dir = seg - 1;
#pragma unroll
                    for (int e = 0; e < 8; ++e) { const float x0 = lbraw[dir * 512 + c0 + e], x1 = lbraw[1024 + dir * 512 + c0 + e]; lb[e] = 1.f / (1.f + __expf(x1 - x0)); }
                }
#pragma unroll
                for (int ai = 0; ai < 2; ++ai)
#pragma unroll
                    for (int m = 0; m < 4; ++m) {
                        float v[8];
#pragma unroll
                        for (int e = 0; e < 4; ++e) { v[e] = acc[ai][bj][m][0][e]; v[4 + e] = acc[ai][bj][m][1][e]; }
                        if (mode == 1) {
#pragma unroll
                            for (int e = 0; e < 8; ++e) v[e] = ::siluf(v[e]);
                        } else if (mode == 2) {
#pragma unroll
                            for (int e = 0; e < 8; ++e) { const float f = lb[e] + (1.f - lb[e]) * ::sigmf(v[e]); v[e] = __logf(f); }
                        }
                        u32x4 w; w.x = pkbf(v[0], v[1]); w.y = pkbf(v[2], v[3]); w.z = pkbf(v[4], v[5]); w.w = pkbf(v[6], v[7]);
                        *(u32x4*)(base + (size_t)(row0 + ai * HALF + m * 16) * 512 + c0) = w;
                    }
            }
        } else {
            if (wc == 0 && fq < 2) {
                float al[8], db[8];
                if (fq == 1) {
#pragma unroll
                    for (int e = 0; e < 8; ++e) { al[e] = -__expf(Alog[e]); db[e] = dtb[e]; }
                }
#pragma unroll
                for (int ai = 0; ai < 2; ++ai)
#pragma unroll
                    for (int m = 0; m < 4; ++m) {
                        const int row = row0 + ai * HALF + m * 16;
                        float v[8];
#pragma unroll
                        for (int e = 0; e < 4; ++e) { v[e] = acc[ai][0][m][0][e]; v[4 + e] = acc[ai][0][m][1][e]; }
                        if (fq == 0) {
#pragma unroll
                            for (int e = 0; e < 8; ++e) v[e] = ::sigmf(v[e]);
                            *(f32x4*)(BETA + (size_t)row * 8) = (f32x4){v[0], v[1], v[2], v[3]};
                            *(f32x4*)(BETA + (size_t)row * 8 + 4) = (f32x4){v[4], v[5], v[6], v[7]};
                        } else {
#pragma unroll
                            for (int e = 0; e < 8; ++e) { const float x = v[e] + db[e]; const float sp = x > 15.f ? x : log1pf(__expf(x)); v[e] = al[e] * sp; }
                            *(f32x4*)(GG + (size_t)row * 8) = (f32x4){v[0], v[1], v[2], v[3]};
                            *(f32x4*)(GG + (size_t)row * 8 + 4) = (f32x4){v[4], v[5], v[6], v[7]};
                        }
                    }
            }
        }
    }
};

struct EpiRes {
    static constexpr bool PERM = true, AFTER_DRAIN = false;
    const float* base0; const float* base1;
    float* out; const float* mod; int goff;
    const float *p1 = nullptr, *p2 = nullptr, *p3 = nullptr;
    __device__ __forceinline__ void operator()(const f32x4 (&acc)[2][2][4][2], const Unit& u, int wr, int wc, int fr, int fq) const {
        const int row0 = u.pm * BM + wr * 64 + fr;
        const int mr = u.pm < 16 ? 0 : 1 + ((u.pm - 16) >> 4);
        const float* gp = mod + (size_t)mr * 6144 + goff;
#pragma unroll
        for (int bj = 0; bj < 2; ++bj) {
            const int c0 = u.pn * BM + bj * HALF + wc * 32 + 8 * fq;
            const f32x4 g0 = *(const f32x4*)(gp + c0), g1 = *(const f32x4*)(gp + c0 + 4);
#pragma unroll
            for (int ai = 0; ai < 2; ++ai)
#pragma unroll
                for (int m = 0; m < 4; ++m) {
                    const int row = row0 + ai * HALF + m * 16;
                    const float* bp = (row < 4096 ? base0 + (size_t)row * 1024 : base1 + (size_t)(row - 4096) * 1024) + c0;
                    const f32x4 b0 = *(const f32x4*)bp, b1 = *(const f32x4*)(bp + 4);
                    float* op = out + (size_t)row * 1024 + c0;
                    f32x4 a0 = acc[ai][bj][m][0], a1 = acc[ai][bj][m][1];
                    if (p1) { const float *q1 = p1 + threadIdx.x * 4, *q2 = p2 + threadIdx.x * 4, *q3 = p3 + threadIdx.x * 4; asm volatile("" : "+v"(q1), "+v"(q2), "+v"(q3));
                        const int i0 = (((ai * 2 + bj) * 4 + m) * 2) * 2048, i1 = i0 + 2048;
                        a0 = a0 + (*(const f32x4*)(q1 + i0) + *(const f32x4*)(q2 + i0)) + *(const f32x4*)(q3 + i0); a1 = a1 + (*(const f32x4*)(q1 + i1) + *(const f32x4*)(q2 + i1)) + *(const f32x4*)(q3 + i1); }
                    *(f32x4*)op = b0 + g0 * a0;
                    *(f32x4*)(op + 4) = b1 + g1 * a1;
                }
        }
    }
};

struct EpiGU {
    static constexpr bool PERM = true, AFTER_DRAIN = false;
    bf16_t* GU;
    __device__ __forceinline__ void operator()(const f32x4 (&acc)[2][2][4][2], const Unit& u, int wr, int wc, int fr, int fq) const {
        const int row0 = u.pm * BM + wr * 64 + fr, c0 = u.pn * HALF + wc * 32 + 8 * fq;
#pragma unroll
        for (int ai = 0; ai < 2; ++ai)
#pragma unroll
            for (int m = 0; m < 4; ++m) {
                float v[8];
#pragma unroll
                for (int e = 0; e < 4; ++e) { v[e] = ::siluf(acc[ai][0][m][0][e]) * acc[ai][1][m][0][e]; v[4 + e] = ::siluf(acc[ai][0][m][1][e]) * acc[ai][1][m][1][e]; }
                u32x4 w; w.x = pkbf(v[0], v[1]); w.y = pkbf(v[2], v[3]); w.z = pkbf(v[4], v[5]); w.w = pkbf(v[6], v[7]);
                *(u32x4*)(GU + (size_t)(row0 + ai * HALF + m * 16) * 2816 + c0) = w;
            }
    }
};

template <class Inner> struct EpiSplit {
    static constexpr bool PERM = Inner::PERM, AFTER_DRAIN = false;
    Inner in; float* slab; unsigned* cnt; PG8_LAS unsigned* flag;
    __device__ __forceinline__ void operator()(const f32x4 (&acc)[2][2][4][2], const Unit& u, int wr, int wc, int fr, int fq) const {
        if (u.ns == 1) { in(acc, u, wr, wc, fr, fq); return; }
        const int tid = threadIdx.x;
        float* my = slab + (size_t)(u.su * 4 + u.sl) * 65536;
        const __amdgpu_buffer_rsrc_t rs = __builtin_amdgcn_make_buffer_rsrc(my, 0, 262144, 0x00020000);
#pragma unroll
        for (int ai = 0; ai < 2; ++ai)
#pragma unroll
            for (int bj = 0; bj < 2; ++bj)
#pragma unroll
                for (int m = 0; m < 4; ++m)
#pragma unroll
                    for (int n = 0; n < 2; ++n) __builtin_amdgcn_raw_buffer_store_b128(__builtin_bit_cast(u32x4, acc[ai][bj][m][n]), rs, (unsigned)(tid * 16), (unsigned)((((ai * 2 + bj) * 4 + m) * 2 + n) * 8192), 16);
        asm volatile("s_waitcnt vmcnt(0)" ::: "memory");
        __builtin_amdgcn_s_barrier();
        if (tid == 0) {
            const unsigned old = __hip_atomic_fetch_add(cnt + 64 * u.su, 1u, __ATOMIC_RELAXED, __HIP_MEMORY_SCOPE_AGENT);
            const unsigned last = (old == 3u) ? 1u : 0u;
            if (last) { __builtin_amdgcn_fence(__ATOMIC_ACQUIRE, "agent"); asm volatile("s_waitcnt vmcnt(0)" ::: "memory"); }
            *flag = last;
        }
        asm volatile("s_waitcnt lgkmcnt(0)" ::: "memory");
        __builtin_amdgcn_s_barrier();
        const unsigned last = *flag;
        if (last) {
            Inner in2 = in;
            in2.p1 = slab + (size_t)(u.su * 4 + ((u.sl + 1) & 3)) * 65536; in2.p2 = slab + (size_t)(u.su * 4 + ((u.sl + 2) & 3)) * 65536; in2.p3 = slab + (size_t)(u.su * 4 + ((u.sl + 3) & 3)) * 65536;
            in2(acc, u, wr, wc, fr, fq);
        }
    }
};
template <class Epi, class Sched, bool ALIGN_EPI = false, bool SP2 = false>
__device__ __forceinline__ void gemm_phase(PG8_LAS unsigned char* lds, const Gemm g, const Sched& S, const Epi& E) {
    const int tid = threadIdx.x, wid = __builtin_amdgcn_readfirstlane(tid >> 6), lane = tid & 63, wr = wid >> 2, wc = wid & 3, fr = lane & 15, fq = lane >> 4;
    const int K = g.K;
    unsigned voffA[2], voffB[2];
#pragma unroll
    for (int i = 0; i < 2; ++i) { int R, C; stage_rc(tid * 16 + i * 8192, R, C); const int Rb = Epi::PERM ? ((R & ~31) + perm32(R & 31)) : R;
        voffA[i] = (unsigned)(R * K + C) * 2u; voffB[i] = (unsigned)(Rb * K + C) * 2u; }
    const size_t kstep = (size_t)(BK * 2);
    const size_t hstep = (size_t)HALF * K * 2;
    const size_t tstep = 2 * hstep;
    const unsigned ldsw = (unsigned)wid * 1024u;
    const int aoff = lds_byte(wr * 64 + fr, fq * 8), boff = lds_byte(wc * 32 + fr, fq * 8);
#define PG8_SA(b, h) (((b) * 2 + (h)) * HTB)
#define PG8_SB(b, h) ((4 + (b) * 2 + (h)) * HTB)
#define PG8_STAGE(bufoff, gbase, voff) do { _Pragma("unroll") for (int _i = 0; _i < 2; ++_i) \
        __builtin_amdgcn_global_load_lds((const unsigned*)((const char*)(gbase) + (voff)[_i]), (PG8_LAS unsigned*)(lds + (bufoff) + ldsw + _i * 8192), 16, 0, 0); } while (0)
#define PG8_LDA(dst, b, h) do { _Pragma("unroll") for (int m = 0; m < 4; ++m) _Pragma("unroll") for (int k = 0; k < 2; ++k) dst[m][k] = *(const PG8_LAS bf16x8*)(lds + PG8_SA(b, h) + aoff + m * 2048 + k * 1024); } while (0)
#define PG8_LDB(dst, b, h) do { _Pragma("unroll") for (int n = 0; n < 2; ++n) _Pragma("unroll") for (int k = 0; k < 2; ++k) dst[n][k] = *(const PG8_LAS bf16x8*)(lds + PG8_SB(b, h) + boff + n * 2048 + k * 1024); } while (0)
#define PG8_MMA(ai, bj, At, Bt) do { __builtin_amdgcn_s_setprio(1); _Pragma("unroll") for (int m = 0; m < 4; ++m) _Pragma("unroll") for (int n = 0; n < 2; ++n) _Pragma("unroll") for (int k = 0; k < 2; ++k) \
        acc[ai][bj][m][n] = __builtin_amdgcn_mfma_f32_16x16x32_bf16(Bt[n][k], At[m][k], acc[ai][bj][m][n], 0, 0, 0); __builtin_amdgcn_s_setprio(0); } while (0)
#define PG8_WAIT_V(n) asm volatile("s_waitcnt vmcnt(" #n ")" ::: "memory")
#define PG8_WAIT_L(n) asm volatile("s_waitcnt lgkmcnt(" #n ")" ::: "memory")
#define PG8_BAR __builtin_amdgcn_s_barrier()
#define PG8_SCHED __builtin_amdgcn_sched_barrier(0)
    Unit cur, nxt; int ui = 0;
    if (!S.next(0, cur)) return;
    f32x4 acc[2][2][4][2];
#pragma unroll
    for (int a = 0; a < 2; ++a)
#pragma unroll
        for (int b = 0; b < 2; ++b)
#pragma unroll
            for (int m = 0; m < 4; ++m)
#pragma unroll
                for (int n = 0; n < 2; ++n) acc[a][b][m][n] = (f32x4){0.f, 0.f, 0.f, 0.f};
    bf16x8 At[4][2], B0[2][2], B1[2][2];
    const char* cA = (const char*)g.A + (size_t)cur.pm * tstep + (size_t)cur.k0 * 2; const char* cB = (const char*)g.Bt + (size_t)cur.pn * tstep + (size_t)cur.k0 * 2;
    S.a_ready(cur);
    if constexpr (SP2) {
        PG8_STAGE(PG8_SB(0, 0), cB, voffB); PG8_STAGE(PG8_SB(0, 1), cB + hstep, voffB); PG8_STAGE(PG8_SA(0, 0), cA, voffA); PG8_STAGE(PG8_SA(0, 1), cA + hstep, voffA);
        if (wr == 1) PG8_BAR;
        PG8_WAIT_V(2); PG8_BAR;
        PG8_STAGE(PG8_SB(1, 0), cB + kstep, voffB); PG8_STAGE(PG8_SA(1, 0), cA + kstep, voffA); PG8_STAGE(PG8_SB(1, 1), cB + hstep + kstep, voffB);
        PG8_WAIT_V(6); PG8_BAR;
    } else {
        PG8_STAGE(PG8_SB(0, 0), cB, voffB); PG8_STAGE(PG8_SA(0, 0), cA, voffA); PG8_STAGE(PG8_SB(0, 1), cB + hstep, voffB); PG8_STAGE(PG8_SA(0, 1), cA + hstep, voffA);
        if (wr == 1) PG8_BAR;
        PG8_WAIT_V(4); PG8_BAR;
        PG8_STAGE(PG8_SB(1, 0), cB + kstep, voffB); PG8_STAGE(PG8_SA(1, 0), cA + kstep, voffA); PG8_STAGE(PG8_SB(1, 1), cB + hstep + kstep, voffB);
        PG8_WAIT_V(6); PG8_BAR;
    }
    for (;;) {
        const bool has_next = S.next(ui + 1, nxt);
        const char* nA = has_next ? (const char*)g.A + (size_t)nxt.pm * tstep + (size_t)nxt.k0 * 2 : cA; const char* nB = has_next ? (const char*)g.Bt + (size_t)nxt.pn * tstep + (size_t)nxt.k0 * 2 : cB;
        const int nt = cur.nt;
        for (int t = 0; t < nt; t += 2) {
            const bool last = (t == nt - 2);
            const char* a1 = cA + (size_t)(t + 1) * kstep;
            const char* a2 = last ? nA : cA + (size_t)(t + 2) * kstep; const char* b2 = last ? nB : cB + (size_t)(t + 2) * kstep;
            const char* a3 = a2 + kstep; const char* b3 = b2 + kstep;
            if (last && has_next) S.a_ready(nxt);
            if constexpr (SP2) {
            PG8_LDB(B0, 0, 0); PG8_LDB(B1, 0, 1); PG8_SCHED; PG8_LDA(At, 0, 0); PG8_STAGE(PG8_SA(1, 1), a1 + hstep, voffA);
            PG8_WAIT_V(8); PG8_WAIT_L(0); PG8_BAR; PG8_MMA(0, 0, At, B0); PG8_MMA(0, 1, At, B1); PG8_BAR; PG8_SCHED;
            PG8_LDA(At, 0, 1); PG8_STAGE(PG8_SB(0, 0), b2, voffB); PG8_STAGE(PG8_SB(0, 1), b2 + hstep, voffB); PG8_STAGE(PG8_SA(0, 0), a2, voffA);
            PG8_WAIT_V(8); PG8_WAIT_L(0); PG8_BAR; PG8_MMA(1, 0, At, B0); PG8_MMA(1, 1, At, B1); PG8_BAR; PG8_SCHED;
            PG8_LDB(B0, 1, 0); PG8_LDB(B1, 1, 1); PG8_SCHED; PG8_LDA(At, 1, 0); PG8_STAGE(PG8_SA(0, 1), a2 + hstep, voffA);
            PG8_WAIT_V(8); PG8_WAIT_L(0); PG8_BAR; PG8_MMA(0, 0, At, B0); PG8_MMA(0, 1, At, B1); PG8_BAR; PG8_SCHED;
            PG8_LDA(At, 1, 1); PG8_STAGE(PG8_SB(1, 0), b3, voffB); PG8_STAGE(PG8_SB(1, 1), b3 + hstep, voffB); PG8_STAGE(PG8_SA(1, 0), a3, voffA);
            PG8_WAIT_V(8); PG8_WAIT_L(0); PG8_BAR; PG8_MMA(1, 0, At, B0); PG8_MMA(1, 1, At, B1); PG8_BAR; PG8_SCHED;
            } else {
            PG8_LDB(B0, 0, 0); PG8_SCHED; PG8_LDA(At, 0, 0); PG8_STAGE(PG8_SA(1, 1), a1 + hstep, voffA);
            PG8_WAIT_L(8); PG8_BAR; PG8_WAIT_L(0); PG8_MMA(0, 0, At, B0); PG8_BAR; PG8_SCHED;
            PG8_LDB(B1, 0, 1); PG8_STAGE(PG8_SB(0, 0), b2, voffB);
            PG8_BAR; PG8_WAIT_L(0); PG8_MMA(0, 1, At, B1); PG8_BAR;
            PG8_LDA(At, 0, 1); PG8_STAGE(PG8_SA(0, 0), a2, voffA);
            PG8_BAR; PG8_WAIT_L(0); PG8_MMA(1, 0, At, B0); PG8_BAR; PG8_SCHED;
            PG8_STAGE(PG8_SB(0, 1), b2 + hstep, voffB);
            PG8_WAIT_V(6); PG8_BAR; PG8_MMA(1, 1, At, B1); PG8_BAR;
            PG8_LDB(B0, 1, 0); PG8_SCHED; PG8_LDA(At, 1, 0); PG8_STAGE(PG8_SA(0, 1), a2 + hstep, voffA);
            PG8_WAIT_L(8); PG8_BAR; PG8_WAIT_L(0); PG8_MMA(0, 0, At, B0); PG8_BAR; PG8_SCHED;
            PG8_LDB(B1, 1, 1); PG8_STAGE(PG8_SB(1, 0), b3, voffB);
            PG8_BAR; PG8_WAIT_L(0); PG8_MMA(0, 1, At, B1); PG8_BAR;
            PG8_LDA(At, 1, 1); PG8_STAGE(PG8_SA(1, 0), a3, voffA);
            PG8_BAR; PG8_WAIT_L(0); PG8_MMA(1, 0, At, B0); PG8_BAR; PG8_SCHED;
            PG8_STAGE(PG8_SB(1, 1), b3 + hstep, voffB);
            PG8_WAIT_V(6); PG8_BAR; PG8_MMA(1, 1, At, B1); PG8_BAR;
            }
        }
        if constexpr (ALIGN_EPI) { if (wr == 0) PG8_BAR; }
        if constexpr (!Epi::AFTER_DRAIN) { E(acc, cur, wr, wc, fr, fq); S.done(cur); }
        if (!has_next) break;
#pragma unroll
        for (int a = 0; a < 2; ++a)
#pragma unroll
            for (int b = 0; b < 2; ++b)
#pragma unroll
                for (int m = 0; m < 4; ++m)
#pragma unroll
                    for (int n = 0; n < 2; ++n) acc[a][b][m][n] = (f32x4){0.f, 0.f, 0.f, 0.f};
        cur = nxt; cA = nA; cB = nB; ++ui;
        if constexpr (ALIGN_EPI) { if (wr == 1) PG8_BAR; }
    }
    PG8_WAIT_V(0);
    if constexpr (!ALIGN_EPI) { if (wr == 0) PG8_BAR; }
    PG8_BAR;
    if constexpr (Epi::AFTER_DRAIN) { E.fused(acc, cur, wr, wc, fr, fq, lds, wid, lane); S.done(cur); }
#undef PG8_SA
#undef PG8_SB
#undef PG8_STAGE
#undef PG8_LDA
#undef PG8_LDB
#undef PG8_MMA
#undef PG8_WAIT_V
#undef PG8_WAIT_L
#undef PG8_BAR
#undef PG8_SCHED
}
}

#define XB_TMO      128
#define XB_XCNT(j)  (256  + 64 * (j))
#define XB_XSUB(j)  (1280 + 64 * (j))
#define XB_XGEN(j)  (2304 + 64 * (j))
#define XB_TOP      3328
#define XB_TOPGEN   3392
#define XCD_BAR_WORDS 3456
#define XB_SPIN_CAP (1u << 18)

__device__ __forceinline__ unsigned xb_ld(unsigned* p)              { return __hip_atomic_load(p, __ATOMIC_RELAXED, __HIP_MEMORY_SCOPE_AGENT); }
__device__ __forceinline__ unsigned xb_add(unsigned* p, unsigned v) { return __hip_atomic_fetch_add(p, v, __ATOMIC_RELAXED, __HIP_MEMORY_SCOPE_AGENT); }
__device__ __forceinline__ unsigned xb_xcc_id() { return (unsigned)__builtin_amdgcn_s_getreg((3 << 11) | 20) & 0xFu; }
#define XB_SPIN(cond, bar) do { unsigned _sp = 0; while (cond) { __builtin_amdgcn_s_sleep(1); \
    if ((++_sp & 255u) == 0u) { if (xb_ld(&(bar)[XB_TMO])) break; if (_sp > XB_SPIN_CAP) { atomicAdd(&(bar)[XB_TMO], 1u); break; } } } } while (0)

struct XcdBarrier {
    unsigned* bar; unsigned x;
    volatile LAS unsigned* st;
};

__device__ __forceinline__ XcdBarrier xcd_barrier_post(unsigned* bar, volatile LAS unsigned* st) {
    XcdBarrier b; b.bar = bar; b.x = xb_xcc_id(); b.st = st;
    if (threadIdx.x == 0) (void)xb_add(&bar[XB_XCNT(b.x)], 1u);
    return b;
}
__device__ __forceinline__ void xcd_barrier_complete(unsigned* bar, unsigned x, unsigned& nloc, unsigned& nx) {
    const unsigned G = gridDim.x * gridDim.y * gridDim.z;
    unsigned sum, cnt, mine, sp = 0u;
    for (;;) {
        sum = 0u; cnt = 0u; mine = 0u;
#pragma unroll
        for (unsigned j = 0; j < 16; ++j) { const unsigned c = xb_ld(&bar[XB_XCNT(j)]); sum += c; cnt += (c > 0u) ? 1u : 0u; mine = (j == x) ? c : mine; }
        if (sum == G) break;
        __builtin_amdgcn_s_sleep(1);
        if ((++sp & 255u) == 0u) { if (xb_ld(&bar[XB_TMO])) break; if (sp > XB_SPIN_CAP) { atomicAdd(&bar[XB_TMO], 1u); break; } }
    }
    nloc = mine > 0u ? mine : 1u; nx = cnt > 0u ? cnt : 1u;
}

__device__ __forceinline__ void xcd_barrier(const XcdBarrier& b) {
    asm volatile("s_waitcnt vmcnt(0)" ::: "memory");
    __syncthreads();
    if (threadIdx.x == 0) {
        unsigned* bar = b.bar;
        __builtin_amdgcn_s_waitcnt(0);
        unsigned nloc = b.st[0], nx = b.st[1];
        if (nloc == 0u) { xcd_barrier_complete(bar, b.x, nloc, nx); b.st[0] = nloc; b.st[1] = nx; }
        const unsigned old = xb_add(&bar[XB_XSUB(b.x)], 1u);
        const unsigned gen = old / nloc;
        if (old + 1u == (gen + 1u) * nloc) {
            __builtin_amdgcn_fence(__ATOMIC_RELEASE, "agent");
            asm volatile("s_waitcnt vmcnt(0)" ::: "memory");
            const unsigned og = xb_add(&bar[XB_TOP], 1u);
            const unsigned tg = og / nx;
            if (og + 1u == (tg + 1u) * nx) xb_add(&bar[XB_TOPGEN], 1u);
            else XB_SPIN(xb_ld(&bar[XB_TOPGEN]) == tg, bar);
            __builtin_amdgcn_fence(__ATOMIC_ACQUIRE, "agent");
            xb_add(&bar[XB_XGEN(b.x)], 1u);
            asm volatile("s_waitcnt vmcnt(0)" ::: "memory");
        } else {
            XB_SPIN(xb_ld(&bar[XB_XGEN(b.x)]) == gen, bar);
            __builtin_amdgcn_fence(__ATOMIC_ACQUIRE, "agent");
            asm volatile("s_waitcnt vmcnt(0)" ::: "memory");
        }
    }
    __syncthreads();
}

struct Args { const float* in[N_IN]; float* out; unsigned char* ws; int ph_lo, ph_hi; };
struct Frame {
    LAS unsigned char* lds;
    int tid, lane, wave, bid, G;
    unsigned long long pacc, pt0;
    const float* in[N_IN];
    float* out; unsigned char* ws;
};
#define probe_acc F.pacc
#define probe_t0 F.pt0
#define WSP(T, off) ((T*)(F.ws + (off)))
#define OUTB(T, off) ((T*)((unsigned char*)F.out + (off)))

__device__ __forceinline__ void transpose_item(const float* W, int K, int N, bf16* WT, int dst_row0, int k0, int n0, LAS float* scr, int lane) {
    float wv[32];
#pragma unroll
    for (int i = 0; i < 32; ++i) { const int kk = 2 * i + (lane >> 5), n = n0 + (lane & 31); wv[i] = n < N ? W[(size_t)(k0 + kk) * N + n] : 0.f; }
#pragma unroll
    for (int i = 0; i < 32; ++i) { const int kk = 2 * i + (lane >> 5); scr[kk * 33 + (lane & 31)] = wv[i]; }
    LDS_WAIT(); asm volatile("" ::: "memory");
    const int c = lane & 7;
#pragma unroll
    for (int j = 0; j < 4; ++j) { const int n = (lane >> 3) + 8 * j; const LAS float* s = scr + (8 * c) * 33 + n;
        u32x4 o; o.x = pk2(s[0 * 33], s[1 * 33]); o.y = pk2(s[2 * 33], s[3 * 33]); o.z = pk2(s[4 * 33], s[5 * 33]); o.w = pk2(s[6 * 33], s[7 * 33]);
        *(u32x4*)(WT + (size_t)(dst_row0 + n) * K + k0 + 8 * c) = o; }
    LDS_WAIT(); asm volatile("" ::: "memory");
}

__device__ __forceinline__ void p0_prologue(Frame& F) {
    const int gw = F.bid * NWAVES + F.wave, NGW = F.G * NWAVES;
    {
        LAS float* scr = (LAS float*)(F.lds + 49152 + F.wave * 8704);
        constexpr int NB = NPAD / 32, NITEMS = 16 * NB;
        for (int it = gw; it < NITEMS; it += NGW) { const int kb = it / NB, nb = it % NB; transpose_item(F.in[I_WIN], 1024, DPROJ, WSP(bf16, WS_WIN), 32 * nb, 64 * kb, 32 * nb, scr, F.lane); }
    }
    {
        LAS float* sc = (LAS float*)F.lds;
        LAS float* red = (LAS float*)(F.lds + 20480);
        for (int idx = F.tid; idx < 5 * 1024; idx += NTHR) { const int r = idx >> 10, k = idx & 1023; const float v = r == 0 ? F.in[I_CCTX][k] : F.in[I_C][(r - 1) * 1024 + k]; sc[idx] = siluf(v); }
        __syncthreads();
        const float* wada = F.in[I_WADA]; const float* bada = F.in[I_BADA]; float* mod = WSP(float, WS_MOD);
        for (int it = F.bid; it < 256; it += F.G) {
            const int kg = it >> 3, cg = it & 7, c4 = F.tid % 192, rh = F.tid / 192;
            float acc[5][4];
#pragma unroll
            for (int r = 0; r < 5; ++r)
#pragma unroll
                for (int e = 0; e < 4; ++e) acc[r][e] = 0.f;
            if (rh < 2) {
                const float* wp = wada + (size_t)(32 * kg + 16 * rh) * 6144 + 768 * cg + 4 * c4;
                f32x4 wr[16];
#pragma unroll
                for (int kk = 0; kk < 16; ++kk) wr[kk] = *(const f32x4*)(wp + (size_t)kk * 6144);
#pragma unroll
                for (int kk = 0; kk < 16; ++kk) {
                    const f32x4 w = wr[kk];
                    const int k = 32 * kg + 16 * rh + kk;
#pragma unroll
                    for (int r = 0; r < 5; ++r) { const float s = sc[r * 1024 + k]; acc[r][0] += s * w.x; acc[r][1] += s * w.y; acc[r][2] += s * w.z; acc[r][3] += s * w.w; }
                }
            }
            if (rh == 1) {
#pragma unroll
                for (int r = 0; r < 5; ++r)
#pragma unroll
                    for (int e = 0; e < 4; ++e) red[c4 * 20 + r * 4 + e] = acc[r][e];
            }
            __syncthreads();
            if (rh == 0) {
                const int col = 768 * cg + 4 * c4;
#pragma unroll
                for (int r = 0; r < 5; ++r)
#pragma unroll
                    for (int e = 0; e < 4; ++e) { float v = acc[r][e] + red[c4 * 20 + r * 4 + e]; if (kg == 0) v += bada[col + e]; atomicAdd(mod + r * 6144 + col + e, v); }
            }
            __syncthreads();
        }
    }
}

__device__ __forceinline__ void modnorm_rows(Frame& F, const float* x0, const float* x1, const float* nw, int sh_off, int sc_off, bf16* H) {
    const int gw = F.bid * NWAVES + F.wave, NGW = F.G * NWAVES;
    const float* mod = WSP(float, WS_MOD);
    f32x4 v[2][4], vn[2][4];
#define MN_LOAD(dst, M0) do { _Pragma("unroll") for (int u = 0; u < 2; ++u) { const int m_ = (M0) + u * NGW; if (m_ < NT) { const float* xr_ = m_ < NCTX ? x0 + (size_t)m_ * DM : x1 + (size_t)(m_ - NCTX) * DM; \
        _Pragma("unroll") for (int j = 0; j < 4; ++j) dst[u][j] = *(const f32x4*)(xr_ + 4 * F.lane + 256 * j); } } } while (0)
    MN_LOAD(vn, gw);
    for (int m0 = gw; m0 < NT; m0 += 2 * NGW) {
#pragma unroll
        for (int u = 0; u < 2; ++u)
#pragma unroll
            for (int j = 0; j < 4; ++j) v[u][j] = vn[u][j];
        if (m0 + 2 * NGW < NT) MN_LOAD(vn, m0 + 2 * NGW);
#pragma unroll
        for (int u = 0; u < 2; ++u) { const int m = m0 + u * NGW; if (m < NT) {
            const int mr = m < NCTX ? 0 : 1 + ((m - NCTX) >> 12);
            const float* mp = mod + (size_t)mr * 6144;
            float s = 0.f;
#pragma unroll
            for (int j = 0; j < 4; ++j) s += (v[u][j].x * v[u][j].x + v[u][j].y * v[u][j].y) + (v[u][j].z * v[u][j].z + v[u][j].w * v[u][j].w);
            const float rstd = __builtin_amdgcn_rsqf(wave_sum(s) * (1.f / DM) + EPS);
#pragma unroll
            for (int j = 0; j < 4; ++j) {
                const int c = 4 * F.lane + 256 * j;
                const f32x4 w = *(const f32x4*)(nw + c), sc = *(const f32x4*)(mp + sc_off + c), sh = *(const f32x4*)(mp + sh_off + c);
                const f32x4 h = (v[u][j] * rstd * w) * (sc + 1.f) + sh;
                u32x2 o; o.x = pk2(h.x, h.y); o.y = pk2(h.z, h.w);
                *(u32x2*)(H + (size_t)m * DM + c) = o;
            } } }
    }
#undef MN_LOAD
}

__device__ __forceinline__ void final_norm(Frame& F) {
    const int gw = F.bid * NWAVES + F.wave, NGW = F.G * NWAVES;
    const float* nf = F.in[I_NF];
    f32x4 w[4];
#pragma unroll
    for (int j = 0; j < 4; ++j) w[j] = *(const f32x4*)(nf + 4 * F.lane + 256 * j);
    for (int m0 = gw; m0 < NT; m0 += 2 * NGW) {
        f32x4 v[2][4];
#pragma unroll
        for (int u = 0; u < 2; ++u) { const int m = m0 + u * NGW; if (m < NT) {
#pragma unroll
            for (int j = 0; j < 4; ++j) v[u][j] = *(const f32x4*)(F.out + (size_t)m * DM + 4 * F.lane + 256 * j); } }
#pragma unroll
        for (int u = 0; u < 2; ++u) { const int m = m0 + u * NGW; if (m < NT) {
            float s = 0.f;
#pragma unroll
            for (int j = 0; j < 4; ++j) s += (v[u][j].x * v[u][j].x + v[u][j].y * v[u][j].y) + (v[u][j].z * v[u][j].z + v[u][j].w * v[u][j].w);
            const float rstd = __builtin_amdgcn_rsqf(wave_sum(s) * (1.f / DM) + EPS);
#pragma unroll
            for (int j = 0; j < 4; ++j) *(f32x4*)(F.out + (size_t)m * DM + 4 * F.lane + 256 * j) = v[u][j] * rstd * w[j]; } }
    }
}

__device__ __forceinline__ void late_weights(Frame& F, const int gw, const int NGW) {
    {
        LAS float* scr = (LAS float*)(F.lds + F.wave * 8704);
        constexpr int I_O = 16 * 32, I_G = 16 * 88, I_D = 44 * 32, NITEMS = I_O + 2 * I_G + I_D;
        for (int it = gw; it < NITEMS; it += NGW) {
            int r = it;
            if (r < I_O) { const int kb = r / 32, nb = r % 32; transpose_item(F.in[I_WOUT], 1024, 1024, WSP(bf16, WS_WOUT), 32 * nb, 64 * kb, 32 * nb, scr, F.lane); continue; } r -= I_O;
            if (r < I_G) { const int kb = r / 88, nb = r % 88, n0 = 32 * nb; transpose_item(F.in[I_WGATE], 1024, DFF, WSP(bf16, WS_WGU), 256 * (n0 >> 7) + (n0 & 127), 64 * kb, n0, scr, F.lane); continue; } r -= I_G;
            if (r < I_G) { const int kb = r / 88, nb = r % 88, n0 = 32 * nb; transpose_item(F.in[I_WUP], 1024, DFF, WSP(bf16, WS_WGU), 256 * (n0 >> 7) + 128 + (n0 & 127), 64 * kb, n0, scr, F.lane); continue; } r -= I_G;
            { const int kb = r / 32, nb = r % 32; transpose_item(F.in[I_WDOWN], DFF, 1024, WSP(bf16, WS_WDN), 32 * nb, 64 * kb, 32 * nb, scr, F.lane); }
        }
    }
}

__device__ __forceinline__ void p5_headnorm(Frame& F) {
    const int gw = F.bid * NWAVES + F.wave, NGW = F.G * NWAVES;
    const bf16* OA0 = OUTB(bf16, OUT_OA); const bf16* OA1 = OUTB(bf16, OUT_OA + 20 * MiB);
    const bf16* OB0 = WSP(bf16, WS_OB);   const bf16* OB1 = WSP(bf16, WS_OB + 20 * MiB);
    const bf16* AG = WSP(bf16, WS_AG);    const bf16* BZ = WSP(bf16, WS_BZ);
    bf16* Y = WSP(bf16, WS_YIN);
    const int half = F.lane >> 5, c = 16 * (F.lane & 31);
    const float* nw = (half ? F.in[I_GNORM] : F.in[I_HNORM]) + c;
    f32x4 wn[4];
#pragma unroll
    for (int q = 0; q < 4; ++q) wn[q] = *(const f32x4*)(nw + 4 * q);
    u32x4 ra[2], rb[2], rg[2], na[2], nb2[2], ng[2];
#define P5_LOAD(A, B, Gt, M) do { const size_t off_ = (size_t)(M) * 512 + c; \
        _Pragma("unroll") for (int q = 0; q < 2; ++q) { A[q] = *(const u32x4*)((half ? OB0 : OA0) + off_ + 8 * q); B[q] = *(const u32x4*)((half ? OB1 : OA1) + off_ + 8 * q); Gt[q] = *(const u32x4*)((half ? BZ : AG) + off_ + 8 * q); } } while (0)
    if (gw < NT) P5_LOAD(na, nb2, ng, gw);
    for (int m = gw; m < NT; m += NGW) {
#pragma unroll
        for (int q = 0; q < 2; ++q) { ra[q] = na[q]; rb[q] = nb2[q]; rg[q] = ng[q]; }
        if (m + NGW < NT) P5_LOAD(na, nb2, ng, m + NGW);
        float o[16]; float ss = 0.f;
#pragma unroll
        for (int q = 0; q < 2; ++q)
#pragma unroll
            for (int e = 0; e < 4; ++e) { o[8 * q + 2 * e] = bflo(ra[q][e]) + bflo(rb[q][e]); o[8 * q + 2 * e + 1] = bfhi(ra[q][e]) + bfhi(rb[q][e]); }
#pragma unroll
        for (int e = 0; e < 16; ++e) ss += o[e] * o[e];
        ss += __shfl_xor(ss, 1); ss += __shfl_xor(ss, 2); ss += __shfl_xor(ss, 4);
        const float rstd = __builtin_amdgcn_rsqf(ss * (1.f / 128.f) + EPS);
#pragma unroll
        for (int q = 0; q < 2; ++q) {
            float y[8];
#pragma unroll
            for (int e = 0; e < 4; ++e) { y[2 * e] = o[8 * q + 2 * e] * rstd * wn[2 * q + (e >> 1)][2 * (e & 1)] * bflo(rg[q][e]); y[2 * e + 1] = o[8 * q + 2 * e + 1] * rstd * wn[2 * q + (e >> 1)][2 * (e & 1) + 1] * bfhi(rg[q][e]); }
            u32x4 w; w.x = pk2(y[0], y[1]); w.y = pk2(y[2], y[3]); w.z = pk2(y[4], y[5]); w.w = pk2(y[6], y[7]);
            *(u32x4*)(Y + (size_t)m * DM + half * 512 + c + 8 * q) = w;
        }
    }
#undef P5_LOAD
}

__device__ __forceinline__ int uc_index(int s, int n, int h, int dir) { return ((chunk_base(s) + n) * 4 + h) * 2 + dir; }
__device__ __forceinline__ unsigned char* grec_ptr(Frame& F, int uc) { return uc < N1G ? F.ws + WS_I + (size_t)uc * GREC : (unsigned char*)F.out + OUT_GOVF + (size_t)(uc - N1G) * GREC; }
__device__ __forceinline__ unsigned char* hrec_ptr(Frame& F, int uc) { return F.ws + WS_I + (size_t)uc * HREC; }
__device__ __forceinline__ bool allowed(int dir, int t, int s) { return dir ? (s >= t) : (s <= t); }

__device__ __forceinline__ void write_qd_image(Frame& F, const LAS bf16* X, int pitch, const LAS float* rowscale, unsigned char* dst) {
    const int r = F.lane & 15, g = F.lane >> 4, mt = F.wave >> 1;
#pragma unroll
    for (int q = 0; q < 2; ++q) {
        const int ks = 2 * (F.wave & 1) + q, row = 16 * mt + r;
        const u32x2 a = *(const LAS u32x2*)(X + row * pitch + 32 * ks + 4 * g), b = *(const LAS u32x2*)(X + row * pitch + 32 * ks + 16 + 4 * g);
        u32x4 o;
        if (rowscale) { const float sc = rowscale[row];
            o.x = pk2(bflo(a.x) * sc, bfhi(a.x) * sc); o.y = pk2(bflo(a.y) * sc, bfhi(a.y) * sc); o.z = pk2(bflo(b.x) * sc, bfhi(b.x) * sc); o.w = pk2(bflo(b.y) * sc, bfhi(b.y) * sc);
        } else { o.x = a.x; o.y = a.y; o.z = b.x; o.w = b.y; }
        *(u32x4*)(dst + ((mt * 4 + ks) * 64 + F.lane) * 16) = o;
    }
}
__device__ __forceinline__ void write_at_image(Frame& F, const LAS bf16* KA, const LAS bf16* QB, int pitch, const LAS float* Cs, int dir, unsigned char* dst) {
    const int r = F.lane & 15, g = F.lane >> 4, mt = F.wave >> 1, ks2 = F.wave & 1;
    f32x4 a0 = {0.f, 0.f, 0.f, 0.f}, a1 = {0.f, 0.f, 0.f, 0.f};
#pragma unroll
    for (int kd = 0; kd < 4; ++kd) {
        const bf16x8 bq = as_frag(*(const LAS u32x4*)(QB + (16 * mt + r) * pitch + 32 * kd + 8 * g));
        const bf16x8 k0 = as_frag(*(const LAS u32x4*)(KA + (32 * ks2 + r) * pitch + 32 * kd + 8 * g));
        const bf16x8 k1 = as_frag(*(const LAS u32x4*)(KA + (32 * ks2 + 16 + r) * pitch + 32 * kd + 8 * g));
        a0 = mfma16(k0, bq, a0); a1 = mfma16(k1, bq, a1);
    }
    const int t = 16 * mt + r; const float ct = Cs ? Cs[t] : 0.f;
    f32x4 cs0 = {0.f, 0.f, 0.f, 0.f}, cs1 = {0.f, 0.f, 0.f, 0.f};
    if (Cs) { cs0 = *(const LAS f32x4*)(Cs + 32 * ks2 + 4 * g); cs1 = *(const LAS f32x4*)(Cs + 32 * ks2 + 16 + 4 * g); }
    float v[8];
#pragma unroll
    for (int j = 0; j < 8; ++j) {
        const int s = 32 * ks2 + kperm(g, j); const bool ok = allowed(dir, t, s);
        float x = (j < 4) ? a0[j & 3] : a1[j & 3];
        if (Cs) { const float e = __expf(ok ? ct - ((j < 4) ? cs0[j & 3] : cs1[j & 3]) : 0.f); x *= e; }
        v[j] = ok ? x : 0.f;
    }
    u32x4 o; o.x = pk2(v[0], v[1]); o.y = pk2(v[2], v[3]); o.z = pk2(v[4], v[5]); o.w = pk2(v[6], v[7]);
    *(u32x4*)(dst + ((mt * 2 + ks2) * 64 + F.lane) * 16) = o;
}

__device__ __forceinline__ void p3h_load(Frame& F, int task, unsigned (&gw)[8], unsigned (&qw)[8], unsigned (&vw)[8]) {
    const int dir = task & 1, h = (task >> 1) & 3, cidx = task >> 3;
    int s, n; if (cidx < 64) { s = cidx >> 2; n = cidx & 3; } else { s = 16 + ((cidx - 64) >> 6); n = (cidx - 64) & 63; }
    const bf16* Gd = OUTB(bf16, dir ? OUT_GB : OUT_GF); const bf16* QA = OUTB(bf16, OUT_QA); const bf16* VA = OUTB(bf16, OUT_VA);
    const int c0 = 2 * (F.tid & 63), re = F.tid >> 6;
#pragma unroll
    for (int e = 0; e < 8; ++e) {
        const size_t off = (size_t)tok_a(s, n, 8 * re + e) * 512 + h * 128 + c0;
        gw[e] = *(const unsigned*)(Gd + off); qw[e] = *(const unsigned*)(QA + off);
        if (dir == ((task >> 8) & 1)) vw[e] = *(const unsigned*)(VA + off);
    }
}
__device__ __forceinline__ void p3_hgrn(Frame& F) {
    constexpr int PITCH = 136;
    LAS bf16* QDb = (LAS bf16*)(F.lds);
    LAS bf16* KDb = (LAS bf16*)(F.lds + 17408);
    LAS unsigned char* KTi = F.lds + 34816;
    LAS float* part = (LAS float*)(F.lds + 51200);
    LAS float* etot = (LAS float*)(F.lds + 55296);
    LAS bf16* Vb = (LAS bf16*)(F.lds + 56320);
    unsigned ngw[8], nqw[8], nvw[8];
    if (F.bid < NUC) p3h_load(F, F.bid, ngw, nqw, nvw);
    for (int task = F.bid; task < NUC; task += F.G) {
        const int dir = task & 1, h = (task >> 1) & 3, cidx = task >> 3;
        int s, n; if (cidx < 64) { s = cidx >> 2; n = cidx & 3; } else { s = 16 + ((cidx - 64) >> 6); n = (cidx - 64) & 63; }
        PROBE_BEGIN(61);
        unsigned char* rec = hrec_ptr(F, task);
        const int cp = F.tid & 63, re = F.tid >> 6, c0 = 2 * cp;
        float f0[8], f1[8], q0[8], q1[8], p0[8], p1[8];
#pragma unroll
        for (int e = 0; e < 8; ++e) {
            f0[e] = __expf(bflo(ngw[e])); f1[e] = __expf(bfhi(ngw[e])); q0[e] = bflo(nqw[e]); q1[e] = bfhi(nqw[e]);
            if (dir == ((task >> 8) & 1)) *(LAS unsigned*)(Vb + (8 * re + e) * PITCH + c0) = nvw[e];
        }
        if (task + F.G < NUC) p3h_load(F, task + F.G, ngw, nqw, nvw);
        if (dir == 0) { float a = 1.f, b = 1.f;
#pragma unroll
            for (int e = 0; e < 8; ++e) { a *= f0[e]; b *= f1[e]; p0[e] = a; p1[e] = b; }
            part[re * 128 + c0] = a; part[re * 128 + c0 + 1] = b;
        } else { float a = 1.f, b = 1.f;
#pragma unroll
            for (int e = 7; e >= 0; --e) { a *= f0[e]; b *= f1[e]; p0[e] = a; p1[e] = b; }
            part[re * 128 + c0] = a; part[re * 128 + c0 + 1] = b;
        }
        __syncthreads();
        PROBE_END(61); PROBE_BEGIN(62);
        float o0 = 1.f, o1 = 1.f, t0 = 1.f, t1 = 1.f;
#pragma unroll
        for (int r2 = 0; r2 < 8; ++r2) { const float a = part[r2 * 128 + c0], b = part[r2 * 128 + c0 + 1]; t0 *= a; t1 *= b; const bool pre = dir ? (r2 > re) : (r2 < re); if (pre) { o0 *= a; o1 *= b; } }
        if (re == 0) { etot[c0] = t0; etot[c0 + 1] = t1; }
        float kt0[8], kt1[8];
#pragma unroll
        for (int e = 0; e < 8; ++e) {
            const float E0 = o0 * p0[e], E1 = o1 * p1[e];
            const float k0 = 1.f - f0[e], k1 = 1.f - f1[e];
            const float kd0 = k0 * __builtin_amdgcn_rcpf(E0), kd1 = k1 * __builtin_amdgcn_rcpf(E1);
            const int row = 8 * re + e;
            *(LAS unsigned*)(QDb + row * PITCH + c0) = pk2(q0[e] * E0, q1[e] * E1);
            *(LAS unsigned*)(KDb + row * PITCH + c0) = pk2(kd0, kd1);
            kt0[e] = kd0 * t0; kt1[e] = kd1 * t1;
        }
        {
            const int ks = re >> 2, hf = (re >> 1) & 1;
#pragma unroll
            for (int cc = 0; cc < 2; ++cc) {
                const int c = c0 + cc, kt = c >> 4, r = c & 15;
#pragma unroll
                for (int p = 0; p < 2; ++p) {
                    const int g = 2 * (re & 1) + p;
                    u32x2 w;
                    if (cc == 0) { w.x = pk2(kt0[4 * p], kt0[4 * p + 1]); w.y = pk2(kt0[4 * p + 2], kt0[4 * p + 3]); } else { w.x = pk2(kt1[4 * p], kt1[4 * p + 1]); w.y = pk2(kt1[4 * p + 2], kt1[4 * p + 3]); }
                    *(LAS u32x2*)(KTi + ((kt * 2 + ks) * 64 + g * 16 + r) * 16 + 8 * hf) = w;
                }
            }
        }
        __syncthreads();
        PROBE_END(62); PROBE_BEGIN(63);
        write_qd_image(F, QDb, PITCH, nullptr, rec);
        write_at_image(F, KDb, QDb, PITCH, nullptr, dir, rec + 16384);
        for (int i = F.tid; i < 1024; i += NTHR) *(u32x4*)(rec + 24576 + i * 16) = *(const LAS u32x4*)(KTi + i * 16);
        if (F.tid < 32) *(f32x4*)(rec + 40960 + F.tid * 16) = *(const LAS f32x4*)((LAS unsigned char*)etot + F.tid * 16);
        if (dir == ((task >> 8) & 1)) {
            unsigned char* vb = F.ws + WS_HVB + (size_t)(task >> 1) * 16384;
            const int c = F.lane & 15, g = F.lane >> 4, w = F.wave;
#pragma unroll
            for (int ks2 = 0; ks2 < 2; ++ks2) {
                unsigned short x[8];
#pragma unroll
                for (int j = 0; j < 8; ++j) x[j] = Vb[(32 * ks2 + kperm(g, j)) * PITCH + 16 * w + c];
                u32x4 o; o.x = x[0] | ((unsigned)x[1] << 16); o.y = x[2] | ((unsigned)x[3] << 16); o.z = x[4] | ((unsigned)x[5] << 16); o.w = x[6] | ((unsigned)x[7] << 16);
                *(u32x4*)(vb + ((w * 2 + ks2) * 64 + F.lane) * 16) = o;
            }
        }
        __syncthreads();
        PROBE_END(63);
    }
}

__device__ __forceinline__ int lp_rowoff(int a) { if (a == 0) return 0; const int A = a - 1, m = A >> 2, r = A & 3; return 8 * m * (m + 1) + 4 * r * (m + 1); }

__device__ __forceinline__ void p3g_invert(LAS float* Lp, int dir, int lane) {
    float T[64];
    const int j = lane;
#pragma unroll
    for (int t = 0; t < 64; ++t) {
        float a0 = 0.f, a1 = 0.f, a2 = 0.f, a3 = 0.f;
        const LAS float* lrow = Lp + lp_rowoff(t);
#pragma unroll
        for (int s4 = 0; s4 < (t + 3) / 4; ++s4) {
            const f32x4 l = *(const LAS f32x4*)(lrow + 4 * s4);
            if (4 * s4 + 0 < t) a0 += l[0] * T[4 * s4 + 0];
            if (4 * s4 + 1 < t) a1 += l[1] * T[4 * s4 + 1];
            if (4 * s4 + 2 < t) a2 += l[2] * T[4 * s4 + 2];
            if (4 * s4 + 3 < t) a3 += l[3] * T[4 * s4 + 3];
        }
        int jj = j; asm volatile("" : "+v"(jj));
        T[t] = (t == jj ? 1.f : 0.f) - ((a0 + a1) + (a2 + a3));
        asm volatile("" ::: "memory");
    }
    LAS bf16* Tb = (LAS bf16*)Lp;
    if (dir == 0) { LAS bf16* tp = Tb + j;
#pragma unroll
        for (int t = 0; t < 64; ++t) tp[t * 72] = (bf16)f2bf(T[t]);
    } else { LAS bf16* tp = Tb + (63 - j);
#pragma unroll
        for (int t = 0; t < 64; ++t) tp[(63 - t) * 72] = (bf16)f2bf(T[t]);
    }
}

__device__ __forceinline__ void p3g_load(Frame& F, int task, const bf16* BQ, const bf16* BK, const bf16* BV, const float* BETA, const float* GGp, u32x4 (&raw)[18], float& gbeta, float& ggate) {
    const int dir = task & 1, h = (task >> 1) & 3, cidx = task >> 3;
    int s, n; if (cidx < 64) { s = cidx >> 2; n = cidx & 3; } else { s = 16 + ((cidx - 64) >> 6); n = (cidx - 64) & 63; }
    const int i = F.tid >> 3, m = tok_b(s, n, i);
    int pos, len, dlt; if (s < 16) { pos = 64 * n + i; len = 256; dlt = 1; } else { pos = i; len = 64; dlt = 64; }
    const bool hasp = pos > 0, hasn = pos + 1 < len; const u32x4 zz = {0u, 0u, 0u, 0u};
#pragma unroll
    for (int a = 0; a < 3; ++a) {
        const bf16* src = (a == 0 ? BQ : (a == 1 ? BK : BV)) + (size_t)m * 512 + h * 128 + 16 * (F.tid & 7);
#pragma unroll
        for (int q = 0; q < 2; ++q) {
            raw[a * 6 + q * 3 + 0] = hasp ? *(const u32x4*)(src - (ptrdiff_t)dlt * 512 + 8 * q) : zz;
            raw[a * 6 + q * 3 + 1] = *(const u32x4*)(src + 8 * q);
            raw[a * 6 + q * 3 + 2] = hasn ? *(const u32x4*)(src + (ptrdiff_t)dlt * 512 + 8 * q) : zz;
        }
    }
    if (F.wave == 0) { const int mg = tok_b(s, n, F.lane); gbeta = BETA[(size_t)mg * 8 + dir * 4 + h]; ggate = GGp[(size_t)mg * 8 + dir * 4 + h]; }
}

__device__ __forceinline__ void p3_gdn(Frame& F, const int t0, const int tn, const int rank, const int nranks) {
    constexpr int PITCH = 136, TP = 72, NBMAX = 10, LSLOT = 9216;
    LAS unsigned char* slots = F.lds + 40960;
    LAS float* Cs = (LAS float*)(F.lds + 512);
    LAS float* Bs = Cs + 64;
    LAS float* Es = Cs + 128;
    LAS float* Ets = Cs + 192;
    LAS float* Sc = Cs + 256;
    LAS bf16* Qb = (LAS bf16*)(F.lds + 2048);
    LAS bf16* Kb = (LAS bf16*)(F.lds + 19456);
    LAS bf16* VT = (LAS bf16*)(F.lds + 2048);
    LAS bf16* KGT = (LAS bf16*)(F.lds + 20480);
    LAS float* Wc = (LAS float*)(F.lds + 133120);
    int wc_head = -1;
    const bf16* BQ = WSP(bf16, WS_BQ); const bf16* BK = WSP(bf16, WS_BK); const bf16* BV = WSP(bf16, WS_BV);
    const float* BETA = WSP(float, WS_BETA); const float* GGp = WSP(float, WS_GG);
    const float* convw = F.in[I_CONV];
    const int ntask = rank < tn ? (tn - rank + nranks - 1) / nranks : 0;
    for (int b0 = 0; b0 < ntask; b0 += NBMAX) {
      const int nb = ntask - b0 < NBMAX ? ntask - b0 : NBMAX;
      PROBE_BEGIN(51);
      u32x4 raw[18]; float gbeta = 0.f, ggate = 0.f;
#define P3G_LOAD(JT) p3g_load(F, t0 + rank + (b0 + (JT)) * nranks, BQ, BK, BV, BETA, GGp, raw, gbeta, ggate)
      if (nb > 0) P3G_LOAD(0);
      for (int jt = 0; jt < nb; ++jt) {
        const int task = t0 + rank + (b0 + jt) * nranks;
        const int dir = task & 1, h = (task >> 1) & 3, cidx = task >> 3;
        int s, n; if (cidx < 64) { s = cidx >> 2; n = cidx & 3; } else { s = 16 + ((cidx - 64) >> 6); n = (cidx - 64) & 63; }
        unsigned char* rec = grec_ptr(F, task);
        LAS float* Lp = (LAS float*)(slots + jt * LSLOT);
        if (h != wc_head) {
            __syncthreads();
            for (int idx = F.tid; idx < 1152; idx += NTHR) { const int a = idx / 384, r2 = idx % 384, tap = r2 >> 7, ch = r2 & 127; Wc[idx] = convw[tap * 1536 + a * 512 + h * 128 + ch]; }
            wc_head = h;
        }
        PROBE_BEGIN(54);
        if (F.wave == 0) {
            const float beta = gbeta;
            float c = ggate;
#pragma unroll
            for (int d = 1; d < 64; d <<= 1) { const float o = dir ? __shfl_down(c, d) : __shfl_up(c, d); const bool ok = dir ? (F.lane + d < 64) : (F.lane >= d); c += ok ? o : 0.f; }
            const float ctot = __shfl(c, dir ? 0 : 63);
            Cs[F.lane] = c; Bs[F.lane] = beta; Es[F.lane] = __expf(c); Ets[F.lane] = __expf(ctot - c);
            if (F.lane == 0) Sc[0] = __expf(ctot);
        }
        __syncthreads();
        PROBE_END(54); PROBE_BEGIN(55);
        {
            const int i = F.tid >> 3, seg = F.tid & 7, ch0 = 16 * seg;
            const float beta = Bs[i], kg = -beta * Es[i];
#pragma unroll
            for (int a = 0; a < 3; ++a) {
                float val[16];
                const LAS float* wc = Wc + a * 384 + ch0;
#pragma unroll
                for (int q = 0; q < 2; ++q) {
                    const u32x4 xm = raw[a * 6 + q * 3 + 0], x0 = raw[a * 6 + q * 3 + 1], xp = raw[a * 6 + q * 3 + 2];
                    f32x4 w0[2], w1[2], w2[2];
#pragma unroll
                    for (int hh = 0; hh < 2; ++hh) { w0[hh] = *(const LAS f32x4*)(wc + 8 * q + 4 * hh); w1[hh] = *(const LAS f32x4*)(wc + 128 + 8 * q + 4 * hh); w2[hh] = *(const LAS f32x4*)(wc + 256 + 8 * q + 4 * hh); }
#pragma unroll
                    for (int e = 0; e < 4; ++e) {
                        const int ch = 8 * q + 2 * e, hh = e >> 1, ee = 2 * (e & 1);
                        const float y0 = bflo(xm[e]) * w0[hh][ee] + bflo(x0[e]) * w1[hh][ee] + bflo(xp[e]) * w2[hh][ee];
                        const float y1 = bfhi(xm[e]) * w0[hh][ee + 1] + bfhi(x0[e]) * w1[hh][ee + 1] + bfhi(xp[e]) * w2[hh][ee + 1];
                        val[ch] = siluf(y0); val[ch + 1] = siluf(y1);
                    }
                }
                if (a < 2) {
                    float ss = 0.f;
#pragma unroll
                    for (int e = 0; e < 16; ++e) ss += val[e] * val[e];
                    ss += __shfl_xor(ss, 1); ss += __shfl_xor(ss, 2); ss += __shfl_xor(ss, 4);
                    const float rn = __builtin_amdgcn_rsqf(ss + EPS) * (a == 0 ? 0.08838834764831845f : 1.f);
                    unsigned pw[8];
#pragma unroll
                    for (int e = 0; e < 8; ++e) pw[e] = pk2(val[2 * e] * rn, val[2 * e + 1] * rn);
                    LAS bf16* dstp = (a == 0 ? Qb : Kb) + i * PITCH + ch0;
                    *(LAS u32x4*)(dstp) = (u32x4){pw[0], pw[1], pw[2], pw[3]}; *(LAS u32x4*)(dstp + 8) = (u32x4){pw[4], pw[5], pw[6], pw[7]};
                    if (a == 1) {
                        unsigned gw[8];
#pragma unroll
                        for (int e = 0; e < 8; ++e) gw[e] = pk2(kg * val[2 * e] * rn, kg * val[2 * e + 1] * rn);
                        u32x4* gp = (u32x4*)(rec + L_WN + (i * 128 + ch0) * 2);
                        gp[0] = (u32x4){gw[0], gw[1], gw[2], gw[3]}; gp[1] = (u32x4){gw[4], gw[5], gw[6], gw[7]};
                    }
                } else {
                    unsigned vw[8];
#pragma unroll
                    for (int e = 0; e < 8; ++e) vw[e] = pk2(beta * val[2 * e], beta * val[2 * e + 1]);
                    u32x4* vp = (u32x4*)(rec + L_U + (i * 128 + ch0) * 2);
                    vp[0] = (u32x4){vw[0], vw[1], vw[2], vw[3]}; vp[1] = (u32x4){vw[4], vw[5], vw[6], vw[7]};
                }
                asm volatile("" ::: "memory");
            }
            if (jt + 1 < nb) P3G_LOAD(jt + 1);
        }
        PROBE_END(55); PROBE_BEGIN(56);
        __syncthreads();
        {
            const int r = F.lane & 15, g = F.lane >> 4, tt = F.wave >> 1, sp = F.wave & 1;
            f32x4 a0 = {0.f, 0.f, 0.f, 0.f}, a1 = {0.f, 0.f, 0.f, 0.f};
#pragma unroll
            for (int kd = 0; kd < 4; ++kd) {
                const bf16x8 at = as_frag(*(const LAS u32x4*)(Kb + (16 * tt + r) * PITCH + 32 * kd + 8 * g));
                const bf16x8 b0 = as_frag(*(const LAS u32x4*)(Kb + (32 * sp + r) * PITCH + 32 * kd + 8 * g));
                const bf16x8 b1 = as_frag(*(const LAS u32x4*)(Kb + (32 * sp + 16 + r) * PITCH + 32 * kd + 8 * g));
                a0 = mfma16(at, b0, a0); a1 = mfma16(at, b1, a1);
            }
            const f32x4 ct4 = *(const LAS f32x4*)(Cs + 16 * tt + 4 * g), bt4 = *(const LAS f32x4*)(Bs + 16 * tt + 4 * g);
            const float csx0 = Cs[32 * sp + r], csx1 = Cs[32 * sp + 16 + r];
#pragma unroll
            for (int q = 0; q < 2; ++q)
#pragma unroll
                for (int i = 0; i < 4; ++i) {
                    const int t = 16 * tt + 4 * g + i, sx = 32 * sp + 16 * q + r;
                    const bool ok = dir ? (sx > t) : (sx < t);
                    const float v = bt4[i] * (q ? a1[i] : a0[i]) * __expf(ok ? ct4[i] - (q ? csx1 : csx0) : 0.f);
                    const int a = dir ? 63 - t : t, b = dir ? 63 - sx : sx;
                    if (ok) Lp[lp_rowoff(a) + b] = v;
                }
        }
        write_at_image(F, Kb, Qb, PITCH, Cs, dir, rec + L_AT);
        write_qd_image(F, Qb, PITCH, Es, rec + L_QD);
        {
            const int r = F.lane & 15, g = F.lane >> 4, kt = F.wave;
#pragma unroll
            for (int ks2 = 0; ks2 < 2; ++ks2) {
                float v[8];
                const f32x4 e0 = *(const LAS f32x4*)(Ets + 32 * ks2 + 4 * g), e1 = *(const LAS f32x4*)(Ets + 32 * ks2 + 16 + 4 * g);
#pragma unroll
                for (int j = 0; j < 8; ++j) { const int sx = 32 * ks2 + kperm(g, j); v[j] = bf2f(Kb[sx * PITCH + 16 * kt + r]) * ((j < 4) ? e0[j & 3] : e1[j & 3]); }
                u32x4 o; o.x = pk2(v[0], v[1]); o.y = pk2(v[2], v[3]); o.z = pk2(v[4], v[5]); o.w = pk2(v[6], v[7]);
                *(u32x4*)(rec + L_KT + ((kt * 2 + ks2) * 64 + F.lane) * 16) = o;
            }
        }
        if (F.tid == 0) *(float*)(rec + L_SC) = Sc[0];
        __syncthreads();
        PROBE_END(56);
      }
#undef P3G_LOAD
      PROBE_END(51); PROBE_BEGIN(52);
      asm volatile("s_waitcnt vmcnt(0)" ::: "memory");
      for (int jt = F.wave; jt < nb; jt += NWAVES) { const int task = t0 + rank + (b0 + jt) * nranks; p3g_invert((LAS float*)(slots + jt * LSLOT), task & 1, F.lane); }
      __syncthreads();
      PROBE_END(52); PROBE_BEGIN(53);
      u32x4 pv[2], pk[2];
      { unsigned char* rec0 = grec_ptr(F, t0 + rank + b0 * nranks);
#pragma unroll
        for (int q = 0; q < 2; ++q) { const int p = F.lane * 16 + F.wave + 8 * q; pv[q] = *(const u32x4*)(rec0 + L_U + p * 16); pk[q] = *(const u32x4*)(rec0 + L_WN + p * 16); } }
      for (int jt = 0; jt < nb; ++jt) {
        const int task = t0 + rank + (b0 + jt) * nranks;
        unsigned char* rec = grec_ptr(F, task);
        const LAS bf16* Tm = (const LAS bf16*)(slots + jt * LSLOT);
        PROBE_BEGIN(57);
#pragma unroll
        for (int q = 0; q < 2; ++q) {
            const int i = F.lane, c8 = (F.wave + 8 * q) * 8;
            const u32x4 vv = pv[q], kk = pk[q];
            LAS bf16* vt = VT + c8 * TP + i; LAS bf16* kt = KGT + c8 * TP + i;
#pragma unroll
            for (int e = 0; e < 4; ++e) { vt[(2 * e) * TP] = (bf16)(vv[e] & 0xffffu); vt[(2 * e + 1) * TP] = (bf16)(vv[e] >> 16); kt[(2 * e) * TP] = (bf16)(kk[e] & 0xffffu); kt[(2 * e + 1) * TP] = (bf16)(kk[e] >> 16); }
        }
        if (jt + 1 < nb) { unsigned char* rec1 = grec_ptr(F, task + nranks);
#pragma unroll
            for (int q = 0; q < 2; ++q) { const int p = F.lane * 16 + F.wave + 8 * q; pv[q] = *(const u32x4*)(rec1 + L_U + p * 16); pk[q] = *(const u32x4*)(rec1 + L_WN + p * 16); } }
        __syncthreads();
        PROBE_END(57); PROBE_BEGIN(58);
        {
            const int r = F.lane & 15, g = F.lane >> 4;
            {
                const int w = F.wave;
                bf16x8 bv[2];
#pragma unroll
                for (int ks2 = 0; ks2 < 2; ++ks2) bv[ks2] = as_frag(*(const LAS u32x4*)(VT + (16 * w + r) * TP + 32 * ks2 + 8 * g));
#pragma unroll
                for (int mt = 0; mt < 4; ++mt) {
                    f32x4 a = {0.f, 0.f, 0.f, 0.f};
#pragma unroll
                    for (int ks2 = 0; ks2 < 2; ++ks2) a = mfma16(as_frag(*(const LAS u32x4*)(Tm + (16 * mt + r) * TP + 32 * ks2 + 8 * g)), bv[ks2], a);
                    u32x2 o; o.x = pk2(a[0], a[1]); o.y = pk2(a[2], a[3]);
                    *(u32x2*)(rec + L_U + ((w * 4 + mt) * 64 + F.lane) * 8) = o;
                }
            }
            {
                const int mt = F.wave >> 1;
                bf16x8 bt[2];
#pragma unroll
                for (int ks2 = 0; ks2 < 2; ++ks2) bt[ks2] = as_frag(*(const LAS u32x4*)(Tm + (16 * mt + r) * TP + 32 * ks2 + 8 * g));
#pragma unroll
                for (int q = 0; q < 2; ++q) {
                    const int ks = 2 * (F.wave & 1) + q;
                    f32x4 a0 = {0.f, 0.f, 0.f, 0.f}, a1 = {0.f, 0.f, 0.f, 0.f};
#pragma unroll
                    for (int ks2 = 0; ks2 < 2; ++ks2) {
                        a0 = mfma16(as_frag(*(const LAS u32x4*)(KGT + (32 * ks + r) * TP + 32 * ks2 + 8 * g)), bt[ks2], a0);
                        a1 = mfma16(as_frag(*(const LAS u32x4*)(KGT + (32 * ks + 16 + r) * TP + 32 * ks2 + 8 * g)), bt[ks2], a1);
                    }
                    u32x4 o; o.x = pk2(a0[0], a0[1]); o.y = pk2(a0[2], a0[3]); o.z = pk2(a1[0], a1[1]); o.w = pk2(a1[2], a1[3]);
                    *(u32x4*)(rec + L_WN + ((mt * 4 + ks) * 64 + F.lane) * 16) = o;
                }
            }
        }
        __syncthreads();
        PROBE_END(58);
      }
      PROBE_END(53);
    }
}

template <bool GDN>
__device__ __forceinline__ void p4_chain(Frame& F) {
    LAS unsigned char* img = F.lds;
    const int c = F.lane & 15, g = F.lane >> 4;
    const float* st_in = F.in[GDN ? I_SG : I_SH];
    float* st_out = F.out + OUT_Y_FLOATS + (GDN ? STATE_FLOATS : 0);
    bf16* Obase = GDN ? WSP(bf16, WS_OB) : OUTB(bf16, OUT_OA);
    constexpr int N16 = GDN ? GREC / 16 : HREC / 16;
    constexpr int NPC = ((GDN ? GREC : HREC) + 1023) / 1024;
    gu32* prog = (gu32*)(F.ws + WS_CTL) + (GDN ? CW_PROG_G : CW_PROG_H);
    const bool roles = (F.G == 256);
    if (roles && F.bid >= 64 && F.bid < 128) {
        const int hb = F.bid - 64, u = hb & 31, j0 = hb >> 5;
        const int s = 16 + (u >> 3), h = (u >> 1) & 3, dir = u & 1, N = 64;
        u32x4 dummy = {0u, 0u, 0u, 0u};
        for (int st = j0; st < N; st += 2) {
            for (unsigned sp = 0; sp < (1u << 15); ++sp) { const unsigned p = __hip_atomic_load(prog + 64 * u, RLX_AGENT); if ((int)p + P4_PD > st) break; __builtin_amdgcn_s_sleep(8); }
            const int n = dir ? N - 1 - st : st; const int uc = uc_index(s, n, h, dir);
            const unsigned char* rec = GDN ? grec_ptr(F, uc) : hrec_ptr(F, uc);
            for (int idx = F.tid; idx < N16; idx += NTHR) { const unsigned char* p = rec + (size_t)idx * 16; asm volatile("global_load_dwordx4 %0, %1, off" : "+v"(dummy) : "v"(p) : "memory"); }
            if (!GDN) { const unsigned char* vb = F.ws + WS_HVB + (size_t)(uc >> 1) * 16384;
                for (int idx = F.tid; idx < 1024; idx += NTHR) { const unsigned char* p = vb + (size_t)idx * 16; asm volatile("global_load_dwordx4 %0, %1, off" : "+v"(dummy) : "v"(p) : "memory"); } }
        }
        asm volatile("s_waitcnt vmcnt(0)" : "+v"(dummy) :: "memory");
        return;
    }
    for (int uidx0 = F.bid; uidx0 < (roles ? 256 : 160); uidx0 += F.G) {
        int uidx = uidx0, ncw = 8, sl0 = 0;
        if (roles) { if (uidx0 >= 128) uidx = uidx0 - 96; else { uidx = uidx0 & 31; ncw = 4; sl0 = 4 * (uidx0 >> 5); } }
        const bool lead = roles && uidx0 < 32;
        const int w = sl0 + F.wave; const bool comp = F.wave < ncw;
        const int dwn = ncw < 8 ? 8 - ncw : 8, dw0 = ncw < 8 ? F.wave - ncw : F.wave;
        int s, h, dir;
        if (uidx < 32) { s = 16 + (uidx >> 3); h = (uidx >> 1) & 3; dir = uidx & 1; } else { const int j = uidx - 32; s = j >> 3; h = (j >> 1) & 3; dir = j & 1; }
        const int N = seq_nchunk(s), bq = s < 16 ? s : s - 16;
        f32x4 S[8];
        if (!comp) {
#pragma unroll
            for (int kt = 0; kt < 8; ++kt) S[kt] = (f32x4){0.f, 0.f, 0.f, 0.f};
        } else if (s >= 16) {
            const float* sp = st_in + (size_t)((bq * 2 + dir) * 4 + h) * 16384 + 16 * w + c;
#pragma unroll
            for (int kt = 0; kt < 8; ++kt)
#pragma unroll
                for (int i = 0; i < 4; ++i) S[kt][i] = sp[(16 * kt + 4 * g + i) * 128];
        } else {
#pragma unroll
            for (int kt = 0; kt < 8; ++kt) S[kt] = (f32x4){0.f, 0.f, 0.f, 0.f};
        }
#define P4_DMA(STEP, BUF) do { \
            const int n_ = dir ? N - 1 - (STEP) : (STEP); const int uc_ = uc_index(s, n_, h, dir); \
            const unsigned char* rec_ = (GDN ? grec_ptr(F, uc_) : hrec_ptr(F, uc_)) + F.lane * 16; \
            LAS unsigned char* dst_ = F.lds + (BUF) * P4_BUF + (GDN ? 0 : L_QD); \
            for (int p = dw0; p < NPC; p += dwn) { if (GDN && ncw < 8 && (p >> 3) == 7 + (1 - (sl0 >> 2))) continue; __builtin_amdgcn_global_load_lds((const unsigned*)(rec_ + (size_t)p * 1024), (LAS unsigned*)(dst_ + p * 1024), 16, 0, 0); } \
            if (!GDN) { const unsigned char* vb_ = F.ws + WS_HVB + (size_t)(uc_ >> 1) * 16384 + F.lane * 16; LAS unsigned char* dv_ = F.lds + (BUF) * P4_BUF + L_WN; \
                for (int p = dw0; p < 16; p += dwn) { if (ncw < 8 && (p >> 3) == 1 - (sl0 >> 2)) continue; __builtin_amdgcn_global_load_lds((const unsigned*)(vb_ + (size_t)p * 1024), (LAS unsigned*)(dv_ + p * 1024), 16, 0, 0); } } \
        } while (0)
#define FRAG(off, idx) (*(const LAS u32x4*)(img + (off) + ((idx) * 64 + F.lane) * 16))
        if (dw0 >= 0) P4_DMA(0, 0);
        asm volatile("s_waitcnt vmcnt(0)" ::: "memory");
        __syncthreads();
        for (int step = 0; step < N; ++step) {
            PROBE_BEGIN(GDN ? 2 : 12);
            const int cur = step & 1;
            LAS unsigned char* img = F.lds + cur * P4_BUF;
            if (lead && F.tid == 0) __hip_atomic_store(prog + 64 * uidx, (unsigned)(step + 1), RLX_AGENT);
            PROBE_BEGIN(GDN ? 21 : 31);
            if (step + 1 < N && dw0 >= 0) P4_DMA(step + 1, cur ^ 1);
            PROBE_END(GDN ? 21 : 31);
            const int n = dir ? N - 1 - step : step;
            if (comp) {
            PROBE_BEGIN(GDN ? 22 : 32);
            bf16x8 Sb[4];
#pragma unroll
            for (int ks = 0; ks < 4; ++ks) { u32x4 o; o.x = pk2(S[2 * ks][0], S[2 * ks][1]); o.y = pk2(S[2 * ks][2], S[2 * ks][3]); o.z = pk2(S[2 * ks + 1][0], S[2 * ks + 1][1]); o.w = pk2(S[2 * ks + 1][2], S[2 * ks + 1][3]); Sb[ks] = as_frag(o); }
            bf16x8 Xb[2];
            u32x4 fa[8], fb[8];
            f32x4 O[4];
            if (GDN) {
                f32x4 X[4];
#pragma unroll
                for (int mt = 0; mt < 4; ++mt)
#pragma unroll
                    for (int k = 0; k < 2; ++k) fa[mt * 2 + k] = FRAG(L_WN, mt * 4 + k);
#pragma unroll
                for (int mt = 0; mt < 4; ++mt)
#pragma unroll
                    for (int k = 0; k < 2; ++k) fb[mt * 2 + k] = FRAG(L_WN, mt * 4 + 2 + k);
#pragma unroll
                for (int mt = 0; mt < 4; ++mt) { const u32x2 uu = *(const LAS u32x2*)(img + L_U + ((w * 4 + mt) * 64 + F.lane) * 8); X[mt] = (f32x4){bflo(uu.x), bfhi(uu.x), bflo(uu.y), bfhi(uu.y)}; }
#pragma unroll
                for (int k = 0; k < 2; ++k)
#pragma unroll
                    for (int mt = 0; mt < 4; ++mt) X[mt] = mfma16(as_frag(fa[mt * 2 + k]), Sb[k], X[mt]);
#pragma unroll
                for (int mt = 0; mt < 4; ++mt)
#pragma unroll
                    for (int k = 0; k < 2; ++k) fa[mt * 2 + k] = FRAG(L_QD, mt * 4 + k);
#pragma unroll
                for (int k = 0; k < 2; ++k)
#pragma unroll
                    for (int mt = 0; mt < 4; ++mt) X[mt] = mfma16(as_frag(fb[mt * 2 + k]), Sb[2 + k], X[mt]);
#pragma unroll
                for (int k2 = 0; k2 < 2; ++k2) { u32x4 o; o.x = pk2(X[2 * k2][0], X[2 * k2][1]); o.y = pk2(X[2 * k2][2], X[2 * k2][3]); o.z = pk2(X[2 * k2 + 1][0], X[2 * k2 + 1][1]); o.w = pk2(X[2 * k2 + 1][2], X[2 * k2 + 1][3]); Xb[k2] = as_frag(o); }
            } else {
#pragma unroll
                for (int k2 = 0; k2 < 2; ++k2) Xb[k2] = as_frag(FRAG(L_WN, w * 2 + k2));
#pragma unroll
                for (int mt = 0; mt < 4; ++mt)
#pragma unroll
                    for (int k = 0; k < 2; ++k) fa[mt * 2 + k] = FRAG(L_QD, mt * 4 + k);
            }
            PROBE_END(GDN ? 22 : 32); PROBE_BEGIN(GDN ? 23 : 33);
#pragma unroll
            for (int mt = 0; mt < 4; ++mt)
#pragma unroll
                for (int k = 0; k < 2; ++k) fb[mt * 2 + k] = FRAG(L_QD, mt * 4 + 2 + k);
#pragma unroll
            for (int mt = 0; mt < 4; ++mt) O[mt] = (f32x4){0.f, 0.f, 0.f, 0.f};
#pragma unroll
            for (int k = 0; k < 2; ++k)
#pragma unroll
                for (int mt = 0; mt < 4; ++mt) O[mt] = mfma16(Sb[k], as_frag(fa[mt * 2 + k]), O[mt]);
#pragma unroll
            for (int i = 0; i < 8; ++i) fa[i] = FRAG(L_AT, i);
#pragma unroll
            for (int k = 0; k < 2; ++k)
#pragma unroll
                for (int mt = 0; mt < 4; ++mt) O[mt] = mfma16(Sb[2 + k], as_frag(fb[mt * 2 + k]), O[mt]);
#pragma unroll
            for (int i = 0; i < 8; ++i) fb[i] = FRAG(L_KT, i);
#pragma unroll
            for (int k2 = 0; k2 < 2; ++k2)
#pragma unroll
                for (int mt = 0; mt < 4; ++mt) O[mt] = mfma16(Xb[k2], as_frag(fa[mt * 2 + k2]), O[mt]);
#pragma unroll
            for (int i = 0; i < 8; ++i) fa[i] = FRAG(L_KT, 8 + i);
            PROBE_END(GDN ? 23 : 33); PROBE_BEGIN(GDN ? 24 : 34);
            {
                f32x4 d[8];
                if (GDN) { const float ds = *(const LAS float*)(img + L_SC);
#pragma unroll
                    for (int kt = 0; kt < 8; ++kt) d[kt] = (f32x4){ds, ds, ds, ds}; }
                else {
#pragma unroll
                    for (int kt = 0; kt < 8; ++kt) d[kt] = *(const LAS f32x4*)(img + L_U + (16 * kt + 4 * g) * 4); }
#pragma unroll
                for (int kt = 0; kt < 8; ++kt) S[kt] = S[kt] * d[kt];
            }
#pragma unroll
            for (int k2 = 0; k2 < 2; ++k2)
#pragma unroll
                for (int kt = 0; kt < 4; ++kt) S[kt] = mfma16(as_frag(fb[kt * 2 + k2]), Xb[k2], S[kt]);
#pragma unroll
            for (int k2 = 0; k2 < 2; ++k2)
#pragma unroll
                for (int kt = 0; kt < 4; ++kt) S[4 + kt] = mfma16(as_frag(fa[kt * 2 + k2]), Xb[k2], S[4 + kt]);
            PROBE_END(GDN ? 24 : 34); PROBE_BEGIN(GDN ? 25 : 35);
#pragma unroll
            for (int mt = 0; mt < 4; ++mt) {
                const int li = 16 * mt + c;
                const int m = GDN ? tok_b(s, n, li) : tok_a(s, n, li);
                u32x2 o; o.x = pk2(O[mt][0], O[mt][1]); o.y = pk2(O[mt][2], O[mt][3]);
                *(u32x2*)(Obase + (size_t)dir * (10 * MiB) + (size_t)m * 512 + h * 128 + 16 * w + 4 * g) = o;
            }
            PROBE_END(GDN ? 25 : 35);
            }
            PROBE_END(GDN ? 2 : 12); PROBE_BEGIN(GDN ? 3 : 13);
            asm volatile("s_waitcnt vmcnt(0)" ::: "memory");
            __syncthreads();
            PROBE_END(GDN ? 3 : 13);
        }
#undef P4_DMA
#undef FRAG
        if (s < 16 && comp) {
            float* sp = st_out + (size_t)((bq * 2 + dir) * 4 + h) * 16384 + 16 * w + c;
#pragma unroll
            for (int kt = 0; kt < 8; ++kt)
#pragma unroll
                for (int i = 0; i < 4; ++i) sp[(16 * kt + 4 * g + i) * 128] = S[kt][i];
        }
    }
    if (GDN && roles && F.bid >= 128) { __syncthreads(); late_weights(F, (F.bid - 128) * NWAVES + F.wave, 128 * NWAVES); }
    if (!GDN && roles && F.bid >= 128) { __syncthreads(); p3_gdn(F, NUC - NR_EARLY, NR_EARLY, F.bid - 128, 128); }
}

constexpr int NPHASE = 13;
__global__ void __launch_bounds__(NTHR, 2) mk_fwd(Args args) {
    extern __shared__ __attribute__((aligned(16))) unsigned char lds_raw[];
    Frame F;
    F.lds = (LAS unsigned char*)lds_raw;
    F.tid = threadIdx.x; F.lane = F.tid & 63; F.wave = __builtin_amdgcn_readfirstlane(F.tid >> 6);
    F.bid = blockIdx.x; F.G = gridDim.x;
#pragma unroll
    for (int i = 0; i < N_IN; ++i) F.in[i] = args.in[i];
    F.out = args.out; F.ws = args.ws; F.pacc = 0ull; F.pt0 = 0ull;
    volatile LAS unsigned* MISC = (volatile LAS unsigned*)(F.lds + MISC_OFF);
    for (int u = F.tid; u < (LDS_BYTES - LDSCTL_OFF) / 4; u += NTHR) ((LAS unsigned*)(F.lds + LDSCTL_OFF))[u] = 0u;
    __syncthreads();
    const int lo = args.ph_lo, hi = args.ph_hi;
    const bool multi = (hi - lo) > 1;
    XcdBarrier bar; bar.bar = (unsigned*)(F.ws + WS_CTL) + CW_BAR; bar.x = 0; bar.st = nullptr;
    if (multi) bar = xcd_barrier_post((unsigned*)(F.ws + WS_CTL) + CW_BAR, MISC + 8);
#ifndef PH_MASK
#define PH_MASK 0x1fff
#endif
#define IN(k) (((PH_MASK >> (k)) & 1) && lo <= (k) && (k) < hi)
#define SEAM(k) do { if (IN(k) && IN((k) + 1)) xcd_barrier(bar); } while (0)
#define NREP(k) ((((REP_MASK) >> (k)) & 1) ? 2 : 1)
#define REPSYNC(k) do { if (((REP_MASK) >> (k)) & 1) xcd_barrier(bar); } while (0)

    PROBE_BEGIN(100);
    if (IN(0)) for (int rep = 0; rep < NREP(0); ++rep) { if (rep) REPSYNC(0); p0_prologue(F); } SEAM(0); PROBE_END(100);
    PROBE_BEGIN(101);
    if (IN(1)) for (int rep = 0; rep < NREP(1); ++rep) { if (rep) REPSYNC(1); modnorm_rows(F, F.in[I_XP], F.in[I_XS], F.in[I_N1], 0, 1024, WSP(bf16, WS_H)); } SEAM(1); PROBE_END(101);
    PROBE_BEGIN(102);
    if (IN(2)) for (int rep = 0; rep < NREP(2); ++rep) { if (rep) REPSYNC(2);
        pg8::Gemm g{WSP(bf16, WS_H), WSP(bf16, WS_WIN), NT, NPAD, DM}; pg8::StaticOrder S; S.init(NT, NPAD, DM, F.G, F.bid);
        pg8::EpiProj E;
        E.d0 = OUTB(bf16, OUT_QA); E.d1 = OUTB(bf16, OUT_GF); E.d2 = OUTB(bf16, OUT_GB); E.d3 = OUTB(bf16, OUT_VA); E.d4 = WSP(bf16, WS_AG);
        E.d5 = WSP(bf16, WS_BQ); E.d6 = WSP(bf16, WS_BK); E.d7 = WSP(bf16, WS_BV); E.d8 = WSP(bf16, WS_BZ);
        E.BETA = WSP(float, WS_BETA); E.GG = WSP(float, WS_GG); E.lbraw = F.in[I_LB]; E.Alog = F.in[I_ALOG]; E.dtb = F.in[I_DTB];
        pg8::gemm_phase<pg8::EpiProj, pg8::StaticOrder, true, true>(F.lds, g, S, E);
    } SEAM(2); PROBE_END(102);
    PROBE_BEGIN(103);
    if (IN(3)) for (int rep = 0; rep < NREP(3); ++rep) { if (rep) REPSYNC(3); p3_hgrn(F); } SEAM(3); PROBE_END(103);
    PROBE_BEGIN(104);
    if (IN(4)) for (int rep = 0; rep < NREP(4); ++rep) { if (rep) REPSYNC(4); p4_chain<false>(F); } SEAM(4); PROBE_END(104);
    PROBE_BEGIN(105);
    if (IN(5)) for (int rep = 0; rep < NREP(5); ++rep) { if (rep) REPSYNC(5); p3_gdn(F, 0, (F.G == 256) ? NUC - NR_EARLY : NUC, F.bid, F.G); } SEAM(5); PROBE_END(105);
    PROBE_BEGIN(106);
    if (IN(6)) for (int rep = 0; rep < NREP(6); ++rep) { if (rep) REPSYNC(6); p4_chain<true>(F); } SEAM(6); PROBE_END(106);
    PROBE_BEGIN(107);
    if (IN(7)) for (int rep = 0; rep < NREP(7); ++rep) { if (rep) REPSYNC(7); if (F.G != 256) late_weights(F, F.bid * NWAVES + F.wave, F.G * NWAVES); p5_headnorm(F); } SEAM(7); PROBE_END(107);
    PROBE_BEGIN(108);
    if (IN(8)) for (int rep = 0; rep < NREP(8); ++rep) { if (rep) REPSYNC(8);
        pg8::Gemm g{WSP(bf16, WS_YIN), WSP(bf16, WS_WOUT), NT, DM, DM}; pg8::SplitOrder S; S.init(NT, DM, DM, F.G, F.bid);
        pg8::EpiSplit<pg8::EpiRes> E{{F.in[I_XP], F.in[I_XS], F.out, WSP(float, WS_MOD), 2048, nullptr, nullptr, nullptr}, WSP(float, WS_SLAB), (unsigned*)(F.ws + WS_CTL) + CW_SPLIT6, (LAS unsigned*)(F.lds + MISC_OFF + 64)};
        pg8::gemm_phase<pg8::EpiSplit<pg8::EpiRes>, pg8::SplitOrder, true, true>(F.lds, g, S, E);
    } SEAM(8); PROBE_END(108);
    PROBE_BEGIN(109);
    if (IN(9)) for (int rep = 0; rep < NREP(9); ++rep) { if (rep) REPSYNC(9); modnorm_rows(F, F.out, F.out + (size_t)NCTX * DM, F.in[I_N2], 3072, 4096, WSP(bf16, WS_H2)); } SEAM(9); PROBE_END(109);
    PROBE_BEGIN(110);
    if (IN(10)) for (int rep = 0; rep < NREP(10); ++rep) { if (rep) REPSYNC(10);
        pg8::Gemm g{WSP(bf16, WS_H2), WSP(bf16, WS_WGU), NT, 2 * DFF, DM}; pg8::StaticOrder S; S.init(NT, 2 * DFF, DM, F.G, F.bid);
        pg8::EpiGU E{WSP(bf16, WS_GU)};
        pg8::gemm_phase<pg8::EpiGU, pg8::StaticOrder, true, true>(F.lds, g, S, E);
    } SEAM(10); PROBE_END(110);
    PROBE_BEGIN(111);
    if (IN(11)) for (int rep = 0; rep < NREP(11); ++rep) { if (rep) REPSYNC(11);
        pg8::Gemm g{WSP(bf16, WS_GU), WSP(bf16, WS_WDN), NT, DM, DFF}; pg8::SplitOrder S; S.init(NT, DM, DFF, F.G, F.bid);
        pg8::EpiSplit<pg8::EpiRes> E{{F.out, F.out + (size_t)NCTX * DM, F.out, WSP(float, WS_MOD), 5120, nullptr, nullptr, nullptr}, WSP(float, WS_SLAB), (unsigned*)(F.ws + WS_CTL) + CW_SPLIT9, (LAS unsigned*)(F.lds + MISC_OFF + 64)};
        pg8::gemm_phase<pg8::EpiSplit<pg8::EpiRes>, pg8::SplitOrder, true, true>(F.lds, g, S, E);
    } SEAM(11); PROBE_END(111);
    PROBE_BEGIN(112);
    if (IN(12)) for (int rep = 0; rep < NREP(12); ++rep) { if (rep) REPSYNC(12); final_norm(F); }
    PROBE_END(112);
    if (PROBE_ID != 0 && blockIdx.x == PROBE_BLK && threadIdx.x == 0) { const unsigned long long t0 = __builtin_amdgcn_s_memrealtime(), dt = F.pacc * PROBE_K; while (__builtin_amdgcn_s_memrealtime() - t0 < dt) __builtin_amdgcn_s_sleep(16); }
#undef IN
#undef SEAM
}

extern "C" void kernel_launch(void* const* d_in, const int* in_sizes, int n_in, void* d_out, int out_size, void* d_ws, size_t ws_size, hipStream_t stream) {
    static int grid = 0;
    if (grid == 0) {
        if (n_in != N_IN || ws_size < WS_END) { fprintf(stderr, "kernel_launch: unexpected n_in %d / ws %zu\n", n_in, ws_size); grid = -1; return; }
        int dev = 0, cus = 0;
        if (hipGetDevice(&dev) != hipSuccess || hipDeviceGetAttribute(&cus, hipDeviceAttributeMultiprocessorCount, dev) != hipSuccess) { grid = -1; return; }
        if (hipFuncSetAttribute((const void*)mk_fwd, hipFuncAttributeMaxDynamicSharedMemorySize, LDS_BYTES) != hipSuccess) { fprintf(stderr, "kernel_launch: hipFuncSetAttribute failed\n"); grid = -1; return; }
        int per_cu = 0;
        if (hipOccupancyMaxActiveBlocksPerMultiprocessor(&per_cu, (const void*)mk_fwd, NTHR, LDS_BYTES) != hipSuccess || per_cu < 1) { fprintf(stderr, "kernel_launch: occupancy query reports %d\n", per_cu); }
        (void)hipGetLastError();
        grid = cus < 256 ? cus : 256;
    }
    if (grid < 0) return;
    (void)hipMemsetAsync((char*)d_ws + WS_CTL, 0, CTL_ZERO_BYTES, stream);
    Args a{};
    for (int i = 0; i < N_IN; ++i) a.in[i] = (const float*)d_in[i];
    a.out = (float*)d_out; a.ws = (unsigned char*)d_ws;
#if MK_ONE_LAUNCH
    a.ph_lo = 0; a.ph_hi = NPHASE;
    hipLaunchKernelGGL(mk_fwd, dim3(grid), dim3(NTHR), LDS_BYTES, stream, a);
#else
    for (int k = 0; k < NPHASE; ++k) { a.ph_lo = k; a.ph_hi = k + 1; hipLaunchKernelGGL(mk_fwd, dim3(grid), dim3(NTHR), LDS_BYTES, stream, a); }
#endif
}
```

```cpp
#include <hip/hip_runtime.h>
#include <cstdio>
#include <cstdint>

#ifndef REP_MASK
#define REP_MASK 0x0
#endif
#ifndef PROBE_ID
#define PROBE_ID 0
#endif
#define PROBE_K 1
#ifndef PROBE_BLK
#define PROBE_BLK 0
#endif
#ifndef MK_ONE_LAUNCH
#define MK_ONE_LAUNCH 1
#endif

#define LAS __attribute__((address_space(3)))
#define GAS __attribute__((address_space(1)))
typedef unsigned short bf16;
typedef short bf16x8 __attribute__((ext_vector_type(8)));
typedef float f32x4 __attribute__((ext_vector_type(4)));
typedef float f32x2 __attribute__((ext_vector_type(2)));
typedef unsigned u32x4 __attribute__((ext_vector_type(4)));
typedef unsigned u32x2 __attribute__((ext_vector_type(2)));
typedef GAS unsigned gu32;

constexpr int NT = 20480, NCTX = 4096, DM = 1024, DPROJ = 4624, NPAD = 4864, DFF = 2816, NSEQ = 20;
constexpr float EPS = 1e-6f;
constexpr int NWAVES = 8, NTHR = 512;
enum { I_XP = 0, I_XS, I_C, I_SH, I_SG, I_CCTX, I_WADA, I_BADA, I_N1, I_N2, I_WIN, I_CONV, I_LB, I_ALOG, I_DTB, I_HNORM, I_GNORM, I_WOUT, I_WGATE, I_WUP, I_WDOWN, I_NF, N_IN };

constexpr size_t MiB = 1u << 20;
constexpr size_t WS_CTL = 0, CTL_ZERO_BYTES = 2 * MiB;
constexpr size_t WS_MOD = 1 * MiB;
constexpr size_t WS_BETA = 2 * MiB, WS_GG = 3 * MiB;
constexpr size_t WS_BQ = 4 * MiB, WS_BK = 24 * MiB, WS_BV = 44 * MiB;
constexpr size_t WS_OB = 4 * MiB;
constexpr size_t WS_AG = 64 * MiB, WS_BZ = 84 * MiB;
constexpr size_t WS_I = 104 * MiB;
constexpr size_t WS_H = 104 * MiB;
constexpr size_t WS_WIN = 144 * MiB;
constexpr size_t WS_YIN = 104 * MiB;
constexpr size_t WS_WOUT = 44 * MiB, WS_WGU = 46 * MiB, WS_WDN = 57 * MiB;
constexpr size_t WS_H2 = 4 * MiB;
constexpr size_t WS_GU = 64 * MiB;
constexpr size_t WS_SLAB = 160 * MiB;
constexpr size_t WS_XR = 176 * MiB;
constexpr size_t WS_END = 256 * MiB;
constexpr size_t OUT_QA = 0, OUT_VA = 20 * MiB, OUT_GF = 40 * MiB, OUT_GB = 60 * MiB, OUT_OA = 0, OUT_GOVF = 40 * MiB;
constexpr size_t OUT_Y_FLOATS = (size_t)NT * DM, STATE_FLOATS = (size_t)16 * 2 * 4 * 128 * 128;
constexpr int HREC = 41472;
constexpr int GREC = 73984;
constexpr int NUC = 2560, NVB = 1280;
constexpr size_t WS_HVB = WS_I + (size_t)NUC * HREC;
constexpr int N1G = 2154;
static_assert((size_t)N1G * GREC <= 152 * MiB && (size_t)(NUC - N1G) * GREC <= 40 * MiB, "GDN image split");
constexpr int NR_EARLY = 768;
static_assert(WS_I + (size_t)(NUC - NR_EARLY) * GREC >= WS_I + (size_t)NUC * HREC + (size_t)NVB * 16384, "early GDN records must not touch the HGRN images");
static_assert(WS_HVB + (size_t)NVB * 16384 <= WS_END, "HGRN images fit");
constexpr int L_WN = 0, L_QD = 16384, L_AT = 32768, L_KT = 40960, L_U = 57344, L_SC = 73728;

constexpr int CW_BAR = 4096;
constexpr int CW_PROG_H = 16384, CW_PROG_G = 16384 + 64 * 32;
constexpr int P4_PD = 4;
constexpr int CW_SPLIT6 = 32768, CW_SPLIT9 = 32768 + 64 * 64;
constexpr int P4_BUF = 74752;
constexpr int RING_BYTES = 2 * P4_BUF, LDSCTL_OFF = RING_BYTES, MISC_OFF = LDSCTL_OFF + 320, LDS_BYTES = RING_BYTES + 1024;
static_assert(RING_BYTES >= 131072 && LDS_BYTES <= 163840, "LDS map");

#define PROBE_BEGIN(id) do { if (PROBE_ID == (id) && blockIdx.x == PROBE_BLK && threadIdx.x == 0) probe_t0 = __builtin_amdgcn_s_memrealtime(); } while (0)
#define PROBE_END(id) do { if (PROBE_ID == (id) && blockIdx.x == PROBE_BLK && threadIdx.x == 0) probe_acc += __builtin_amdgcn_s_memrealtime() - probe_t0; } while (0)
#define LDS_WAIT() asm volatile("s_waitcnt lgkmcnt(0)" ::: "memory")
#define VM_WAIT() asm volatile("s_waitcnt vmcnt(0)" ::: "memory")
#define RLX_AGENT __ATOMIC_RELAXED, __HIP_MEMORY_SCOPE_AGENT
__device__ __forceinline__ unsigned f2bf(float f) { unsigned u = __builtin_bit_cast(unsigned, f); return (u + 0x7fffu + ((u >> 16) & 1u)) >> 16; }
__device__ __forceinline__ unsigned pk2(float lo, float hi) { return f2bf(lo) | (f2bf(hi) << 16); }
__device__ __forceinline__ float bflo(unsigned w) { return __builtin_bit_cast(float, w << 16); }
__device__ __forceinline__ float bfhi(unsigned w) { return __builtin_bit_cast(float, w & 0xffff0000u); }
__device__ __forceinline__ float bf2f(unsigned short h) { return __builtin_bit_cast(float, (unsigned)h << 16); }
__device__ __forceinline__ float siluf(float x) { return x * __builtin_amdgcn_rcpf(1.f + __expf(-x)); }
__device__ __forceinline__ float sigmf(float x) { return __builtin_amdgcn_rcpf(1.f + __expf(-x)); }
__device__ __forceinline__ f32x4 mfma16(bf16x8 a, bf16x8 b, f32x4 c) { return __builtin_amdgcn_mfma_f32_16x16x32_bf16(a, b, c, 0, 0, 0); }
__device__ __forceinline__ bf16x8 as_frag(u32x4 v) { return __builtin_bit_cast(bf16x8, v); }
__device__ __forceinline__ float wave_sum(float v) {
#pragma unroll
    for (int o = 1; o < 64; o <<= 1) v += __shfl_xor(v, o);
    return v;
}
__device__ __forceinline__ int seq_base(int s) { return s < 16 ? s * 256 : NCTX + (s - 16) * 4096; }
__device__ __forceinline__ int seq_nchunk(int s) { return s < 16 ? 4 : 64; }
__device__ __forceinline__ int chunk_base(int s) { return s < 16 ? 4 * s : 64 + 64 * (s - 16); }
__device__ __forceinline__ int tok_a(int s, int n, int i) { return seq_base(s) + 64 * n + i; }
__device__ __forceinline__ int tok_b(int s, int n, int i) { return s < 16 ? s * 256 + 64 * n + i : NCTX + (s - 16) * 4096 + 64 * i + n; }
__device__ __forceinline__ int kperm(int g, int j) { return 16 * (j >> 2) + 4 * g + (j & 3); }

namespace pg8 {
#define PG8_LAS __attribute__((address_space(3)))
typedef unsigned short bf16_t;
typedef short bf16x8 __attribute__((ext_vector_type(8)));
typedef float f32x4 __attribute__((ext_vector_type(4)));
typedef unsigned u32x4 __attribute__((ext_vector_type(4)));
constexpr int BM = 256, BK = 64, HALF = 128, HTB = HALF * BK * 2  , STAGE_BYTES = 8 * HTB, NXCD = 8, WGM = 8;

__host__ __device__ __forceinline__ int lds_byte(int r, int c) { const int st = (r >> 4) * 2 + (c >> 5), rr = r & 15, cc = c & 31, ob = rr * 64 + cc * 2; return st * 1024 + (ob ^ (((ob >> 9) & 1) << 5)); }
__host__ __device__ __forceinline__ void stage_rc(int b, int& R, int& C) { const int st = b / 1024, sb = b % 1024, swz = sb ^ (((sb >> 9) & 1) << 5); R = (st >> 1) * 16 + swz / 64; C = (st & 1) * 32 + (swz % 64) / 2; }
__host__ __device__ __forceinline__ int perm32(int rho) { const int n = rho >> 4, i = rho & 15; return 8 * (i >> 2) + 4 * n + (i & 3); }

struct Unit { int pm, pn, k0, nt, ns, su, sl; };
struct Gemm { const bf16_t* A; const bf16_t* Bt; int M, N, K; };

struct StaticOrder {
    int nM, nN, nwg, G, c, K;
    __host__ __device__ void init(int M, int N, int K_, int G_, int c_) { nM = M / BM; nN = N / BM; nwg = nM * nN; G = G_; c = c_; K = K_; }
    __host__ __device__ bool next(int i, Unit& u) const {
        const long L = (long)i * G + c; if (L >= nwg) return false;
        int wgid = (int)L; { const int q = nwg / NXCD, r = nwg % NXCD, xcd = wgid % NXCD, off = wgid / NXCD; wgid = (xcd < r ? xcd * (q + 1) : r * (q + 1) + (xcd - r) * q) + off; }
        const int nig = WGM * nN, gid = wgid / nig, fm = gid * WGM, gsz = (nM - fm) < WGM ? (nM - fm) : WGM;
        u.pm = fm + ((wgid % nig) % gsz); u.pn = (wgid % nig) / gsz; u.k0 = 0; u.nt = K / BK; u.ns = 1; u.su = 0; u.sl = 0; return true;
    }
    __device__ __forceinline__ void a_ready(const Unit&) const {}
    __device__ __forceinline__ void done(const Unit&) const {}
};

struct SplitOrder {
    StaticOrder so; bool split;
    __host__ __device__ void init(int M, int N, int K_, int G_, int c_) { so.init(M, N, K_, G_, c_); split = false && (G_ == 256 && so.nwg == 320); }
    __host__ __device__ bool next(int i, Unit& u) const {
        if (!split) return so.next(i, u);
        if (i == 0) return so.next(0, u);
        if (i > 1) return false;
        StaticOrder t = so; t.c = 256 + (so.c >> 2); t.G = 1 << 20; if (!t.next(0, u)) return false;
        const int ntt = so.K / BK, sl = so.c & 3, q = ((ntt / 4) + 1) & ~1;
        const int big = (ntt - 4 * (q - 2)) / 2;
        const int t0 = sl < big ? sl * q : big * q + (sl - big) * (q - 2), tn = sl < big ? q : q - 2;
        u.k0 = t0 * BK; u.nt = tn; u.ns = 4; u.su = so.c >> 2; u.sl = sl; return true;
    }
    __device__ __forceinline__ void a_ready(const Unit&) const {}
    __device__ __forceinline__ void done(const Unit&) const {}
};

__device__ __forceinline__ unsigned pkbf(float lo, float hi) { return ::pk2(lo, hi); }

struct EpiProj {
    static constexpr bool PERM = true, AFTER_DRAIN = false;
    bf16_t *d0, *d1, *d2, *d3, *d4, *d5, *d6, *d7, *d8;
    float* BETA; float* GG;
    const float* lbraw;
    const float* Alog; const float* dtb;
    __device__ __forceinline__ void operator()(const f32x4 (&acc)[2][2][4][2], const Unit& u, int wr, int wc, int fr, int fq) const {
        const int pn = u.pn, row0 = u.pm * BM + wr * 64 + fr;
        if (pn < 18) {
            const int seg = pn >> 1;
            bf16_t* base = seg == 0 ? d0 : seg == 1 ? d1 : seg == 2 ? d2 : seg == 3 ? d3 : seg == 4 ? d4 : seg == 5 ? d5 : seg == 6 ? d6 : seg == 7 ? d7 : d8;
            const int mode = (seg == 0 || seg == 4 || seg == 8) ? 1 : ((seg == 1 || seg == 2) ? 2 : 0);
#pragma unroll
            for (int bj = 0; bj < 2; ++bj) {
                const int c0 = (pn & 1) * 256 + bj * HALF + wc * 32 + 8 * fq;
                float lb[8];
                if (mode == 2) {
                    const int dir = seg - 1;
#pragma unroll
                    for (int e = 0; e < 8; ++e) { const float x0 = lbraw[dir * 512 + c0 + e], x1 = lbraw[1024 + dir * 512 + c0 + e]; lb[e] = 1.f / (1.f + __expf(x1 - x0)); }
                }
#pragma unroll
                for (int ai = 0; ai < 2; ++ai)
#pragma unroll
                    for (int m = 0; m < 4; ++m) {
                        float v[8];
#pragma unroll
                        for (int e = 0; e < 4; ++e) { v[e] = acc[ai][bj][m][0][e]; v[4 + e] = acc[ai][bj][m][1][e]; }
                        if (mode == 1) {
#pragma unroll
                            for (int e = 0; e < 8; ++e) v[e] = ::siluf(v[e]);
                        } else if (mode == 2) {
#pragma unroll
                            for (int e = 0; e < 8; ++e) { const float f = lb[e] + (1.f - lb[e]) * ::sigmf(v[e]); v[e] = __logf(f); }
                        }
                        u32x4 w; w.x = pkbf(v[0], v[1]); w.y = pkbf(v[2], v[3]); w.z = pkbf(v[4], v[5]); w.w = pkbf(v[6], v[7]);
                        *(u32x4*)(base + (size_t)(row0 + ai * HALF + m * 16) * 512 + c0) = w;
                    }
            }
        } else {
            if (wc == 0 && fq < 2) {
                float al[8], db[8];
                if (fq == 1) {
#pragma unroll
                    for (int e = 0; e < 8; ++e) { al[e] = -__expf(Alog[e]); db[e] = dtb[e]; }
                }
#pragma unroll
                for (int ai = 0; ai < 2; ++ai)
#pragma unroll
                    for (int m = 0; m < 4; ++m) {
                        const int row = row0 + ai * HALF + m * 16;
                        float v[8];
#pragma unroll
                        for (int e = 0; e < 4; ++e) { v[e] = acc[ai][0][m][0][e]; v[4 + e] = acc[ai][0][m][1][e]; }
                        if (fq == 0) {
#pragma unroll
                            for (int e = 0; e < 8; ++e) v[e] = ::sigmf(v[e]);
                            *(f32x4*)(BETA + (size_t)row * 8) = (f32x4){v[0], v[1], v[2], v[3]};
                            *(f32x4*)(BETA + (size_t)row * 8 + 4) = (f32x4){v[4], v[5], v[6], v[7]};
                        } else {
#pragma unroll
                            for (int e = 0; e < 8; ++e) { const float x = v[e] + db[e]; const float sp = x > 15.f ? x : log1pf(__expf(x)); v[e] = al[e] * sp; }
                            *(f32x4*)(GG + (size_t)row * 8) = (f32x4){v[0], v[1], v[2], v[3]};
                            *(f32x4*)(GG + (size_t)row * 8 + 4) = (f32x4){v[4], v[5], v[6], v[7]};
                        }
                    }
            }
        }
    }
};

template <bool BASE_BF16> struct EpiRes {
    static constexpr bool PERM = true, AFTER_DRAIN = false;
    const float* base0; const float* base1;
    const bf16_t* baseb;
    bf16_t* out; const float* mod; int goff;
    const float *p1 = nullptr, *p2 = nullptr, *p3 = nullptr;
    __device__ __forceinline__ void operator()(const f32x4 (&acc)[2][2][4][2], const Unit& u, int wr, int wc, int fr, int fq) const {
        const int row0 = u.pm * BM + wr * 64 + fr;
        const int mr = u.pm < 16 ? 0 : 1 + ((u.pm - 16) >> 4);
        const float* gp = mod + (size_t)mr * 6144 + goff;
#pragma unroll
        for (int bj = 0; bj < 2; ++bj) {
            const int c0 = u.pn * BM + bj * HALF + wc * 32 + 8 * fq;
            const f32x4 g0 = *(const f32x4*)(gp + c0), g1 = *(const f32x4*)(gp + c0 + 4);
#pragma unroll
            for (int ai = 0; ai < 2; ++ai)
#pragma unroll
                for (int m = 0; m < 4; ++m) {
                    const int row = row0 + ai * HALF + m * 16;
                    f32x4 b0, b1;
                    if (BASE_BF16) { const u32x4 bw = *(const u32x4*)(baseb + (size_t)row * 1024 + c0);
                        b0 = (f32x4){::bflo(bw.x), ::bfhi(bw.x), ::bflo(bw.y), ::bfhi(bw.y)}; b1 = (f32x4){::bflo(bw.z), ::bfhi(bw.z), ::bflo(bw.w), ::bfhi(bw.w)}; }
                    else { const float* bp = (row < 4096 ? base0 + (size_t)row * 1024 : base1 + (size_t)(row - 4096) * 1024) + c0; b0 = *(const f32x4*)bp; b1 = *(const f32x4*)(bp + 4); }
                    f32x4 a0 = acc[ai][bj][m][0], a1 = acc[ai][bj][m][1];
                    if (p1) { const float *q1 = p1 + threadIdx.x * 4, *q2 = p2 + threadIdx.x * 4, *q3 = p3 + threadIdx.x * 4; asm volatile("" : "+v"(q1), "+v"(q2), "+v"(q3));
                        const int i0 = (((ai * 2 + bj) * 4 + m) * 2) * 2048, i1 = i0 + 2048;
                        a0 = a0 + (*(const f32x4*)(q1 + i0) + *(const f32x4*)(q2 + i0)) + *(const f32x4*)(q3 + i0); a1 = a1 + (*(const f32x4*)(q1 + i1) + *(const f32x4*)(q2 + i1)) + *(const f32x4*)(q3 + i1); }
                    const f32x4 o0 = b0 + g0 * a0, o1 = b1 + g1 * a1;
                    u32x4 w; w.x = pkbf(o0[0], o0[1]); w.y = pkbf(o0[2], o0[3]); w.z = pkbf(o1[0], o1[1]); w.w = pkbf(o1[2], o1[3]);
                    *(u32x4*)(out + (size_t)row * 1024 + c0) = w;
                }
        }
    }
};

struct EpiGU {
    static constexpr bool PERM = true, AFTER_DRAIN = false;
    bf16_t* GU;
    __device__ __forceinline__ void operator()(const f32x4 (&acc)[2][2][4][2], const Unit& u, int wr, int wc, int fr, int fq) const {
        const int row0 = u.pm * BM + wr * 64 + fr, c0 = u.pn * HALF + wc * 32 + 8 * fq;
#pragma unroll
        for (int ai = 0; ai < 2; ++ai)
#pragma unroll
            for (int m = 0; m < 4; ++m) {
                float v[8];
#pragma unroll
                for (int e = 0; e < 4; ++e) { v[e] = ::siluf(acc[ai][0][m][0][e]) * acc[ai][1][m][0][e]; v[4 + e] = ::siluf(acc[ai][0][m][1][e]) * acc[ai][1][m][1][e]; }
                u32x4 w; w.x = pkbf(v[0], v[1]); w.y = pkbf(v[2], v[3]); w.z = pkbf(v[4], v[5]); w.w = pkbf(v[6], v[7]);
                *(u32x4*)(GU + (size_t)(row0 + ai * HALF + m * 16) * 2816 + c0) = w;
            }
    }
};

template <class Inner> struct EpiSplit {
    static constexpr bool PERM = Inner::PERM, AFTER_DRAIN = false;
    Inner in; float* slab; unsigned* cnt; PG8_LAS unsigned* flag;
    __device__ __forceinline__ void operator()(const f32x4 (&acc)[2][2][4][2], const Unit& u, int wr, int wc, int fr, int fq) const {
        if (u.ns == 1) { in(acc, u, wr, wc, fr, fq); return; }
        const int tid = threadIdx.x;
        float* my = slab + (size_t)(u.su * 4 + u.sl) * 65536;
        const __amdgpu_buffer_rsrc_t rs = __builtin_amdgcn_make_buffer_rsrc(my, 0, 262144, 0x00020000);
#pragma unroll
        for (int ai = 0; ai < 2; ++ai)
#pragma unroll
            for (int bj = 0; bj < 2; ++bj)
#pragma unroll
                for (int m = 0; m < 4; ++m)
#pragma unroll
                    for (int n = 0; n < 2; ++n) __builtin_amdgcn_raw_buffer_store_b128(__builtin_bit_cast(u32x4, acc[ai][bj][m][n]), rs, (unsigned)(tid * 16), (unsigned)((((ai * 2 + bj) * 4 + m) * 2 + n) * 8192), 16);
        asm volatile("s_waitcnt vmcnt(0)" ::: "memory");
        __builtin_amdgcn_s_barrier();
        if (tid == 0) {
            const unsigned old = __hip_atomic_fetch_add(cnt + 64 * u.su, 1u, __ATOMIC_RELAXED, __HIP_MEMORY_SCOPE_AGENT);
            const unsigned last = (old == 3u) ? 1u : 0u;
            if (last) { __builtin_amdgcn_fence(__ATOMIC_ACQUIRE, "agent"); asm volatile("s_waitcnt vmcnt(0)" ::: "memory"); }
            *flag = last;
        }
        asm volatile("s_waitcnt lgkmcnt(0)" ::: "memory");
        __builtin_amdgcn_s_barrier();
        const unsigned last = *flag;
        if (last) {
            Inner in2 = in;
            in2.p1 = slab + (size_t)(u.su * 4 + ((u.sl + 1) & 3)) * 65536; in2.p2 = slab + (size_t)(u.su * 4 + ((u.sl + 2) & 3)) * 65536; in2.p3 = slab + (size_t)(u.su * 4 + ((u.sl + 3) & 3)) * 65536;
            in2(acc, u, wr, wc, fr, fq);
        }
    }
};
template <class Epi, class Sched, bool ALIGN_EPI = false, bool SP2 = false>
__device__ __forceinline__ void gemm_phase(PG8_LAS unsigned char* lds, const Gemm g, const Sched& S, const Epi& E) {
    const int tid = threadIdx.x, wid = __builtin_amdgcn_readfirstlane(tid >> 6), lane = tid & 63, wr = wid >> 2, wc = wid & 3, fr = lane & 15, fq = lane >> 4;
    const int K = g.K;
    unsigned voffA[2], voffB[2];
#pragma unroll
    for (int i = 0; i < 2; ++i) { int R, C; stage_rc(tid * 16 + i * 8192, R, C); const int Rb = Epi::PERM ? ((R & ~31) + perm32(R & 31)) : R;
        voffA[i] = (unsigned)(R * K + C) * 2u; voffB[i] = (unsigned)(Rb * K + C) * 2u; }
    const size_t kstep = (size_t)(BK * 2);
    const size_t hstep = (size_t)HALF * K * 2;
    const size_t tstep = 2 * hstep;
    const unsigned ldsw = (unsigned)wid * 1024u;
    const int aoff = lds_byte(wr * 64 + fr, fq * 8), boff = lds_byte(wc * 32 + fr, fq * 8);
#define PG8_SA(b, h) (((b) * 2 + (h)) * HTB)
#define PG8_SB(b, h) ((4 + (b) * 2 + (h)) * HTB)
#define PG8_STAGE(bufoff, gbase, voff) do { _Pragma("unroll") for (int _i = 0; _i < 2; ++_i) \
        __builtin_amdgcn_global_load_lds((const unsigned*)((const char*)(gbase) + (voff)[_i]), (PG8_LAS unsigned*)(lds + (bufoff) + ldsw + _i * 8192), 16, 0, 0); } while (0)
#define PG8_LDA(dst, b, h) do { _Pragma("unroll") for (int m = 0; m < 4; ++m) _Pragma("unroll") for (int k = 0; k < 2; ++k) dst[m][k] = *(const PG8_LAS bf16x8*)(lds + PG8_SA(b, h) + aoff + m * 2048 + k * 1024); } while (0)
#define PG8_LDB(dst, b, h) do { _Pragma("unroll") for (int n = 0; n < 2; ++n) _Pragma("unroll") for (int k = 0; k < 2; ++k) dst[n][k] = *(const PG8_LAS bf16x8*)(lds + PG8_SB(b, h) + boff + n * 2048 + k * 1024); } while (0)
#define PG8_MMA(ai, bj, At, Bt) do { __builtin_amdgcn_s_setprio(1); _Pragma("unroll") for (int m = 0; m < 4; ++m) _Pragma("unroll") for (int n = 0; n < 2; ++n) _Pragma("unroll") for (int k = 0; k < 2; ++k) \
        acc[ai][bj][m][n] = __builtin_amdgcn_mfma_f32_16x16x32_bf16(Bt[n][k], At[m][k], acc[ai][bj][m][n], 0, 0, 0); __builtin_amdgcn_s_setprio(0); } while (0)
#define PG8_WAIT_V(n) asm volatile("s_waitcnt vmcnt(" #n ")" ::: "memory")
#define PG8_WAIT_L(n) asm volatile("s_waitcnt lgkmcnt(" #n ")" ::: "memory")
#define PG8_BAR __builtin_amdgcn_s_barrier()
#define PG8_SCHED __builtin_amdgcn_sched_barrier(0)
    Unit cur, nxt; int ui = 0;
    if (!S.next(0, cur)) return;
    f32x4 acc[2][2][4][2];
#pragma unroll
    for (int a = 0; a < 2; ++a)
#pragma unroll
        for (int b = 0; b < 2; ++b)
#pragma unroll
            for (int m = 0; m < 4; ++m)
#pragma unroll
                for (int n = 0; n < 2; ++n) acc[a][b][m][n] = (f32x4){0.f, 0.f, 0.f, 0.f};
    bf16x8 At[4][2], B0[2][2], B1[2][2];
    const char* cA = (const char*)g.A + (size_t)cur.pm * tstep + (size_t)cur.k0 * 2; const char* cB = (const char*)g.Bt + (size_t)cur.pn * tstep + (size_t)cur.k0 * 2;
    S.a_ready(cur);
    if constexpr (SP2) {
        PG8_STAGE(PG8_SB(0, 0), cB, voffB); PG8_STAGE(PG8_SB(0, 1), cB + hstep, voffB); PG8_STAGE(PG8_SA(0, 0), cA, voffA); PG8_STAGE(PG8_SA(0, 1), cA + hstep, voffA);
        if (wr == 1) PG8_BAR;
        PG8_WAIT_V(2); PG8_BAR;
        PG8_STAGE(PG8_SB(1, 0), cB + kstep, voffB); PG8_STAGE(PG8_SA(1, 0), cA + kstep, voffA); PG8_STAGE(PG8_SB(1, 1), cB + hstep + kstep, voffB);
        PG8_WAIT_V(6); PG8_BAR;
    } else {
        PG8_STAGE(PG8_SB(0, 0), cB, voffB); PG8_STAGE(PG8_SA(0, 0), cA, voffA); PG8_STAGE(PG8_SB(0, 1), cB + hstep, voffB); PG8_STAGE(PG8_SA(0, 1), cA + hstep, voffA);
        if (wr == 1) PG8_BAR;
        PG8_WAIT_V(4); PG8_BAR;
        PG8_STAGE(PG8_SB(1, 0), cB + kstep, voffB); PG8_STAGE(PG8_SA(1, 0), cA + kstep, voffA); PG8_STAGE(PG8_SB(1, 1), cB + hstep + kstep, voffB);
        PG8_WAIT_V(6); PG8_BAR;
    }
    for (;;) {
        const bool has_next = S.next(ui + 1, nxt);
        const char* nA = has_next ? (const char*)g.A + (size_t)nxt.pm * tstep + (size_t)nxt.k0 * 2 : cA; const char* nB = has_next ? (const char*)g.Bt + (size_t)nxt.pn * tstep + (size_t)nxt.k0 * 2 : cB;
        const int nt = cur.nt;
        for (int t = 0; t < nt; t += 2) {
            const bool last = (t == nt - 2);
            const char* a1 = cA + (size_t)(t + 1) * kstep;
            const char* a2 = last ? nA : cA + (size_t)(t + 2) * kstep; const char* b2 = last ? nB : cB + (size_t)(t + 2) * kstep;
            const char* a3 = a2 + kstep; const char* b3 = b2 + kstep;
            if (last && has_next) S.a_ready(nxt);
            if constexpr (SP2) {
            PG8_LDB(B0, 0, 0); PG8_LDB(B1, 0, 1); PG8_SCHED; PG8_LDA(At, 0, 0); PG8_STAGE(PG8_SA(1, 1), a1 + hstep, voffA);
            PG8_WAIT_V(8); PG8_WAIT_L(0); PG8_BAR; PG8_MMA(0, 0, At, B0); PG8_MMA(0, 1, At, B1); PG8_BAR; PG8_SCHED;
            PG8_LDA(At, 0, 1); PG8_STAGE(PG8_SB(0, 0), b2, voffB); PG8_STAGE(PG8_SB(0, 1), b2 + hstep, voffB); PG8_STAGE(PG8_SA(0, 0), a2, voffA);
            PG8_WAIT_V(8); PG8_WAIT_L(0); PG8_BAR; PG8_MMA(1, 0, At, B0); PG8_MMA(1, 1, At, B1); PG8_BAR; PG8_SCHED;
            PG8_LDB(B0, 1, 0); PG8_LDB(B1, 1, 1); PG8_SCHED; PG8_LDA(At, 1, 0); PG8_STAGE(PG8_SA(0, 1), a2 + hstep, voffA);
            PG8_WAIT_V(8); PG8_WAIT_L(0); PG8_BAR; PG8_MMA(0, 0, At, B0); PG8_MMA(0, 1, At, B1); PG8_BAR; PG8_SCHED;
            PG8_LDA(At, 1, 1); PG8_STAGE(PG8_SB(1, 0), b3, voffB); PG8_STAGE(PG8_SB(1, 1), b3 + hstep, voffB); PG8_STAGE(PG8_SA(1, 0), a3, voffA);
            PG8_WAIT_V(8); PG8_WAIT_L(0); PG8_BAR; PG8_MMA(1, 0, At, B0); PG8_MMA(1, 1, At, B1); PG8_BAR; PG8_SCHED;
            } else {
            PG8_LDB(B0, 0, 0); PG8_SCHED; PG8_LDA(At, 0, 0); PG8_STAGE(PG8_SA(1, 1), a1 + hstep, voffA);
            PG8_WAIT_L(8); PG8_BAR; PG8_WAIT_L(0); PG8_MMA(0, 0, At, B0); PG8_BAR; PG8_SCHED;
            PG8_LDB(B1, 0, 1); PG8_STAGE(PG8_SB(0, 0), b2, voffB);
            PG8_BAR; PG8_WAIT_L(0); PG8_MMA(0, 1, At, B1); PG8_BAR;
            PG8_LDA(At, 0, 1); PG8_STAGE(PG8_SA(0, 0), a2, voffA);
            PG8_BAR; PG8_WAIT_L(0); PG8_MMA(1, 0, At, B0); PG8_BAR; PG8_SCHED;
            PG8_STAGE(PG8_SB(0, 1), b2 + hstep, voffB);
            PG8_WAIT_V(6); PG8_BAR; PG8_MMA(1, 1, At, B1); PG8_BAR;
            PG8_LDB(B0, 1, 0); PG8_SCHED; PG8_LDA(At, 1, 0); PG8_STAGE(PG8_SA(0, 1), a2 + hstep, voffA);
            PG8_WAIT_L(8); PG8_BAR; PG8_WAIT_L(0); PG8_MMA(0, 0, At, B0); PG8_BAR; PG8_SCHED;
            PG8_LDB(B1, 1, 1); PG8_STAGE(PG8_SB(1, 0), b3, voffB);
            PG8_BAR; PG8_WAIT_L(0); PG8_MMA(0, 1, At, B1); PG8_BAR;
            PG8_LDA(At, 1, 1); PG8_STAGE(PG8_SA(1, 0), a3, voffA);
            PG8_BAR; PG8_WAIT_L(0); PG8_MMA(1, 0, At, B0); PG8_BAR; PG8_SCHED;
            PG8_STAGE(PG8_SB(1, 1), b3 + hstep, voffB);
            PG8_WAIT_V(6); PG8_BAR; PG8_MMA(1, 1, At, B1); PG8_BAR;
            }
        }
        if constexpr (ALIGN_EPI) { if (wr == 0) PG8_BAR; }
        if constexpr (!Epi::AFTER_DRAIN) { E(acc, cur, wr, wc, fr, fq); S.done(cur); }
        if (!has_next) break;
#pragma unroll
        for (int a = 0; a < 2; ++a)
#pragma unroll
            for (int b = 0; b < 2; ++b)
#pragma unroll
                for (int m = 0; m < 4; ++m)
#pragma unroll
                    for (int n = 0; n < 2; ++n) acc[a][b][m][n] = (f32x4){0.f, 0.f, 0.f, 0.f};
        cur = nxt; cA = nA; cB = nB; ++ui;
        if constexpr (ALIGN_EPI) { if (wr == 1) PG8_BAR; }
    }
    PG8_WAIT_V(0);
    if constexpr (!ALIGN_EPI) { if (wr == 0) PG8_BAR; }
    PG8_BAR;
    if constexpr (Epi::AFTER_DRAIN) { E.fused(acc, cur, wr, wc, fr, fq, lds, wid, lane); S.done(cur); }
#undef PG8_SA
#undef PG8_SB
#undef PG8_STAGE
#undef PG8_LDA
#undef PG8_LDB
#undef PG8_MMA
#undef PG8_WAIT_V
#undef PG8_WAIT_L
#undef PG8_BAR
#undef PG8_SCHED
}
}

#define XB_TMO      128
#define XB_XCNT(j)  (256  + 64 * (j))
#define XB_XSUB(j)  (1280 + 64 * (j))
#define XB_XGEN(j)  (2304 + 64 * (j))
#define XB_TOP      3328
#define XB_TOPGEN   3392
#define XCD_BAR_WORDS 3456
#define XB_SPIN_CAP (1u << 18)

__device__ __forceinline__ unsigned xb_ld(unsigned* p)              { return __hip_atomic_load(p, __ATOMIC_RELAXED, __HIP_MEMORY_SCOPE_AGENT); }
__device__ __forceinline__ unsigned xb_add(unsigned* p, unsigned v) { return __hip_atomic_fetch_add(p, v, __ATOMIC_RELAXED, __HIP_MEMORY_SCOPE_AGENT); }
__device__ __forceinline__ unsigned xb_xcc_id() { return (unsigned)__builtin_amdgcn_s_getreg((3 << 11) | 20) & 0xFu; }
#define XB_SPIN(cond, bar) do { unsigned _sp = 0; while (cond) { __builtin_amdgcn_s_sleep(1); \
    if ((++_sp & 255u) == 0u) { if (xb_ld(&(bar)[XB_TMO])) break; if (_sp > XB_SPIN_CAP) { atomicAdd(&(bar)[XB_TMO], 1u); break; } } } } while (0)

struct XcdBarrier {
    unsigned* bar; unsigned x;
    volatile LAS unsigned* st;
};

__device__ __forceinline__ XcdBarrier xcd_barrier_post(unsigned* bar, volatile LAS unsigned* st) {
    XcdBarrier b; b.bar = bar; b.x = xb_xcc_id(); b.st = st;
    if (threadIdx.x == 0) (void)xb_add(&bar[XB_XCNT(b.x)], 1u);
    return b;
}
__device__ __forceinline__ void xcd_barrier_complete(unsigned* bar, unsigned x, unsigned& nloc, unsigned& nx) {
    const unsigned G = gridDim.x * gridDim.y * gridDim.z;
    unsigned sum, cnt, mine, sp = 0u;
    for (;;) {
        sum = 0u; cnt = 0u; mine = 0u;
#pragma unroll
        for (unsigned j = 0; j < 16; ++j) { const unsigned c = xb_ld(&bar[XB_XCNT(j)]); sum += c; cnt += (c > 0u) ? 1u : 0u; mine = (j == x) ? c : mine; }
        if (sum == G) break;
        __builtin_amdgcn_s_sleep(1);
        if ((++sp & 255u) == 0u) { if (xb_ld(&bar[XB_TMO])) break; if (sp > XB_SPIN_CAP) { atomicAdd(&bar[XB_TMO], 1u); break; } }
    }
    nloc = mine > 0u ? mine : 1u; nx = cnt > 0u ? cnt : 1u;
}

__device__ __forceinline__ void xcd_barrier(const XcdBarrier& b) {
    asm volatile("s_waitcnt vmcnt(0)" ::: "memory");
    __syncthreads();
    if (threadIdx.x == 0) {
        unsigned* bar = b.bar;
        __builtin_amdgcn_s_waitcnt(0);
        unsigned nloc = b.st[0], nx = b.st[1];
        if (nloc == 0u) { xcd_barrier_complete(bar, b.x, nloc, nx); b.st[0] = nloc; b.st[1] = nx; }
        const unsigned old = xb_add(&bar[XB_XSUB(b.x)], 1u);
        const unsigned gen = old / nloc;
        if (old + 1u == (gen + 1u) * nloc) {
            __builtin_amdgcn_fence(__ATOMIC_RELEASE, "agent");
            asm volatile("s_waitcnt vmcnt(0)" ::: "memory");
            const unsigned og = xb_add(&bar[XB_TOP], 1u);
            const unsigned tg = og / nx;
            if (og + 1u == (tg + 1u) * nx) xb_add(&bar[XB_TOPGEN], 1u);
            else XB_SPIN(xb_ld(&bar[XB_TOPGEN]) == tg, bar);
            __builtin_amdgcn_fence(__ATOMIC_ACQUIRE, "agent");
            xb_add(&bar[XB_XGEN(b.x)], 1u);
            asm volatile("s_waitcnt vmcnt(0)" ::: "memory");
        } else {
            XB_SPIN(xb_ld(&bar[XB_XGEN(b.x)]) == gen, bar);
            __builtin_amdgcn_fence(__ATOMIC_ACQUIRE, "agent");
            asm volatile("s_waitcnt vmcnt(0)" ::: "memory");
        }
    }
    __syncthreads();
}

struct Args { const float* in[N_IN]; float* out; unsigned char* ws; int ph_lo, ph_hi; };
struct Frame {
    LAS unsigned char* lds;
    int tid, lane, wave, bid, G;
    unsigned long long pacc, pt0;
    const float* in[N_IN];
    float* out; unsigned char* ws;
};
#define probe_acc F.pacc
#define probe_t0 F.pt0
#define WSP(T, off) ((T*)(F.ws + (off)))
#define OUTB(T, off) ((T*)((unsigned char*)F.out + (off)))

__device__ __forceinline__ void transpose_item(const float* W, int K, int N, bf16* WT, int dst_row0, int k0, int n0, LAS float* scr, int lane) {
    float wv[32];
#pragma unroll
    for (int i = 0; i < 32; ++i) { const int kk = 2 * i + (lane >> 5), n = n0 + (lane & 31); wv[i] = n < N ? W[(size_t)(k0 + kk) * N + n] : 0.f; }
#pragma unroll
    for (int i = 0; i < 32; ++i) { const int kk = 2 * i + (lane >> 5); scr[kk * 33 + (lane & 31)] = wv[i]; }
    LDS_WAIT(); asm volatile("" ::: "memory");
    const int c = lane & 7;
#pragma unroll
    for (int j = 0; j < 4; ++j) { const int n = (lane >> 3) + 8 * j; const LAS float* s = scr + (8 * c) * 33 + n;
        u32x4 o; o.x = pk2(s[0 * 33], s[1 * 33]); o.y = pk2(s[2 * 33], s[3 * 33]); o.z = pk2(s[4 * 33], s[5 * 33]); o.w = pk2(s[6 * 33], s[7 * 33]);
        *(u32x4*)(WT + (size_t)(dst_row0 + n) * K + k0 + 8 * c) = o; }
    LDS_WAIT(); asm volatile("" ::: "memory");
}

__device__ __forceinline__ void p0_prologue(Frame& F) {
    const int gw = F.bid * NWAVES + F.wave, NGW = F.G * NWAVES;
    {
        LAS float* scr = (LAS float*)(F.lds + 49152 + F.wave * 8704);
        constexpr int NB = NPAD / 32, NITEMS = 16 * NB;
        for (int it = gw; it < NITEMS; it += NGW) { const int kb = it / NB, nb = it % NB; transpose_item(F.in[I_WIN], 1024, DPROJ, WSP(bf16, WS_WIN), 32 * nb, 64 * kb, 32 * nb, scr, F.lane); }
    }
    {
        LAS float* sc = (LAS float*)F.lds;
        LAS float* red = (LAS float*)(F.lds + 20480);
        for (int idx = F.tid; idx < 5 * 1024; idx += NTHR) { const int r = idx >> 10, k = idx & 1023; const float v = r == 0 ? F.in[I_CCTX][k] : F.in[I_C][(r - 1) * 1024 + k]; sc[idx] = siluf(v); }
        __syncthreads();
        const float* wada = F.in[I_WADA]; const float* bada = F.in[I_BADA]; float* mod = WSP(float, WS_MOD);
        for (int it = F.bid; it < 256; it += F.G) {
            const int kg = it >> 3, cg = it & 7, c4 = F.tid % 192, rh = F.tid / 192;
            float acc[5][4];
#pragma unroll
            for (int r = 0; r < 5; ++r)
#pragma unroll
                for (int e = 0; e < 4; ++e) acc[r][e] = 0.f;
            if (rh < 2) {
                const float* wp = wada + (size_t)(32 * kg + 16 * rh) * 6144 + 768 * cg + 4 * c4;
                f32x4 wr[16];
#pragma unroll
                for (int kk = 0; kk < 16; ++kk) wr[kk] = *(const f32x4*)(wp + (size_t)kk * 6144);
#pragma unroll
                for (int kk = 0; kk < 16; ++kk) {
                    const f32x4 w = wr[kk];
                    const int k = 32 * kg + 16 * rh + kk;
#pragma unroll
                    for (int r = 0; r < 5; ++r) { const float s = sc[r * 1024 + k]; acc[r][0] += s * w.x; acc[r][1] += s * w.y; acc[r][2] += s * w.z; acc[r][3] += s * w.w; }
                }
            }
            if (rh == 1) {
#pragma unroll
                for (int r = 0; r < 5; ++r)
#pragma unroll
                    for (int e = 0; e < 4; ++e) red[c4 * 20 + r * 4 + e] = acc[r][e];
            }
            __syncthreads();
            if (rh == 0) {
                const int col = 768 * cg + 4 * c4;
#pragma unroll
                for (int r = 0; r < 5; ++r)
#pragma unroll
                    for (int e = 0; e < 4; ++e) { float v = acc[r][e] + red[c4 * 20 + r * 4 + e]; if (kg == 0) v += bada[col + e]; atomicAdd(mod + r * 6144 + col + e, v); }
            }
            __syncthreads();
        }
    }
}

template <bool XBF>
__device__ __forceinline__ void modnorm_rows(Frame& F, const float* x0, const float* x1, const bf16* xb, const float* nw, int sh_off, int sc_off, bf16* H) {
    const int gw = F.bid * NWAVES + F.wave, NGW = F.G * NWAVES;
    const float* mod = WSP(float, WS_MOD);
    f32x4 v[2][4], vn[2][4];
#define MN_LOAD(dst, M0) do { _Pragma("unroll") for (int u = 0; u < 2; ++u) { const int m_ = (M0) + u * NGW; if (m_ < NT) { \
        if (XBF) { _Pragma("unroll") for (int j = 0; j < 4; ++j) { const u32x2 w_ = *(const u32x2*)(xb + (size_t)m_ * DM + 4 * F.lane + 256 * j); dst[u][j] = (f32x4){bflo(w_.x), bfhi(w_.x), bflo(w_.y), bfhi(w_.y)}; } } \
        else { const float* xr_ = m_ < NCTX ? x0 + (size_t)m_ * DM : x1 + (size_t)(m_ - NCTX) * DM; \
        _Pragma("unroll") for (int j = 0; j < 4; ++j) dst[u][j] = *(const f32x4*)(xr_ + 4 * F.lane + 256 * j); } } } } while (0)
    MN_LOAD(vn, gw);
    for (int m0 = gw; m0 < NT; m0 += 2 * NGW) {
#pragma unroll
        for (int u = 0; u < 2; ++u)
#pragma unroll
            for (int j = 0; j < 4; ++j) v[u][j] = vn[u][j];
        if (m0 + 2 * NGW < NT) MN_LOAD(vn, m0 + 2 * NGW);
#pragma unroll
        for (int u = 0; u < 2; ++u) { const int m = m0 + u * NGW; if (m < NT) {
            const int mr = m < NCTX ? 0 : 1 + ((m - NCTX) >> 12);
            const float* mp = mod + (size_t)mr * 6144;
            float s = 0.f;
#pragma unroll
            for (int j = 0; j < 4; ++j) s += (v[u][j].x * v[u][j].x + v[u][j].y * v[u][j].y) + (v[u][j].z * v[u][j].z + v[u][j].w * v[u][j].w);
            const float rstd = __builtin_amdgcn_rsqf(wave_sum(s) * (1.f / DM) + EPS);
#pragma unroll
            for (int j = 0; j < 4; ++j) {
                const int c = 4 * F.lane + 256 * j;
                const f32x4 w = *(const f32x4*)(nw + c), sc = *(const f32x4*)(mp + sc_off + c), sh = *(const f32x4*)(mp + sh_off + c);
                const f32x4 h = (v[u][j] * rstd * w) * (sc + 1.f) + sh;
                u32x2 o; o.x = pk2(h.x, h.y); o.y = pk2(h.z, h.w);
                *(u32x2*)(H + (size_t)m * DM + c) = o;
            } } }
    }
#undef MN_LOAD
}

__device__ __forceinline__ void final_norm(Frame& F) {
    const int gw = F.bid * NWAVES + F.wave, NGW = F.G * NWAVES;
    const float* nf = F.in[I_NF];
    f32x4 w[4];
#pragma unroll
    for (int j = 0; j < 4; ++j) w[j] = *(const f32x4*)(nf + 4 * F.lane + 256 * j);
    for (int m0 = gw; m0 < NT; m0 += 2 * NGW) {
        f32x4 v[2][4];
#pragma unroll
        for (int u = 0; u < 2; ++u) { const int m = m0 + u * NGW; if (m < NT) {
#pragma unroll
            for (int j = 0; j < 4; ++j) { const u32x2 w_ = *(const u32x2*)(WSP(bf16, WS_XR) + (size_t)m * DM + 4 * F.lane + 256 * j); v[u][j] = (f32x4){bflo(w_.x), bfhi(w_.x), bflo(w_.y), bfhi(w_.y)}; } } }
#pragma unroll
        for (int u = 0; u < 2; ++u) { const int m = m0 + u * NGW; if (m < NT) {
            float s = 0.f;
#pragma unroll
            for (int j = 0; j < 4; ++j) s += (v[u][j].x * v[u][j].x + v[u][j].y * v[u][j].y) + (v[u][j].z * v[u][j].z + v[u][j].w * v[u][j].w);
            const float rstd = __builtin_amdgcn_rsqf(wave_sum(s) * (1.f / DM) + EPS);
#pragma unroll
            for (int j = 0; j < 4; ++j) *(f32x4*)(F.out + (size_t)m * DM + 4 * F.lane + 256 * j) = v[u][j] * rstd * w[j]; } }
    }
}

__device__ __forceinline__ void late_weights(Frame& F, const int gw, const int NGW) {
    {
        LAS float* scr = (LAS float*)(F.lds + F.wave * 8704);
        constexpr int I_O = 16 * 32, I_G = 16 * 88, I_D = 44 * 32, NITEMS = I_O + 2 * I_G + I_D;
        for (int it = gw; it < NITEMS; it += NGW) {
            int r = it;
            if (r < I_O) { const int kb = r / 32, nb = r % 32; transpose_item(F.in[I_WOUT], 1024, 1024, WSP(bf16, WS_WOUT), 32 * nb, 64 * kb, 32 * nb, scr, F.lane); continue; } r -= I_O;
            if (r < I_G) { const int kb = r / 88, nb = r % 88, n0 = 32 * nb; transpose_item(F.in[I_WGATE], 1024, DFF, WSP(bf16, WS_WGU), 256 * (n0 >> 7) + (n0 & 127), 64 * kb, n0, scr, F.lane); continue; } r -= I_G;
            if (r < I_G) { const int kb = r / 88, nb = r % 88, n0 = 32 * nb; transpose_item(F.in[I_WUP], 1024, DFF, WSP(bf16, WS_WGU), 256 * (n0 >> 7) + 128 + (n0 & 127), 64 * kb, n0, scr, F.lane); continue; } r -= I_G;
            { const int kb = r / 32, nb = r % 32; transpose_item(F.in[I_WDOWN], DFF, 1024, WSP(bf16, WS_WDN), 32 * nb, 64 * kb, 32 * nb, scr, F.lane); }
        }
    }
}

__device__ __forceinline__ void p5_headnorm(Frame& F) {
    const int gw = F.bid * NWAVES + F.wave, NGW = F.G * NWAVES;
    const bf16* OA0 = OUTB(bf16, OUT_OA); const bf16* OA1 = OUTB(bf16, OUT_OA + 20 * MiB);
    const bf16* OB0 = WSP(bf16, WS_OB);   const bf16* OB1 = WSP(bf16, WS_OB + 20 * MiB);
    const bf16* AG = WSP(bf16, WS_AG);    const bf16* BZ = WSP(bf16, WS_BZ);
    bf16* Y = WSP(bf16, WS_YIN);
    const int half = F.lane >> 5, c = 16 * (F.lane & 31);
    const float* nw = (half ? F.in[I_GNORM] : F.in[I_HNORM]) + c;
    f32x4 wn[4];
#pragma unroll
    for (int q = 0; q < 4; ++q) wn[q] = *(const f32x4*)(nw + 4 * q);
    u32x4 ra[2], rb[2], rg[2], na[2], nb2[2], ng[2];
#define P5_LOAD(A, B, Gt, M) do { const size_t off_ = (size_t)(M) * 512 + c; \
        _Pragma("unroll") for (int q = 0; q < 2; ++q) { A[q] = *(const u32x4*)((half ? OB0 : OA0) + off_ + 8 * q); B[q] = *(const u32x4*)((half ? OB1 : OA1) + off_ + 8 * q); Gt[q] = *(const u32x4*)((half ? BZ : AG) + off_ + 8 * q); } } while (0)
    if (gw < NT) P5_LOAD(na, nb2, ng, gw);
    for (int m = gw; m < NT; m += NGW) {
#pragma unroll
        for (int q = 0; q < 2; ++q) { ra[q] = na[q]; rb[q] = nb2[q]; rg[q] = ng[q]; }
        if (m + NGW < NT) P5_LOAD(na, nb2, ng, m + NGW);
        float o[16]; float ss = 0.f;
#pragma unroll
        for (int q = 0; q < 2; ++q)
#pragma unroll
            for (int e = 0; e < 4; ++e) { o[8 * q + 2 * e] = bflo(ra[q][e]) + bflo(rb[q][e]); o[8 * q + 2 * e + 1] = bfhi(ra[q][e]) + bfhi(rb[q][e]); }
#pragma unroll
        for (int e = 0; e < 16; ++e) ss += o[e] * o[e];
        ss += __shfl_xor(ss, 1); ss += __shfl_xor(ss, 2); ss += __shfl_xor(ss, 4);
        const float rstd = __builtin_amdgcn_rsqf(ss * (1.f / 128.f) + EPS);
#pragma unroll
        for (int q = 0; q < 2; ++q) {
            float y[8];
#pragma unroll
            for (int e = 0; e < 4; ++e) { y[2 * e] = o[8 * q + 2 * e] * rstd * wn[2 * q + (e >> 1)][2 * (e & 1)] * bflo(rg[q][e]); y[2 * e + 1] = o[8 * q + 2 * e + 1] * rstd * wn[2 * q + (e >> 1)][2 * (e & 1) + 1] * bfhi(rg[q][e]); }
            u32x4 w; w.x = pk2(y[0], y[1]); w.y = pk2(y[2], y[3]); w.z = pk2(y[4], y[5]); w.w = pk2(y[6], y[7]);
            *(u32x4*)(Y + (size_t)m * DM + half * 512 + c + 8 * q) = w;
        }
    }
#undef P5_LOAD
}

__device__ __forceinline__ int uc_index(int s, int n, int h, int dir) { return ((chunk_base(s) + n) * 4 + h) * 2 + dir; }
__device__ __forceinline__ unsigned char* grec_ptr(Frame& F, int uc) { return uc < N1G ? F.ws + WS_I + (size_t)uc * GREC : (unsigned char*)F.out + OUT_GOVF + (size_t)(uc - N1G) * GREC; }
__device__ __forceinline__ unsigned char* hrec_ptr(Frame& F, int uc) { return F.ws + WS_I + (size_t)uc * HREC; }
__device__ __forceinline__ bool allowed(int dir, int t, int s) { return dir ? (s >= t) : (s <= t); }

__device__ __forceinline__ void write_qd_image(Frame& F, const LAS bf16* X, int pitch, const LAS float* rowscale, unsigned char* dst) {
    const int r = F.lane & 15, g = F.lane >> 4, mt = F.wave >> 1;
#pragma unroll
    for (int q = 0; q < 2; ++q) {
        const int ks = 2 * (F.wave & 1) + q, row = 16 * mt + r;
        const u32x2 a = *(const LAS u32x2*)(X + row * pitch + 32 * ks + 4 * g), b = *(const LAS u32x2*)(X + row * pitch + 32 * ks + 16 + 4 * g);
        u32x4 o;
        if (rowscale) { const float sc = rowscale[row];
            o.x = pk2(bflo(a.x) * sc, bfhi(a.x) * sc); o.y = pk2(bflo(a.y) * sc, bfhi(a.y) * sc); o.z = pk2(bflo(b.x) * sc, bfhi(b.x) * sc); o.w = pk2(bflo(b.y) * sc, bfhi(b.y) * sc);
        } else { o.x = a.x; o.y = a.y; o.z = b.x; o.w = b.y; }
        *(u32x4*)(dst + ((mt * 4 + ks) * 64 + F.lane) * 16) = o;
    }
}
__device__ __forceinline__ void write_at_image(Frame& F, const LAS bf16* KA, const LAS bf16* QB, int pitch, const LAS float* Cs, int dir, unsigned char* dst) {
    const int r = F.lane & 15, g = F.lane >> 4, mt = F.wave >> 1, ks2 = F.wave & 1;
    f32x4 a0 = {0.f, 0.f, 0.f, 0.f}, a1 = {0.f, 0.f, 0.f, 0.f};
#pragma unroll
    for (int kd = 0; kd < 4; ++kd) {
        const bf16x8 bq = as_frag(*(const LAS u32x4*)(QB + (16 * mt + r) * pitch + 32 * kd + 8 * g));
        const bf16x8 k0 = as_frag(*(const LAS u32x4*)(KA + (32 * ks2 + r) * pitch + 32 * kd + 8 * g));
        const bf16x8 k1 = as_frag(*(const LAS u32x4*)(KA + (32 * ks2 + 16 + r) * pitch + 32 * kd + 8 * g));
        a0 = mfma16(k0, bq, a0); a1 = mfma16(k1, bq, a1);
    }
    const int t = 16 * mt + r; const float ct = Cs ? Cs[t] : 0.f;
    f32x4 cs0 = {0.f, 0.f, 0.f, 0.f}, cs1 = {0.f, 0.f, 0.f, 0.f};
    if (Cs) { cs0 = *(const LAS f32x4*)(Cs + 32 * ks2 + 4 * g); cs1 = *(const LAS f32x4*)(Cs + 32 * ks2 + 16 + 4 * g); }
    float v[8];
#pragma unroll
    for (int j = 0; j < 8; ++j) {
        const int s = 32 * ks2 + kperm(g, j); const bool ok = allowed(dir, t, s);
        float x = (j < 4) ? a0[j & 3] : a1[j & 3];
        if (Cs) { const float e = __expf(ok ? ct - ((j < 4) ? cs0[j & 3] : cs1[j & 3]) : 0.f); x *= e; }
        v[j] = ok ? x : 0.f;
    }
    u32x4 o; o.x = pk2(v[0], v[1]); o.y = pk2(v[2], v[3]); o.z = pk2(v[4], v[5]); o.w = pk2(v[6], v[7]);
    *(u32x4*)(dst + ((mt * 2 + ks2) * 64 + F.lane) * 16) = o;
}

__device__ __forceinline__ void p3h_load(Frame& F, int task, unsigned (&gw)[8], unsigned (&qw)[8], unsigned (&vw)[8]) {
    const int dir = task & 1, h = (task >> 1) & 3, cidx = task >> 3;
    int s, n; if (cidx < 64) { s = cidx >> 2; n = cidx & 3; } else { s = 16 + ((cidx - 64) >> 6); n = (cidx - 64) & 63; }
    const bf16* Gd = OUTB(bf16, dir ? OUT_GB : OUT_GF); const bf16* QA = OUTB(bf16, OUT_QA); const bf16* VA = OUTB(bf16, OUT_VA);
    const int c0 = 2 * (F.tid & 63), re = F.tid >> 6;
#pragma unroll
    for (int e = 0; e < 8; ++e) {
        const size_t off = (size_t)tok_a(s, n, 8 * re + e) * 512 + h * 128 + c0;
        gw[e] = *(const unsigned*)(Gd + off); qw[e] = *(const unsigned*)(QA + off);
        if (dir == ((task >> 8) & 1)) vw[e] = *(const unsigned*)(VA + off);
    }
}
__device__ __forceinline__ void p3_hgrn(Frame& F) {
    constexpr int PITCH = 136;
    LAS bf16* QDb = (LAS bf16*)(F.lds);
    LAS bf16* KDb = (LAS bf16*)(F.lds + 17408);
    LAS unsigned char* KTi = F.lds + 34816;
    LAS float* part = (LAS float*)(F.lds + 51200);
    LAS float* etot = (LAS float*)(F.lds + 55296);
    LAS bf16* Vb = (LAS bf16*)(F.lds + 56320);
    unsigned ngw[8], nqw[8], nvw[8];
    if (F.bid < NUC) p3h_load(F, F.bid, ngw, nqw, nvw);
    for (int task = F.bid; task < NUC; task += F.G) {
        const int dir = task & 1, h = (task >> 1) & 3, cidx = task >> 3;
        int s, n; if (cidx < 64) { s = cidx >> 2; n = cidx & 3; } else { s = 16 + ((cidx - 64) >> 6); n = (cidx - 64) & 63; }
        PROBE_BEGIN(61);
        unsigned char* rec = hrec_ptr(F, task);
        const int cp = F.tid & 63, re = F.tid >> 6, c0 = 2 * cp;
        float f0[8], f1[8], q0[8], q1[8], p0[8], p1[8];
#pragma unroll
        for (int e = 0; e < 8; ++e) {
            f0[e] = __expf(bflo(ngw[e])); f1[e] = __expf(bfhi(ngw[e])); q0[e] = bflo(nqw[e]); q1[e] = bfhi(nqw[e]);
            if (dir == ((task >> 8) & 1)) *(LAS unsigned*)(Vb + (8 * re + e) * PITCH + c0) = nvw[e];
        }
        if (task + F.G < NUC) p3h_load(F, task + F.G, ngw, nqw, nvw);
        if (dir == 0) { float a = 1.f, b = 1.f;
#pragma unroll
            for (int e = 0; e < 8; ++e) { a *= f0[e]; b *= f1[e]; p0[e] = a; p1[e] = b; }
            part[re * 128 + c0] = a; part[re * 128 + c0 + 1] = b;
        } else { float a = 1.f, b = 1.f;
#pragma unroll
            for (int e = 7; e >= 0; --e) { a *= f0[e]; b *= f1[e]; p0[e] = a; p1[e] = b; }
            part[re * 128 + c0] = a; part[re * 128 + c0 + 1] = b;
        }
        __syncthreads();
        PROBE_END(61); PROBE_BEGIN(62);
        float o0 = 1.f, o1 = 1.f, t0 = 1.f, t1 = 1.f;
#pragma unroll
        for (int r2 = 0; r2 < 8; ++r2) { const float a = part[r2 * 128 + c0], b = part[r2 * 128 + c0 + 1]; t0 *= a; t1 *= b; const bool pre = dir ? (r2 > re) : (r2 < re); if (pre) { o0 *= a; o1 *= b; } }
        if (re == 0) { etot[c0] = t0; etot[c0 + 1] = t1; }
        float kt0[8], kt1[8];
#pragma unroll
        for (int e = 0; e < 8; ++e) {
            const float E0 = o0 * p0[e], E1 = o1 * p1[e];
            const float k0 = 1.f - f0[e], k1 = 1.f - f1[e];
            const float kd0 = k0 * __builtin_amdgcn_rcpf(E0), kd1 = k1 * __builtin_amdgcn_rcpf(E1);
            const int row = 8 * re + e;
            *(LAS unsigned*)(QDb + row * PITCH + c0) = pk2(q0[e] * E0, q1[e] * E1);
            *(LAS unsigned*)(KDb + row * PITCH + c0) = pk2(kd0, kd1);
            kt0[e] = kd0 * t0; kt1[e] = kd1 * t1;
        }
        {
            const int ks = re >> 2, hf = (re >> 1) & 1;
#pragma unroll
            for (int cc = 0; cc < 2; ++cc) {
                const int c = c0 + cc, kt = c >> 4, r = c & 15;
#pragma unroll
                for (int p = 0; p < 2; ++p) {
                    const int g = 2 * (re & 1) + p;
                    u32x2 w;
                    if (cc == 0) { w.x = pk2(kt0[4 * p], kt0[4 * p + 1]); w.y = pk2(kt0[4 * p + 2], kt0[4 * p + 3]); } else { w.x = pk2(kt1[4 * p], kt1[4 * p + 1]); w.y = pk2(kt1[4 * p + 2], kt1[4 * p + 3]); }
                    *(LAS u32x2*)(KTi + ((kt * 2 + ks) * 64 + g * 16 + r) * 16 + 8 * hf) = w;
                }
            }
        }
        __syncthreads();
        PROBE_END(62); PROBE_BEGIN(63);
        write_qd_image(F, QDb, PITCH, nullptr, rec);
        write_at_image(F, KDb, QDb, PITCH, nullptr, dir, rec + 16384);
        for (int i = F.tid; i < 1024; i += NTHR) *(u32x4*)(rec + 24576 + i * 16) = *(const LAS u32x4*)(KTi + i * 16);
        if (F.tid < 32) *(f32x4*)(rec + 40960 + F.tid * 16) = *(const LAS f32x4*)((LAS unsigned char*)etot + F.tid * 16);
        if (dir == ((task >> 8) & 1)) {
            unsigned char* vb = F.ws + WS_HVB + (size_t)(task >> 1) * 16384;
            const int c = F.lane & 15, g = F.lane >> 4, w = F.wave;
#pragma unroll
            for (int ks2 = 0; ks2 < 2; ++ks2) {
                unsigned short x[8];
#pragma unroll
                for (int j = 0; j < 8; ++j) x[j] = Vb[(32 * ks2 + kperm(g, j)) * PITCH + 16 * w + c];
                u32x4 o; o.x = x[0] | ((unsigned)x[1] << 16); o.y = x[2] | ((unsigned)x[3] << 16); o.z = x[4] | ((unsigned)x[5] << 16); o.w = x[6] | ((unsigned)x[7] << 16);
                *(u32x4*)(vb + ((w * 2 + ks2) * 64 + F.lane) * 16) = o;
            }
        }
        __syncthreads();
        PROBE_END(63);
    }
}

__device__ __forceinline__ int lp_rowoff(int a) { if (a == 0) return 0; const int A = a - 1, m = A >> 2, r = A & 3; return 8 * m * (m + 1) + 4 * r * (m + 1); }

__device__ __forceinline__ void p3g_invert(LAS float* Lp, int dir, int lane) {
    float T[64];
    const int j = lane;
#pragma unroll
    for (int t = 0; t < 64; ++t) {
        float a0 = 0.f, a1 = 0.f, a2 = 0.f, a3 = 0.f;
        const LAS float* lrow = Lp + lp_rowoff(t);
#pragma unroll
        for (int s4 = 0; s4 < (t + 3) / 4; ++s4) {
            const f32x4 l = *(const LAS f32x4*)(lrow + 4 * s4);
            if (4 * s4 + 0 < t) a0 += l[0] * T[4 * s4 + 0];
            if (4 * s4 + 1 < t) a1 += l[1] * T[4 * s4 + 1];
            if (4 * s4 + 2 < t) a2 += l[2] * T[4 * s4 + 2];
            if (4 * s4 + 3 < t) a3 += l[3] * T[4 * s4 + 3];
        }
        int jj = j; asm volatile("" : "+v"(jj));
        T[t] = (t == jj ? 1.f : 0.f) - ((a0 + a1) + (a2 + a3));
        asm volatile("" ::: "memory");
    }
    LAS bf16* Tb = (LAS bf16*)Lp;
    if (dir == 0) { LAS bf16* tp = Tb + j;
#pragma unroll
        for (int t = 0; t < 64; ++t) tp[t * 72] = (bf16)f2bf(T[t]);
    } else { LAS bf16* tp = Tb + (63 - j);
#pragma unroll
        for (int t = 0; t < 64; ++t) tp[(63 - t) * 72] = (bf16)f2bf(T[t]);
    }
}

__device__ __forceinline__ void p3g_load(Frame& F, int task, const bf16* BQ, const bf16* BK, const bf16* BV, const float* BETA, const float* GGp, u32x4 (&raw)[18], float& gbeta, float& ggate) {
    const int dir = task & 1, h = (task >> 1) & 3, cidx = task >> 3;
    int s, n; if (cidx < 64) { s = cidx >> 2; n = cidx & 3; } else { s = 16 + ((cidx - 64) >> 6); n = (cidx - 64) & 63; }
    const int i = F.tid >> 3, m = tok_b(s, n, i);
    int pos, len, dlt; if (s < 16) { pos = 64 * n + i; len = 256; dlt = 1; } else { pos = i; len = 64; dlt = 64; }
    const bool hasp = pos > 0, hasn = pos + 1 < len; const u32x4 zz = {0u, 0u, 0u, 0u};
#pragma unroll
    for (int a = 0; a < 3; ++a) {
        const bf16* src = (a == 0 ? BQ : (a == 1 ? BK : BV)) + (size_t)m * 512 + h * 128 + 16 * (F.tid & 7);
#pragma unroll
        for (int q = 0; q < 2; ++q) {
            raw[a * 6 + q * 3 + 0] = hasp ? *(const u32x4*)(src - (ptrdiff_t)dlt * 512 + 8 * q) : zz;
            raw[a * 6 + q * 3 + 1] = *(const u32x4*)(src + 8 * q);
            raw[a * 6 + q * 3 + 2] = hasn ? *(const u32x4*)(src + (ptrdiff_t)dlt * 512 + 8 * q) : zz;
        }
    }
    if (F.wave == 0) { const int mg = tok_b(s, n, F.lane); gbeta = BETA[(size_t)mg * 8 + dir * 4 + h]; ggate = GGp[(size_t)mg * 8 + dir * 4 + h]; }
}

__device__ __forceinline__ void p3_gdn(Frame& F, const int t0, const int tn, const int rank, const int nranks) {
    constexpr int PITCH = 136, TP = 72, NBMAX = 10, LSLOT = 9216;
    LAS unsigned char* slots = F.lds + 40960;
    LAS float* Cs = (LAS float*)(F.lds + 512);
    LAS float* Bs = Cs + 64;
    LAS float* Es = Cs + 128;
    LAS float* Ets = Cs + 192;
    LAS float* Sc = Cs + 256;
    LAS bf16* Qb = (LAS bf16*)(F.lds + 2048);
    LAS bf16* Kb = (LAS bf16*)(F.lds + 19456);
    LAS bf16* VT = (LAS bf16*)(F.lds + 2048);
    LAS bf16* KGT = (LAS bf16*)(F.lds + 20480);
    LAS float* Wc = (LAS float*)(F.lds + 133120);
    int wc_head = -1;
    const bf16* BQ = WSP(bf16, WS_BQ); const bf16* BK = WSP(bf16, WS_BK); const bf16* BV = WSP(bf16, WS_BV);
    const float* BETA = WSP(float, WS_BETA); const float* GGp = WSP(float, WS_GG);
    const float* convw = F.in[I_CONV];
    const int ntask = rank < tn ? (tn - rank + nranks - 1) / nranks : 0;
    for (int b0 = 0; b0 < ntask; b0 += NBMAX) {
      const int nb = ntask - b0 < NBMAX ? ntask - b0 : NBMAX;
      PROBE_BEGIN(51);
      u32x4 raw[18]; float gbeta = 0.f, ggate = 0.f;
#define P3G_LOAD(JT) p3g_load(F, t0 + rank + (b0 + (JT)) * nranks, BQ, BK, BV, BETA, GGp, raw, gbeta, ggate)
      if (nb > 0) P3G_LOAD(0);
      for (int jt = 0; jt < nb; ++jt) {
        const int task = t0 + rank + (b0 + jt) * nranks;
        const int dir = task & 1, h = (task >> 1) & 3, cidx = task >> 3;
        int s, n; if (cidx < 64) { s = cidx >> 2; n = cidx & 3; } else { s = 16 + ((cidx - 64) >> 6); n = (cidx - 64) & 63; }
        unsigned char* rec = grec_ptr(F, task);
        LAS float* Lp = (LAS float*)(slots + jt * LSLOT);
        if (h != wc_head) {
            __syncthreads();
            for (int idx = F.tid; idx < 1152; idx += NTHR) { const int a = idx / 384, r2 = idx % 384, tap = r2 >> 7, ch = r2 & 127; Wc[idx] = convw[tap * 1536 + a * 512 + h * 128 + ch]; }
            wc_head = h;
        }
        PROBE_BEGIN(54);
        if (F.wave == 0) {
            const float beta = gbeta;
            float c = ggate;
#pragma unroll
            for (int d = 1; d < 64; d <<= 1) { const float o = dir ? __shfl_down(c, d) : __shfl_up(c, d); const bool ok = dir ? (F.lane + d < 64) : (F.lane >= d); c += ok ? o : 0.f; }
            const float ctot = __shfl(c, dir ? 0 : 63);
            Cs[F.lane] = c; Bs[F.lane] = beta; Es[F.lane] = __expf(c); Ets[F.lane] = __expf(ctot - c);
            if (F.lane == 0) Sc[0] = __expf(ctot);
        }
        __syncthreads();
        PROBE_END(54); PROBE_BEGIN(55);
        {
            const int i = F.tid >> 3, seg = F.tid & 7, ch0 = 16 * seg;
            const float beta = Bs[i], kg = -beta * Es[i];
#pragma unroll
            for (int a = 0; a < 3; ++a) {
                float val[16];
                const LAS float* wc = Wc + a * 384 + ch0;
#pragma unroll
                for (int q = 0; q < 2; ++q) {
                    const u32x4 xm = raw[a * 6 + q * 3 + 0], x0 = raw[a * 6 + q * 3 + 1], xp = raw[a * 6 + q * 3 + 2];
                    f32x4 w0[2], w1[2], w2[2];
#pragma unroll
                    for (int hh = 0; hh < 2; ++hh) { w0[hh] = *(const LAS f32x4*)(wc + 8 * q + 4 * hh); w1[hh] = *(const LAS f32x4*)(wc + 128 + 8 * q + 4 * hh); w2[hh] = *(const LAS f32x4*)(wc + 256 + 8 * q + 4 * hh); }
#pragma unroll
                    for (int e = 0; e < 4; ++e) {
                        const int ch = 8 * q + 2 * e, hh = e >> 1, ee = 2 * (e & 1);
                        const float y0 = bflo(xm[e]) * w0[hh][ee] + bflo(x0[e]) * w1[hh][ee] + bflo(xp[e]) * w2[hh][ee];
                        const float y1 = bfhi(xm[e]) * w0[hh][ee + 1] + bfhi(x0[e]) * w1[hh][ee + 1] + bfhi(xp[e]) * w2[hh][ee + 1];
                        val[ch] = siluf(y0); val[ch + 1] = siluf(y1);
                    }
                }
                if (a < 2) {
                    float ss = 0.f;
#pragma unroll
                    for (int e = 0; e < 16; ++e) ss += val[e] * val[e];
                    ss += __shfl_xor(ss, 1); ss += __shfl_xor(ss, 2); ss += __shfl_xor(ss, 4);
                    const float rn = __builtin_amdgcn_rsqf(ss + EPS) * (a == 0 ? 0.08838834764831845f : 1.f);
                    unsigned pw[8];
#pragma unroll
                    for (int e = 0; e < 8; ++e) pw[e] = pk2(val[2 * e] * rn, val[2 * e + 1] * rn);
                    LAS bf16* dstp = (a == 0 ? Qb : Kb) + i * PITCH + ch0;
                    *(LAS u32x4*)(dstp) = (u32x4){pw[0], pw[1], pw[2], pw[3]}; *(LAS u32x4*)(dstp + 8) = (u32x4){pw[4], pw[5], pw[6], pw[7]};
                    if (a == 1) {
                        unsigned gw[8];
#pragma unroll
                        for (int e = 0; e < 8; ++e) gw[e] = pk2(kg * val[2 * e] * rn, kg * val[2 * e + 1] * rn);
                        u32x4* gp = (u32x4*)(rec + L_WN + (i * 128 + ch0) * 2);
                        gp[0] = (u32x4){gw[0], gw[1], gw[2], gw[3]}; gp[1] = (u32x4){gw[4], gw[5], gw[6], gw[7]};
                    }
                } else {
                    unsigned vw[8];
#pragma unroll
                    for (int e = 0; e < 8; ++e) vw[e] = pk2(beta * val[2 * e], beta * val[2 * e + 1]);
                    u32x4* vp = (u32x4*)(rec + L_U + (i * 128 + ch0) * 2);
                    vp[0] = (u32x4){vw[0], vw[1], vw[2], vw[3]}; vp[1] = (u32x4){vw[4], vw[5], vw[6], vw[7]};
                }
                asm volatile("" ::: "memory");
            }
            if (jt + 1 < nb) P3G_LOAD(jt + 1);
        }
        PROBE_END(55); PROBE_BEGIN(56);
        __syncthreads();
        {
            const int r = F.lane & 15, g = F.lane >> 4, tt = F.wave >> 1, sp = F.wave & 1;
            f32x4 a0 = {0.f, 0.f, 0.f, 0.f}, a1 = {0.f, 0.f, 0.f, 0.f};
#pragma unroll
            for (int kd = 0; kd < 4; ++kd) {
                const bf16x8 at = as_frag(*(const LAS u32x4*)(Kb + (16 * tt + r) * PITCH + 32 * kd + 8 * g));
                const bf16x8 b0 = as_frag(*(const LAS u32x4*)(Kb + (32 * sp + r) * PITCH + 32 * kd + 8 * g));
                const bf16x8 b1 = as_frag(*(const LAS u32x4*)(Kb + (32 * sp + 16 + r) * PITCH + 32 * kd + 8 * g));
                a0 = mfma16(at, b0, a0); a1 = mfma16(at, b1, a1);
            }
            const f32x4 ct4 = *(const LAS f32x4*)(Cs + 16 * tt + 4 * g), bt4 = *(const LAS f32x4*)(Bs + 16 * tt + 4 * g);
            const float csx0 = Cs[32 * sp + r], csx1 = Cs[32 * sp + 16 + r];
#pragma unroll
            for (int q = 0; q < 2; ++q)
#pragma unroll
                for (int i = 0; i < 4; ++i) {
                    const int t = 16 * tt + 4 * g + i, sx = 32 * sp + 16 * q + r;
                    const bool ok = dir ? (sx > t) : (sx < t);
                    const float v = bt4[i] * (q ? a1[i] : a0[i]) * __expf(ok ? ct4[i] - (q ? csx1 : csx0) : 0.f);
                    const int a = dir ? 63 - t : t, b = dir ? 63 - sx : sx;
                    if (ok) Lp[lp_rowoff(a) + b] = v;
                }
        }
        write_at_image(F, Kb, Qb, PITCH, Cs, dir, rec + L_AT);
        write_qd_image(F, Qb, PITCH, Es, rec + L_QD);
        {
            const int r = F.lane & 15, g = F.lane >> 4, kt = F.wave;
#pragma unroll
            for (int ks2 = 0; ks2 < 2; ++ks2) {
                float v[8];
                const f32x4 e0 = *(const LAS f32x4*)(Ets + 32 * ks2 + 4 * g), e1 = *(const LAS f32x4*)(Ets + 32 * ks2 + 16 + 4 * g);
#pragma unroll
                for (int j = 0; j < 8; ++j) { const int sx = 32 * ks2 + kperm(g, j); v[j] = bf2f(Kb[sx * PITCH + 16 * kt + r]) * ((j < 4) ? e0[j & 3] : e1[j & 3]); }
                u32x4 o; o.x = pk2(v[0], v[1]); o.y = pk2(v[2], v[3]); o.z = pk2(v[4], v[5]); o.w = pk2(v[6], v[7]);
                *(u32x4*)(rec + L_KT + ((kt * 2 + ks2) * 64 + F.lane) * 16) = o;
            }
        }
        if (F.tid == 0) *(float*)(rec + L_SC) = Sc[0];
        __syncthreads();
        PROBE_END(56);
      }
#undef P3G_LOAD
      PROBE_END(51); PROBE_BEGIN(52);
      asm volatile("s_waitcnt vmcnt(0)" ::: "memory");
      for (int jt = F.wave; jt < nb; jt += NWAVES) { const int task = t0 + rank + (b0 + jt) * nranks; p3g_invert((LAS float*)(slots + jt * LSLOT), task & 1, F.lane); }
      __syncthreads();
      PROBE_END(52); PROBE_BEGIN(53);
      u32x4 pv[2], pk[2];
      { unsigned char* rec0 = grec_ptr(F, t0 + rank + b0 * nranks);
#pragma unroll
        for (int q = 0; q < 2; ++q) { const int p = F.lane * 16 + F.wave + 8 * q; pv[q] = *(const u32x4*)(rec0 + L_U + p * 16); pk[q] = *(const u32x4*)(rec0 + L_WN + p * 16); } }
      for (int jt = 0; jt < nb; ++jt) {
        const int task = t0 + rank + (b0 + jt) * nranks;
        unsigned char* rec = grec_ptr(F, task);
        const LAS bf16* Tm = (const LAS bf16*)(slots + jt * LSLOT);
        PROBE_BEGIN(57);
#pragma unroll
        for (int q = 0; q < 2; ++q) {
            const int i = F.lane, c8 = (F.wave + 8 * q) * 8;
            const u32x4 vv = pv[q], kk = pk[q];
            LAS bf16* vt = VT + c8 * TP + i; LAS bf16* kt = KGT + c8 * TP + i;
#pragma unroll
            for (int e = 0; e < 4; ++e) { vt[(2 * e) * TP] = (bf16)(vv[e] & 0xffffu); vt[(2 * e + 1) * TP] = (bf16)(vv[e] >> 16); kt[(2 * e) * TP] = (bf16)(kk[e] & 0xffffu); kt[(2 * e + 1) * TP] = (bf16)(kk[e] >> 16); }
        }
        if (jt + 1 < nb) { unsigned char* rec1 = grec_ptr(F, task + nranks);
#pragma unroll
            for (int q = 0; q < 2; ++q) { const int p = F.lane * 16 + F.wave + 8 * q; pv[q] = *(const u32x4*)(rec1 + L_U + p * 16); pk[q] = *(const u32x4*)(rec1 + L_WN + p * 16); } }
        __syncthreads();
        PROBE_END(57); PROBE_BEGIN(58);
        {
            const int r = F.lane & 15, g = F.lane >> 4;
            {
                const int w = F.wave;
                bf16x8 bv[2];
#pragma unroll
                for (int ks2 = 0; ks2 < 2; ++ks2) bv[ks2] = as_frag(*(const LAS u32x4*)(VT + (16 * w + r) * TP + 32 * ks2 + 8 * g));
#pragma unroll
                for (int mt = 0; mt < 4; ++mt) {
                    f32x4 a = {0.f, 0.f, 0.f, 0.f};
#pragma unroll
                    for (int ks2 = 0; ks2 < 2; ++ks2) a = mfma16(as_frag(*(const LAS u32x4*)(Tm + (16 * mt + r) * TP + 32 * ks2 + 8 * g)), bv[ks2], a);
                    u32x2 o; o.x = pk2(a[0], a[1]); o.y = pk2(a[2], a[3]);
                    *(u32x2*)(rec + L_U + ((w * 4 + mt) * 64 + F.lane) * 8) = o;
                }
            }
            {
                const int mt = F.wave >> 1;
                bf16x8 bt[2];
#pragma unroll
                for (int ks2 = 0; ks2 < 2; ++ks2) bt[ks2] = as_frag(*(const LAS u32x4*)(Tm + (16 * mt + r) * TP + 32 * ks2 + 8 * g));
#pragma unroll
                for (int q = 0; q < 2; ++q) {
                    const int ks = 2 * (F.wave & 1) + q;
                    f32x4 a0 = {0.f, 0.f, 0.f, 0.f}, a1 = {0.f, 0.f, 0.f, 0.f};
#pragma unroll
                    for (int ks2 = 0; ks2 < 2; ++ks2) {
                        a0 = mfma16(as_frag(*(const LAS u32x4*)(KGT + (32 * ks + r) * TP + 32 * ks2 + 8 * g)), bt[ks2], a0);
                        a1 = mfma16(as_frag(*(const LAS u32x4*)(KGT + (32 * ks + 16 + r) * TP + 32 * ks2 + 8 * g)), bt[ks2], a1);
                    }
                    u32x4 o; o.x = pk2(a0[0], a0[1]); o.y = pk2(a0[2], a0[3]); o.z = pk2(a1[0], a1[1]); o.w = pk2(a1[2], a1[3]);
                    *(u32x4*)(rec + L_WN + ((mt * 4 + ks) * 64 + F.lane) * 16) = o;
                }
            }
        }
        __syncthreads();
        PROBE_END(58);
      }
      PROBE_END(53);
    }
}

template <bool GDN>
__device__ __forceinline__ void p4_chain(Frame& F) {
    LAS unsigned char* img = F.lds;
    const int c = F.lane & 15, g = F.lane >> 4;
    const float* st_in = F.in[GDN ? I_SG : I_SH];
    float* st_out = F.out + OUT_Y_FLOATS + (GDN ? STATE_FLOATS : 0);
    bf16* Obase = GDN ? WSP(bf16, WS_OB) : OUTB(bf16, OUT_OA);
    constexpr int N16 = GDN ? GREC / 16 : HREC / 16;
    constexpr int NPC = ((GDN ? GREC : HREC) + 1023) / 1024;
    gu32* prog = (gu32*)(F.ws + WS_CTL) + (GDN ? CW_PROG_G : CW_PROG_H);
    const bool roles = (F.G == 256);
    if (roles && F.bid >= 64 && F.bid < 128) {
        const int hb = F.bid - 64, u = hb & 31, j0 = hb >> 5;
        const int s = 16 + (u >> 3), h = (u >> 1) & 3, dir = u & 1, N = 64;
        u32x4 dummy = {0u, 0u, 0u, 0u};
        for (int st = j0; st < N; st += 2) {
            for (unsigned sp = 0; sp < (1u << 15); ++sp) { const unsigned p = __hip_atomic_load(prog + 64 * u, RLX_AGENT); if ((int)p + P4_PD > st) break; __builtin_amdgcn_s_sleep(8); }
            const int n = dir ? N - 1 - st : st; const int uc = uc_index(s, n, h, dir);
            const unsigned char* rec = GDN ? grec_ptr(F, uc) : hrec_ptr(F, uc);
            for (int idx = F.tid; idx < N16; idx += NTHR) { const unsigned char* p = rec + (size_t)idx * 16; asm volatile("global_load_dwordx4 %0, %1, off" : "+v"(dummy) : "v"(p) : "memory"); }
            if (!GDN) { const unsigned char* vb = F.ws + WS_HVB + (size_t)(uc >> 1) * 16384;
                for (int idx = F.tid; idx < 1024; idx += NTHR) { const unsigned char* p = vb + (size_t)idx * 16; asm volatile("global_load_dwordx4 %0, %1, off" : "+v"(dummy) : "v"(p) : "memory"); } }
        }
        asm volatile("s_waitcnt vmcnt(0)" : "+v"(dummy) :: "memory");
        return;
    }
    for (int uidx0 = F.bid; uidx0 < (roles ? 256 : 160); uidx0 += F.G) {
        int uidx = uidx0, ncw = 8, sl0 = 0;
        if (roles) { if (uidx0 >= 128) uidx = uidx0 - 96; else { uidx = uidx0 & 31; ncw = 4; sl0 = 4 * (uidx0 >> 5); } }
        const bool lead = roles && uidx0 < 32;
        const int w = sl0 + F.wave; const bool comp = F.wave < ncw;
        const int dwn = ncw < 8 ? 8 - ncw : 8, dw0 = ncw < 8 ? F.wave - ncw : F.wave;
        int s, h, dir;
        if (uidx < 32) { s = 16 + (uidx >> 3); h = (uidx >> 1) & 3; dir = uidx & 1; } else { const int j = uidx - 32; s = j >> 3; h = (j >> 1) & 3; dir = j & 1; }
        const int N = seq_nchunk(s), bq = s < 16 ? s : s - 16;
        f32x4 S[8];
        if (!comp) {
#pragma unroll
            for (int kt = 0; kt < 8; ++kt) S[kt] = (f32x4){0.f, 0.f, 0.f, 0.f};
        } else if (s >= 16) {
            const float* sp = st_in + (size_t)((bq * 2 + dir) * 4 + h) * 16384 + 16 * w + c;
#pragma unroll
            for (int kt = 0; kt < 8; ++kt)
#pragma unroll
                for (int i = 0; i < 4; ++i) S[kt][i] = sp[(16 * kt + 4 * g + i) * 128];
        } else {
#pragma unroll
            for (int kt = 0; kt < 8; ++kt) S[kt] = (f32x4){0.f, 0.f, 0.f, 0.f};
        }
#define P4_DMA(STEP, BUF) do { \
            const int n_ = dir ? N - 1 - (STEP) : (STEP); const int uc_ = uc_index(s, n_, h, dir); \
            const unsigned char* rec_ = (GDN ? grec_ptr(F, uc_) : hrec_ptr(F, uc_)) + F.lane * 16; \
            LAS unsigned char* dst_ = F.lds + (BUF) * P4_BUF + (GDN ? 0 : L_QD); \
            for (int p = dw0; p < NPC; p += dwn) { if (GDN && ncw < 8 && (p >> 3) == 7 + (1 - (sl0 >> 2))) continue; __builtin_amdgcn_global_load_lds((const unsigned*)(rec_ + (size_t)p * 1024), (LAS unsigned*)(dst_ + p * 1024), 16, 0, 0); } \
            if (!GDN) { const unsigned char* vb_ = F.ws + WS_HVB + (size_t)(uc_ >> 1) * 16384 + F.lane * 16; LAS unsigned char* dv_ = F.lds + (BUF) * P4_BUF + L_WN; \
                for (int p = dw0; p < 16; p += dwn) { if (ncw < 8 && (p >> 3) == 1 - (sl0 >> 2)) continue; __builtin_amdgcn_global_load_lds((const unsigned*)(vb_ + (size_t)p * 1024), (LAS unsigned*)(dv_ + p * 1024), 16, 0, 0); } } \
        } while (0)
#define FRAG(off, idx) (*(const LAS u32x4*)(img + (off) + ((idx) * 64 + F.lane) * 16))
        if (dw0 >= 0) P4_DMA(0, 0);
        asm volatile("s_waitcnt vmcnt(0)" ::: "memory");
        __syncthreads();
        for (int step = 0; step < N; ++step) {
            PROBE_BEGIN(GDN ? 2 : 12);
            const int cur = step & 1;
            LAS unsigned char* img = F.lds + cur * P4_BUF;
            if (lead && F.tid == 0) __hip_atomic_store(prog + 64 * uidx, (unsigned)(step + 1), RLX_AGENT);
            PROBE_BEGIN(GDN ? 21 : 31);
            if (step + 1 < N && dw0 >= 0) P4_DMA(step + 1, cur ^ 1);
            PROBE_END(GDN ? 21 : 31);
            const int n = dir ? N - 1 - step : step;
            if (comp) {
            PROBE_BEGIN(GDN ? 22 : 32);
            bf16x8 Sb[4];
#pragma unroll
            for (int ks = 0; ks < 4; ++ks) { u32x4 o; o.x = pk2(S[2 * ks][0], S[2 * ks][1]); o.y = pk2(S[2 * ks][2], S[2 * ks][3]); o.z = pk2(S[2 * ks + 1][0], S[2 * ks + 1][1]); o.w = pk2(S[2 * ks + 1][2], S[2 * ks + 1][3]); Sb[ks] = as_frag(o); }
            bf16x8 Xb[2];
            u32x4 fa[8], fb[8];
            f32x4 O[4];
            if (GDN) {
                f32x4 X[4];
#pragma unroll
                for (int mt = 0; mt < 4; ++mt)
#pragma unroll
                    for (int k = 0; k < 2; ++k) fa[mt * 2 + k] = FRAG(L_WN, mt * 4 + k);
#pragma unroll
                for (int mt = 0; mt < 4; ++mt)
#pragma unroll
                    for (int k = 0; k < 2; ++k) fb[mt * 2 + k] = FRAG(L_WN, mt * 4 + 2 + k);
#pragma unroll
                for (int mt = 0; mt < 4; ++mt) { const u32x2 uu = *(const LAS u32x2*)(img + L_U + ((w * 4 + mt) * 64 + F.lane) * 8); X[mt] = (f32x4){bflo(uu.x), bfhi(uu.x), bflo(uu.y), bfhi(uu.y)}; }
#pragma unroll
                for (int k = 0; k < 2; ++k)
#pragma unroll
                    for (int mt = 0; mt < 4; ++mt) X[mt] = mfma16(as_frag(fa[mt * 2 + k]), Sb[k], X[mt]);
#pragma unroll
                for (int mt = 0; mt < 4; ++mt)
#pragma unroll
                    for (int k = 0; k < 2; ++k) fa[mt * 2 + k] = FRAG(L_QD, mt * 4 + k);
#pragma unroll
                for (int k = 0; k < 2; ++k)
#pragma unroll
                    for (int mt = 0; mt < 4; ++mt) X[mt] = mfma16(as_frag(fb[mt * 2 + k]), Sb[2 + k], X[mt]);
#pragma unroll
                for (int k2 = 0; k2 < 2; ++k2) { u32x4 o; o.x = pk2(X[2 * k2][0], X[2 * k2][1]); o.y = pk2(X[2 * k2][2], X[2 * k2][3]); o.z = pk2(X[2 * k2 + 1][0], X[2 * k2 + 1][1]); o.w = pk2(X[2 * k2 + 1][2], X[2 * k2 + 1][3]); Xb[k2] = as_frag(o); }
            } else {
#pragma unroll
                for (int k2 = 0; k2 < 2; ++k2) Xb[k2] = as_frag(FRAG(L_WN, w * 2 + k2));
#pragma unroll
                for (int mt = 0; mt < 4; ++mt)
#pragma unroll
                    for (int k = 0; k < 2; ++k) fa[mt * 2 + k] = FRAG(L_QD, mt * 4 + k);
            }
            PROBE_END(GDN ? 22 : 32); PROBE_BEGIN(GDN ? 23 : 33);
#pragma unroll
            for (int mt = 0; mt < 4; ++mt)
#pragma unroll
                for (int k = 0; k < 2; ++k) fb[mt * 2 + k] = FRAG(L_QD, mt * 4 + 2 + k);
#pragma unroll
            for (int mt = 0; mt < 4; ++mt) O[mt] = (f32x4){0.f, 0.f, 0.f, 0.f};
#pragma unroll
            for (int k = 0; k < 2; ++k)
#pragma unroll
                for (int mt = 0; mt < 4; ++mt) O[mt] = mfma16(Sb[k], as_frag(fa[mt * 2 + k]), O[mt]);
#pragma unroll
            for (int i = 0; i < 8; ++i) fa[i] = FRAG(L_AT, i);
#pragma unroll
            for (int k = 0; k < 2; ++k)
#pragma unroll
                for (int mt = 0; mt < 4; ++mt) O[mt] = mfma16(Sb[2 + k], as_frag(fb[mt * 2 + k]), O[mt]);
#pragma unroll
            for (int i = 0; i < 8; ++i) fb[i] = FRAG(L_KT, i);
#pragma unroll
            for (int k2 = 0; k2 < 2; ++k2)
#pragma unroll
                for (int mt = 0; mt < 4; ++mt) O[mt] = mfma16(Xb[k2], as_frag(fa[mt * 2 + k2]), O[mt]);
#pragma unroll
            for (int i = 0; i < 8; ++i) fa[i] = FRAG(L_KT, 8 + i);
            PROBE_END(GDN ? 23 : 33); PROBE_BEGIN(GDN ? 24 : 34);
            {
                f32x4 d[8];
                if (GDN) { const float ds = *(const LAS float*)(img + L_SC);
#pragma unroll
                    for (int kt = 0; kt < 8; ++kt) d[kt] = (f32x4){ds, ds, ds, ds}; }
                else {
#pragma unroll
                    for (int kt = 0; kt < 8; ++kt) d[kt] = *(const LAS f32x4*)(img + L_U + (16 * kt + 4 * g) * 4); }
#pragma unroll
                for (int kt = 0; kt < 8; ++kt) S[kt] = S[kt] * d[kt];
            }
#pragma unroll
            for (int k2 = 0; k2 < 2; ++k2)
#pragma unroll
                for (int kt = 0; kt < 4; ++kt) S[kt] = mfma16(as_frag(fb[kt * 2 + k2]), Xb[k2], S[kt]);
#pragma unroll
            for (int k2 = 0; k2 < 2; ++k2)
#pragma unroll
                for (int kt = 0; kt < 4; ++kt) S[4 + kt] = mfma16(as_frag(fa[kt * 2 + k2]), Xb[k2], S[4 + kt]);
            PROBE_END(GDN ? 24 : 34); PROBE_BEGIN(GDN ? 25 : 35);
#pragma unroll
            for (int mt = 0; mt < 4; ++mt) {
                const int li = 16 * mt + c;
                const int m = GDN ? tok_b(s, n, li) : tok_a(s, n, li);
                u32x2 o; o.x = pk2(O[mt][0], O[mt][1]); o.y = pk2(O[mt][2], O[mt][3]);
                *(u32x2*)(Obase + (size_t)dir * (10 * MiB) + (size_t)m * 512 + h * 128 + 16 * w + 4 * g) = o;
            }
            PROBE_END(GDN ? 25 : 35);
            }
            PROBE_END(GDN ? 2 : 12); PROBE_BEGIN(GDN ? 3 : 13);
            asm volatile("s_waitcnt vmcnt(0)" ::: "memory");
            __syncthreads();
            PROBE_END(GDN ? 3 : 13);
        }
#undef P4_DMA
#undef FRAG
        if (s < 16 && comp) {
            float* sp = st_out + (size_t)((bq * 2 + dir) * 4 + h) * 16384 + 16 * w + c;
#pragma unroll
            for (int kt = 0; kt < 8; ++kt)
#pragma unroll
                for (int i = 0; i < 4; ++i) sp[(16 * kt + 4 * g + i) * 128] = S[kt][i];
        }
    }
    if (GDN && roles && F.bid >= 128) { __syncthreads(); late_weights(F, (F.bid - 128) * NWAVES + F.wave, 128 * NWAVES); }
    if (!GDN && roles && F.bid >= 128) { __syncthreads(); p3_gdn(F, NUC - NR_EARLY, NR_EARLY, F.bid - 128, 128); }
}

constexpr int NPHASE = 13;
__global__ void __launch_bounds__(NTHR, 2) mk_fwd(Args args) {
    extern __shared__ __attribute__((aligned(16))) unsigned char lds_raw[];
    Frame F;
    F.lds = (LAS unsigned char*)lds_raw;
    F.tid = threadIdx.x; F.lane = F.tid & 63; F.wave = __builtin_amdgcn_readfirstlane(F.tid >> 6);
    F.bid = blockIdx.x; F.G = gridDim.x;
#pragma unroll
    for (int i = 0; i < N_IN; ++i) F.in[i] = args.in[i];
    F.out = args.out; F.ws = args.ws; F.pacc = 0ull; F.pt0 = 0ull;
    volatile LAS unsigned* MISC = (volatile LAS unsigned*)(F.lds + MISC_OFF);
    for (int u = F.tid; u < (LDS_BYTES - LDSCTL_OFF) / 4; u += NTHR) ((LAS unsigned*)(F.lds + LDSCTL_OFF))[u] = 0u;
    __syncthreads();
    const int lo = args.ph_lo, hi = args.ph_hi;
    const bool multi = (hi - lo) > 1;
    XcdBarrier bar; bar.bar = (unsigned*)(F.ws + WS_CTL) + CW_BAR; bar.x = 0; bar.st = nullptr;
    if (multi) bar = xcd_barrier_post((unsigned*)(F.ws + WS_CTL) + CW_BAR, MISC + 8);
#ifndef PH_MASK
#define PH_MASK 0x1fff
#endif
#define IN(k) (((PH_MASK >> (k)) & 1) && lo <= (k) && (k) < hi)
#define SEAM(k) do { if (IN(k) && IN((k) + 1)) xcd_barrier(bar); } while (0)
#define NREP(k) ((((REP_MASK) >> (k)) & 1) ? 2 : 1)
#define REPSYNC(k) do { if (((REP_MASK) >> (k)) & 1) xcd_barrier(bar); } while (0)

    PROBE_BEGIN(100);
    if (IN(0)) for (int rep = 0; rep < NREP(0); ++rep) { if (rep) REPSYNC(0); p0_prologue(F); } SEAM(0); PROBE_END(100);
    PROBE_BEGIN(101);
    if (IN(1)) for (int rep = 0; rep < NREP(1); ++rep) { if (rep) REPSYNC(1); modnorm_rows<false>(F, F.in[I_XP], F.in[I_XS], nullptr, F.in[I_N1], 0, 1024, WSP(bf16, WS_H)); } SEAM(1); PROBE_END(101);
    PROBE_BEGIN(102);
    if (IN(2)) for (int rep = 0; rep < NREP(2); ++rep) { if (rep) REPSYNC(2);
        pg8::Gemm g{WSP(bf16, WS_H), WSP(bf16, WS_WIN), NT, NPAD, DM}; pg8::StaticOrder S; S.init(NT, NPAD, DM, F.G, F.bid);
        pg8::EpiProj E;
        E.d0 = OUTB(bf16, OUT_QA); E.d1 = OUTB(bf16, OUT_GF); E.d2 = OUTB(bf16, OUT_GB); E.d3 = OUTB(bf16, OUT_VA); E.d4 = WSP(bf16, WS_AG);
        E.d5 = WSP(bf16, WS_BQ); E.d6 = WSP(bf16, WS_BK); E.d7 = WSP(bf16, WS_BV); E.d8 = WSP(bf16, WS_BZ);
        E.BETA = WSP(float, WS_BETA); E.GG = WSP(float, WS_GG); E.lbraw = F.in[I_LB]; E.Alog = F.in[I_ALOG]; E.dtb = F.in[I_DTB];
        pg8::gemm_phase<pg8::EpiProj, pg8::StaticOrder, true, true>(F.lds, g, S, E);
    } SEAM(2); PROBE_END(102);
    PROBE_BEGIN(103);
    if (IN(3)) for (int rep = 0; rep < NREP(3); ++rep) { if (rep) REPSYNC(3); p3_hgrn(F); } SEAM(3); PROBE_END(103);
    PROBE_BEGIN(104);
    if (IN(4)) for (int rep = 0; rep < NREP(4); ++rep) { if (rep) REPSYNC(4); p4_chain<false>(F); } SEAM(4); PROBE_END(104);
    PROBE_BEGIN(105);
    if (IN(5)) for (int rep = 0; rep < NREP(5); ++rep) { if (rep) REPSYNC(5); p3_gdn(F, 0, (F.G == 256) ? NUC - NR_EARLY : NUC, F.bid, F.G); } SEAM(5); PROBE_END(105);
    PROBE_BEGIN(106);
    if (IN(6)) for (int rep = 0; rep < NREP(6); ++rep) { if (rep) REPSYNC(6); p4_chain<true>(F); } SEAM(6); PROBE_END(106);
    PROBE_BEGIN(107);
    if (IN(7)) for (int rep = 0; rep < NREP(7); ++rep) { if (rep) REPSYNC(7); if (F.G != 256) late_weights(F, F.bid * NWAVES + F.wave, F.G * NWAVES); p5_headnorm(F); } SEAM(7); PROBE_END(107);
    PROBE_BEGIN(108);
    if (IN(8)) for (int rep = 0; rep < NREP(8); ++rep) { if (rep) REPSYNC(8);
        pg8::Gemm g{WSP(bf16, WS_YIN), WSP(bf16, WS_WOUT), NT, DM, DM}; pg8::SplitOrder S; S.init(NT, DM, DM, F.G, F.bid);
        pg8::EpiSplit<pg8::EpiRes<false>> E{{F.in[I_XP], F.in[I_XS], nullptr, WSP(bf16, WS_XR), WSP(float, WS_MOD), 2048, nullptr, nullptr, nullptr}, WSP(float, WS_SLAB), (unsigned*)(F.ws + WS_CTL) + CW_SPLIT6, (LAS unsigned*)(F.lds + MISC_OFF + 64)};
        pg8::gemm_phase<pg8::EpiSplit<pg8::EpiRes<false>>, pg8::SplitOrder, true, true>(F.lds, g, S, E);
    } SEAM(8); PROBE_END(108);
    PROBE_BEGIN(109);
    if (IN(9)) for (int rep = 0; rep < NREP(9); ++rep) { if (rep) REPSYNC(9); modnorm_rows<true>(F, nullptr, nullptr, WSP(bf16, WS_XR), F.in[I_N2], 3072, 4096, WSP(bf16, WS_H2)); } SEAM(9); PROBE_END(109);
    PROBE_BEGIN(110);
    if (IN(10)) for (int rep = 0; rep < NREP(10); ++rep) { if (rep) REPSYNC(10);
        pg8::Gemm g{WSP(bf16, WS_H2), WSP(bf16, WS_WGU), NT, 2 * DFF, DM}; pg8::StaticOrder S; S.init(NT, 2 * DFF, DM, F.G, F.bid);
        pg8::EpiGU E{WSP(bf16, WS_GU)};
        pg8::gemm_phase<pg8::EpiGU, pg8::StaticOrder, true, true>(F.lds, g, S, E);
    } SEAM(10); PROBE_END(110);
    PROBE_BEGIN(111);
    if (IN(11)) for (int rep = 0; rep < NREP(11); ++rep) { if (rep) REPSYNC(11);
        pg8::Gemm g{WSP(bf16, WS_GU), WSP(bf16, WS_WDN), NT, DM, DFF}; pg8::SplitOrder S; S.init(NT, DM, DFF, F.G, F.bid);
        pg8::EpiSplit<pg8::EpiRes<true>> E{{nullptr, nullptr, WSP(bf16, WS_XR), WSP(bf16, WS_XR), WSP(float, WS_MOD), 5120, nullptr, nullptr, nullptr}, WSP(float, WS_SLAB), (unsigned*)(F.ws + WS_CTL) + CW_SPLIT9, (LAS unsigned*)(F.lds + MISC_OFF + 64)};
        pg8::gemm_phase<pg8::EpiSplit<pg8::EpiRes<true>>, pg8::SplitOrder, true, true>(F.lds, g, S, E);
    } SEAM(11); PROBE_END(111);
    PROBE_BEGIN(112);
    if (IN(12)) for (int rep = 0; rep < NREP(12); ++rep) { if (rep) REPSYNC(12); final_norm(F); }
    PROBE_END(112);
    if (PROBE_ID != 0 && blockIdx.x == PROBE_BLK && threadIdx.x == 0) { const unsigned long long t0 = __builtin_amdgcn_s_memrealtime(), dt = F.pacc * PROBE_K; while (__builtin_amdgcn_s_memrealtime() - t0 < dt) __builtin_amdgcn_s_sleep(16); }
#undef IN
#undef SEAM
}

extern "C" void kernel_launch(void* const* d_in, const int* in_sizes, int n_in, void* d_out, int out_size, void* d_ws, size_t ws_size, hipStream_t stream) {
    static int grid = 0;
    if (grid == 0) {
        if (n_in != N_IN || ws_size < WS_END) { fprintf(stderr, "kernel_launch: unexpected n_in %d / ws %zu\n", n_in, ws_size); grid = -1; return; }
        int dev = 0, cus = 0;
        if (hipGetDevice(&dev) != hipSuccess || hipDeviceGetAttribute(&cus, hipDeviceAttributeMultiprocessorCount, dev) != hipSuccess) { grid = -1; return; }
        if (hipFuncSetAttribute((const void*)mk_fwd, hipFuncAttributeMaxDynamicSharedMemorySize, LDS_BYTES) != hipSuccess) { fprintf(stderr, "kernel_launch: hipFuncSetAttribute failed\n"); grid = -1; return; }
        int per_cu = 0;
        if (hipOccupancyMaxActiveBlocksPerMultiprocessor(&per_cu, (const void*)mk_fwd, NTHR, LDS_BYTES) != hipSuccess || per_cu < 1) { fprintf(stderr, "kernel_launch: occupancy query reports %d\n", per_cu); }
        (void)hipGetLastError();
        grid = cus < 256 ? cus : 256;
    }
    if (grid < 0) return;
    (void)hipMemsetAsync((char*)d_ws + WS_CTL, 0, CTL_ZERO_BYTES, stream);
    Args a{};
    for (int i = 0; i < N_IN; ++i) a.in[i] = (const float*)d_in[i];
    a.out = (float*)d_out; a.ws = (unsigned char*)d_ws;
#if MK_ONE_LAUNCH
    a.ph_lo = 0; a.ph_hi = NPHASE;
    hipLaunchKernelGGL(mk_fwd, dim3(grid), dim3(NTHR), LDS_BYTES, stream, a);
#else
    for (int k = 0; k < NPHASE; ++k) { a.ph_lo = k; a.ph_hi = k + 1; hipLaunchKernelGGL(mk_fwd, dim3(grid), dim3(NTHR), LDS_BYTES, stream, a); }
#endif
}
```

```cpp
#include <hip/hip_runtime.h>
#include <cstdio>
#include <cstdint>

#ifndef REP_MASK
#define REP_MASK 0x0
#endif
#ifndef PROBE_ID
#define PROBE_ID 0
#endif
#define PROBE_K 1
#ifndef PROBE_BLK
#define PROBE_BLK 0
#endif
#ifndef MK_ONE_LAUNCH
#define MK_ONE_LAUNCH 1
#endif

#define LAS __attribute__((address_space(3)))
#define GAS __attribute__((address_space(1)))
typedef unsigned short bf16;
typedef short bf16x8 __attribute__((ext_vector_type(8)));
typedef float f32x4 __attribute__((ext_vector_type(4)));
typedef float f32x2 __attribute__((ext_vector_type(2)));
typedef unsigned u32x4 __attribute__((ext_vector_type(4)));
typedef unsigned u32x2 __attribute__((ext_vector_type(2)));
typedef GAS unsigned gu32;

constexpr int NT = 20480, NCTX = 4096, DM = 1024, DPROJ = 4624, NPAD = 4864, DFF = 2816, NSEQ = 20;
constexpr float EPS = 1e-6f;
constexpr int NWAVES = 8, NTHR = 512;
enum { I_XP = 0, I_XS, I_C, I_SH, I_SG, I_CCTX, I_WADA, I_BADA, I_N1, I_N2, I_WIN, I_CONV, I_LB, I_ALOG, I_DTB, I_HNORM, I_GNORM, I_WOUT, I_WGATE, I_WUP, I_WDOWN, I_NF, N_IN };

constexpr size_t MiB = 1u << 20;
constexpr size_t WS_CTL = 0, CTL_ZERO_BYTES = 2 * MiB;
constexpr size_t WS_MOD = 1 * MiB;
constexpr size_t WS_BETA = 2 * MiB, WS_GG = 3 * MiB;
constexpr size_t WS_BQ = 4 * MiB, WS_BK = 24 * MiB, WS_BV = 44 * MiB;
constexpr size_t WS_OB = 4 * MiB;
constexpr size_t WS_AG = 64 * MiB, WS_BZ = 84 * MiB;
constexpr size_t WS_I = 104 * MiB;
constexpr size_t WS_H = 104 * MiB;
constexpr size_t WS_WIN = 144 * MiB;
constexpr size_t WS_YIN = 104 * MiB;
constexpr size_t WS_WOUT = 44 * MiB, WS_WGU = 46 * MiB, WS_WDN = 57 * MiB;
constexpr size_t WS_H2 = 4 * MiB;
constexpr size_t WS_GU = 64 * MiB;
constexpr size_t WS_SLAB = 160 * MiB;
constexpr size_t WS_XR = 176 * MiB;
constexpr size_t WS_END = 256 * MiB;
constexpr size_t OUT_QA = 0, OUT_VA = 20 * MiB, OUT_GF = 40 * MiB, OUT_GB = 60 * MiB, OUT_OA = 0, OUT_GOVF = 40 * MiB;
constexpr size_t OUT_Y_FLOATS = (size_t)NT * DM, STATE_FLOATS = (size_t)16 * 2 * 4 * 128 * 128;
constexpr int HREC = 41472;
constexpr int GREC = 73984;
constexpr int NUC = 2560, NVB = 1280;
constexpr size_t WS_HVB = WS_I + (size_t)NUC * HREC;
constexpr int N1G = 2154;
static_assert((size_t)N1G * GREC <= 152 * MiB && (size_t)(NUC - N1G) * GREC <= 40 * MiB, "GDN image split");
constexpr int NR_EARLY = 768;
static_assert(WS_I + (size_t)(NUC - NR_EARLY) * GREC >= WS_I + (size_t)NUC * HREC + (size_t)NVB * 16384, "early GDN records must not touch the HGRN images");
static_assert(WS_HVB + (size_t)NVB * 16384 <= WS_END, "HGRN images fit");
constexpr int L_WN = 0, L_QD = 16384, L_AT = 32768, L_KT = 40960, L_U = 57344, L_SC = 73728;

constexpr int CW_BAR = 4096;
constexpr int CW_PROG_H = 16384, CW_PROG_G = 16384 + 64 * 32;
constexpr int P4_PD = 4;
constexpr int CW_SPLIT6 = 32768, CW_SPLIT9 = 32768 + 64 * 64;
constexpr int P4_BUF = 74752;
constexpr int RING_BYTES = 2 * P4_BUF, LDSCTL_OFF = RING_BYTES, MISC_OFF = LDSCTL_OFF + 320, LDS_BYTES = RING_BYTES + 1024;
static_assert(RING_BYTES >= 131072 && LDS_BYTES <= 163840, "LDS map");

#define PROBE_BEGIN(id) do { if (PROBE_ID == (id) && blockIdx.x == PROBE_BLK && threadIdx.x == 0) probe_t0 = __builtin_amdgcn_s_memrealtime(); } while (0)
#define PROBE_END(id) do { if (PROBE_ID == (id) && blockIdx.x == PROBE_BLK && threadIdx.x == 0) probe_acc += __builtin_amdgcn_s_memrealtime() - probe_t0; } while (0)
#define LDS_WAIT() asm volatile("s_waitcnt lgkmcnt(0)" ::: "memory")
#define VM_WAIT() asm volatile("s_waitcnt vmcnt(0)" ::: "memory")
#define RLX_AGENT __ATOMIC_RELAXED, __HIP_MEMORY_SCOPE_AGENT
typedef float f32x2_t __attribute__((ext_vector_type(2)));
typedef __bf16 bf16x2_t __attribute__((ext_vector_type(2)));
__device__ __forceinline__ unsigned pk2(float lo, float hi) { const f32x2_t v = {lo, hi}; const bf16x2_t b = __builtin_convertvector(v, bf16x2_t); return __builtin_bit_cast(unsigned, b); }
__device__ __forceinline__ unsigned f2bf(float f) { return pk2(f, 0.f) & 0xffffu; }
__device__ __forceinline__ float bflo(unsigned w) { return __builtin_bit_cast(float, w << 16); }
__device__ __forceinline__ float bfhi(unsigned w) { return __builtin_bit_cast(float, w & 0xffff0000u); }
__device__ __forceinline__ float bf2f(unsigned short h) { return __builtin_bit_cast(float, (unsigned)h << 16); }
__device__ __forceinline__ float siluf(float x) { return x * __builtin_amdgcn_rcpf(1.f + __expf(-x)); }
__device__ __forceinline__ float sigmf(float x) { return __builtin_amdgcn_rcpf(1.f + __expf(-x)); }
__device__ __forceinline__ f32x4 mfma16(bf16x8 a, bf16x8 b, f32x4 c) { return __builtin_amdgcn_mfma_f32_16x16x32_bf16(a, b, c, 0, 0, 0); }
__device__ __forceinline__ bf16x8 as_frag(u32x4 v) { return __builtin_bit_cast(bf16x8, v); }
__device__ __forceinline__ float wave_sum(float v) {
#pragma unroll
    for (int o = 1; o < 64; o <<= 1) v += __shfl_xor(v, o);
    return v;
}
__device__ __forceinline__ int seq_base(int s) { return s < 16 ? s * 256 : NCTX + (s - 16) * 4096; }
__device__ __forceinline__ int seq_nchunk(int s) { return s < 16 ? 4 : 64; }
__device__ __forceinline__ int chunk_base(int s) { return s < 16 ? 4 * s : 64 + 64 * (s - 16); }
__device__ __forceinline__ int tok_a(int s, int n, int i) { return seq_base(s) + 64 * n + i; }
__device__ __forceinline__ int tok_b(int s, int n, int i) { return s < 16 ? s * 256 + 64 * n + i : NCTX + (s - 16) * 4096 + 64 * i + n; }
__device__ __forceinline__ int kperm(int g, int j) { return 16 * (j >> 2) + 4 * g + (j & 3); }

namespace pg8 {
#define PG8_LAS __attribute__((address_space(3)))
typedef unsigned short bf16_t;
typedef short bf16x8 __attribute__((ext_vector_type(8)));
typedef float f32x4 __attribute__((ext_vector_type(4)));
typedef unsigned u32x4 __attribute__((ext_vector_type(4)));
constexpr int BM = 256, BK = 64, HALF = 128, HTB = HALF * BK * 2  , STAGE_BYTES = 8 * HTB, NXCD = 8, WGM = 8;

__host__ __device__ __forceinline__ int lds_byte(int r, int c) { const int st = (r >> 4) * 2 + (c >> 5), rr = r & 15, cc = c & 31, ob = rr * 64 + cc * 2; return st * 1024 + (ob ^ (((ob >> 9) & 1) << 5)); }
__host__ __device__ __forceinline__ void stage_rc(int b, int& R, int& C) { const int st = b / 1024, sb = b % 1024, swz = sb ^ (((sb >> 9) & 1) << 5); R = (st >> 1) * 16 + swz / 64; C = (st & 1) * 32 + (swz % 64) / 2; }
__host__ __device__ __forceinline__ int perm32(int rho) { const int n = rho >> 4, i = rho & 15; return 8 * (i >> 2) + 4 * n + (i & 3); }

struct Unit { int pm, pn, k0, nt, ns, su, sl; };
struct Gemm { const bf16_t* A; const bf16_t* Bt; int M, N, K; };

struct StaticOrder {
    int nM, nN, nwg, G, c, K;
    __host__ __device__ void init(int M, int N, int K_, int G_, int c_) { nM = M / BM; nN = N / BM; nwg = nM * nN; G = G_; c = c_; K = K_; }
    __host__ __device__ bool next(int i, Unit& u) const {
        const long L = (long)i * G + c; if (L >= nwg) return false;
        int wgid = (int)L; { const int q = nwg / NXCD, r = nwg % NXCD, xcd = wgid % NXCD, off = wgid / NXCD; wgid = (xcd < r ? xcd * (q + 1) : r * (q + 1) + (xcd - r) * q) + off; }
        const int nig = WGM * nN, gid = wgid / nig, fm = gid * WGM, gsz = (nM - fm) < WGM ? (nM - fm) : WGM;
        u.pm = fm + ((wgid % nig) % gsz); u.pn = (wgid % nig) / gsz; u.k0 = 0; u.nt = K / BK; u.ns = 1; u.su = 0; u.sl = 0; return true;
    }
    __device__ __forceinline__ void a_ready(const Unit&) const {}
    __device__ __forceinline__ void done(const Unit&) const {}
};

struct SplitOrder {
    StaticOrder so; bool split;
    __host__ __device__ void init(int M, int N, int K_, int G_, int c_) { so.init(M, N, K_, G_, c_); split = false && (G_ == 256 && so.nwg == 320); }
    __host__ __device__ bool next(int i, Unit& u) const {
        if (!split) return so.next(i, u);
        if (i == 0) return so.next(0, u);
        if (i > 1) return false;
        StaticOrder t = so; t.c = 256 + (so.c >> 2); t.G = 1 << 20; if (!t.next(0, u)) return false;
        const int ntt = so.K / BK, sl = so.c & 3, q = ((ntt / 4) + 1) & ~1;
        const int big = (ntt - 4 * (q - 2)) / 2;
        const int t0 = sl < big ? sl * q : big * q + (sl - big) * (q - 2), tn = sl < big ? q : q - 2;
        u.k0 = t0 * BK; u.nt = tn; u.ns = 4; u.su = so.c >> 2; u.sl = sl; return true;
    }
    __device__ __forceinline__ void a_ready(const Unit&) const {}
    __device__ __forceinline__ void done(const Unit&) const {}
};

__device__ __forceinline__ unsigned pkbf(float lo, float hi) { return ::pk2(lo, hi); }

struct EpiProj {
    static constexpr bool PERM = true, AFTER_DRAIN = false;
    bf16_t *d0, *d1, *d2, *d3, *d4, *d5, *d6, *d7, *d8;
    float* BETA; float* GG;
    const float* lbraw;
    const float* Alog; const float* dtb;
    __device__ __forceinline__ void operator()(const f32x4 (&acc)[2][2][4][2], const Unit& u, int wr, int wc, int fr, int fq) const {
        const int pn = u.pn, row0 = u.pm * BM + wr * 64 + fr;
        if (pn < 18) {
            const int seg = pn >> 1;
            bf16_t* base = seg == 0 ? d0 : seg == 1 ? d1 : seg == 2 ? d2 : seg == 3 ? d3 : seg == 4 ? d4 : seg == 5 ? d5 : seg == 6 ? d6 : seg == 7 ? d7 : d8;
            const int mode = (seg == 0 || seg == 4 || seg == 8) ? 1 : ((seg == 1 || seg == 2) ? 2 : 0);
#pragma unroll
            for (int bj = 0; bj < 2; ++bj) {
                const int c0 = (pn & 1) * 256 + bj * HALF + wc * 32 + 8 * fq;
                float lb[8];
                if (mode == 2) {
                    const int dir = seg - 1;
#pragma unroll
                    for (int e = 0; e < 8; ++e) { const float x0 = lbraw[dir * 512 + c0 + e], x1 = lbraw[1024 + dir * 512 + c0 + e]; lb[e] = 1.f / (1.f + __expf(x1 - x0)); }
                }
#pragma unroll
                for (int ai = 0; ai < 2; ++ai)
#pragma unroll
                    for (int m = 0; m < 4; ++m) {
                        float v[8];
#pragma unroll
                        for (int e = 0; e < 4; ++e) { v[e] = acc[ai][bj][m][0][e]; v[4 + e] = acc[ai][bj][m][1][e]; }
                        if (mode == 1) {
#pragma unroll
                            for (int e = 0; e < 8; ++e) v[e] = ::siluf(v[e]);
                        } else if (mode == 2) {
#pragma unroll
                            for (int e = 0; e < 8; ++e) { const float f = lb[e] + (1.f - lb[e]) * ::sigmf(v[e]); v[e] = __logf(f); }
                        }
                        u32x4 w; w.x = pkbf(v[0], v[1]); w.y = pkbf(v[2], v[3]); w.z = pkbf(v[4], v[5]); w.w = pkbf(v[6], v[7]);
                        *(u32x4*)(base + (size_t)(row0 + ai * HALF + m * 16) * 512 + c0) = w;
                    }
            }
        } else {
            if (wc == 0 && fq < 2) {
                float al[8], db[8];
                if (fq == 1) {
#pragma unroll
                    for (int e = 0; e < 8; ++e) { al[e] = -__expf(Alog[e]); db[e] = dtb[e]; }
                }
#pragma unroll
                for (int ai = 0; ai < 2; ++ai)
#pragma unroll
                    for (int m = 0; m < 4; ++m) {
                        const int row = row0 + ai * HALF + m * 16;
                        float v[8];
#pragma unroll
                        for (int e = 0; e < 4; ++e) { v[e] = acc[ai][0][m][0][e]; v[4 + e] = acc[ai][0][m][1][e]; }
                        if (fq == 0) {
#pragma unroll
                            for (int e = 0; e < 8; ++e) v[e] = ::sigmf(v[e]);
                            *(f32x4*)(BETA + (size_t)row * 8) = (f32x4){v[0], v[1], v[2], v[3]};
                            *(f32x4*)(BETA + (size_t)row * 8 + 4) = (f32x4){v[4], v[5], v[6], v[7]};
                        } else {
#pragma unroll
                            for (int e = 0; e < 8; ++e) { const float x = v[e] + db[e]; const float sp = x > 15.f ? x : log1pf(__expf(x)); v[e] = al[e] * sp; }
                            *(f32x4*)(GG + (size_t)row * 8) = (f32x4){v[0], v[1], v[2], v[3]};
                            *(f32x4*)(GG + (size_t)row * 8 + 4) = (f32x4){v[4], v[5], v[6], v[7]};
                        }
                    }
            }
        }
    }
};

template <bool BASE_BF16> struct EpiRes {
    static constexpr bool PERM = true, AFTER_DRAIN = false;
    const float* base0; const float* base1;
    const bf16_t* baseb;
    bf16_t* out; const float* mod; int goff;
    const float *p1 = nullptr, *p2 = nullptr, *p3 = nullptr;
    __device__ __forceinline__ void operator()(const f32x4 (&acc)[2][2][4][2], const Unit& u, int wr, int wc, int fr, int fq) const {
        const int row0 = u.pm * BM + wr * 64 + fr;
        const int mr = u.pm < 16 ? 0 : 1 + ((u.pm - 16) >> 4);
        const float* gp = mod + (size_t)mr * 6144 + goff;
#pragma unroll
        for (int bj = 0; bj < 2; ++bj) {
            const int c0 = u.pn * BM + bj * HALF + wc * 32 + 8 * fq;
            const f32x4 g0 = *(const f32x4*)(gp + c0), g1 = *(const f32x4*)(gp + c0 + 4);
#pragma unroll
            for (int ai = 0; ai < 2; ++ai)
#pragma unroll
                for (int m = 0; m < 4; ++m) {
                    const int row = row0 + ai * HALF + m * 16;
                    f32x4 b0, b1;
                    if (BASE_BF16) { const u32x4 bw = *(const u32x4*)(baseb + (size_t)row * 1024 + c0);
                        b0 = (f32x4){::bflo(bw.x), ::bfhi(bw.x), ::bflo(bw.y), ::bfhi(bw.y)}; b1 = (f32x4){::bflo(bw.z), ::bfhi(bw.z), ::bflo(bw.w), ::bfhi(bw.w)}; }
                    else { const float* bp = (row < 4096 ? base0 + (size_t)row * 1024 : base1 + (size_t)(row - 4096) * 1024) + c0; b0 = *(const f32x4*)bp; b1 = *(const f32x4*)(bp + 4); }
                    f32x4 a0 = acc[ai][bj][m][0], a1 = acc[ai][bj][m][1];
                    if (p1) { const float *q1 = p1 + threadIdx.x * 4, *q2 = p2 + threadIdx.x * 4, *q3 = p3 + threadIdx.x * 4; asm volatile("" : "+v"(q1), "+v"(q2), "+v"(q3));
                        const int i0 = (((ai * 2 + bj) * 4 + m) * 2) * 2048, i1 = i0 + 2048;
                        a0 = a0 + (*(const f32x4*)(q1 + i0) + *(const f32x4*)(q2 + i0)) + *(const f32x4*)(q3 + i0); a1 = a1 + (*(const f32x4*)(q1 + i1) + *(const f32x4*)(q2 + i1)) + *(const f32x4*)(q3 + i1); }
                    const f32x4 o0 = b0 + g0 * a0, o1 = b1 + g1 * a1;
                    u32x4 w; w.x = pkbf(o0[0], o0[1]); w.y = pkbf(o0[2], o0[3]); w.z = pkbf(o1[0], o1[1]); w.w = pkbf(o1[2], o1[3]);
                    *(u32x4*)(out + (size_t)row * 1024 + c0) = w;
                }
        }
    }
};

struct EpiGU {
    static constexpr bool PERM = true, AFTER_DRAIN = false;
    bf16_t* GU;
    __device__ __forceinline__ void operator()(const f32x4 (&acc)[2][2][4][2], const Unit& u, int wr, int wc, int fr, int fq) const {
        const int row0 = u.pm * BM + wr * 64 + fr, c0 = u.pn * HALF + wc * 32 + 8 * fq;
#pragma unroll
        for (int ai = 0; ai < 2; ++ai)
#pragma unroll
            for (int m = 0; m < 4; ++m) {
                float v[8];
#pragma unroll
                for (int e = 0; e < 4; ++e) { v[e] = ::siluf(acc[ai][0][m][0][e]) * acc[ai][1][m][0][e]; v[4 + e] = ::siluf(acc[ai][0][m][1][e]) * acc[ai][1][m][1][e]; }
                u32x4 w; w.x = pkbf(v[0], v[1]); w.y = pkbf(v[2], v[3]); w.z = pkbf(v[4], v[5]); w.w = pkbf(v[6], v[7]);
                *(u32x4*)(GU + (size_t)(row0 + ai * HALF + m * 16) * 2816 + c0) = w;
            }
    }
};

template <class Inner> struct EpiSplit {
    static constexpr bool PERM = Inner::PERM, AFTER_DRAIN = false;
    Inner in; float* slab; unsigned* cnt; PG8_LAS unsigned* flag;
    __device__ __forceinline__ void operator()(const f32x4 (&acc)[2][2][4][2], const Unit& u, int wr, int wc, int fr, int fq) const {
        if (u.ns == 1) { in(acc, u, wr, wc, fr, fq); return; }
        const int tid = threadIdx.x;
        float* my = slab + (size_t)(u.su * 4 + u.sl) * 65536;
        const __amdgpu_buffer_rsrc_t rs = __builtin_amdgcn_make_buffer_rsrc(my, 0, 262144, 0x00020000);
#pragma unroll
        for (int ai = 0; ai < 2; ++ai)
#pragma unroll
            for (int bj = 0; bj < 2; ++bj)
#pragma unroll
                for (int m = 0; m < 4; ++m)
#pragma unroll
                    for (int n = 0; n < 2; ++n) __builtin_amdgcn_raw_buffer_store_b128(__builtin_bit_cast(u32x4, acc[ai][bj][m][n]), rs, (unsigned)(tid * 16), (unsigned)((((ai * 2 + bj) * 4 + m) * 2 + n) * 8192), 16);
        asm volatile("s_waitcnt vmcnt(0)" ::: "memory");
        __builtin_amdgcn_s_barrier();
        if (tid == 0) {
            const unsigned old = __hip_atomic_fetch_add(cnt + 64 * u.su, 1u, __ATOMIC_RELAXED, __HIP_MEMORY_SCOPE_AGENT);
            const unsigned last = (old == 3u) ? 1u : 0u;
            if (last) { __builtin_amdgcn_fence(__ATOMIC_ACQUIRE, "agent"); asm volatile("s_waitcnt vmcnt(0)" ::: "memory"); }
            *flag = last;
        }
        asm volatile("s_waitcnt lgkmcnt(0)" ::: "memory");
        __builtin_amdgcn_s_barrier();
        const unsigned last = *flag;
        if (last) {
            Inner in2 = in;
            in2.p1 = slab + (size_t)(u.su * 4 + ((u.sl + 1) & 3)) * 65536; in2.p2 = slab + (size_t)(u.su * 4 + ((u.sl + 2) & 3)) * 65536; in2.p3 = slab + (size_t)(u.su * 4 + ((u.sl + 3) & 3)) * 65536;
            in2(acc, u, wr, wc, fr, fq);
        }
    }
};
template <class Epi, class Sched, bool ALIGN_EPI = false, bool SP2 = false>
__device__ __forceinline__ void gemm_phase(PG8_LAS unsigned char* lds, const Gemm g, const Sched& S, const Epi& E) {
    const int tid = threadIdx.x, wid = __builtin_amdgcn_readfirstlane(tid >> 6), lane = tid & 63, wr = wid >> 2, wc = wid & 3, fr = lane & 15, fq = lane >> 4;
    const int K = g.K;
    unsigned voffA[2], voffB[2];
#pragma unroll
    for (int i = 0; i < 2; ++i) { int R, C; stage_rc(tid * 16 + i * 8192, R, C); const int Rb = Epi::PERM ? ((R & ~31) + perm32(R & 31)) : R;
        voffA[i] = (unsigned)(R * K + C) * 2u; voffB[i] = (unsigned)(Rb * K + C) * 2u; }
    const size_t kstep = (size_t)(BK * 2);
    const size_t hstep = (size_t)HALF * K * 2;
    const size_t tstep = 2 * hstep;
    const unsigned ldsw = (unsigned)wid * 1024u;
    const int aoff = lds_byte(wr * 64 + fr, fq * 8), boff = lds_byte(wc * 32 + fr, fq * 8);
#define PG8_SA(b, h) (((b) * 2 + (h)) * HTB)
#define PG8_SB(b, h) ((4 + (b) * 2 + (h)) * HTB)
#define PG8_STAGE(bufoff, gbase, voff) do { _Pragma("unroll") for (int _i = 0; _i < 2; ++_i) \
        __builtin_amdgcn_global_load_lds((const unsigned*)((const char*)(gbase) + (voff)[_i]), (PG8_LAS unsigned*)(lds + (bufoff) + ldsw + _i * 8192), 16, 0, 0); } while (0)
#define PG8_LDA(dst, b, h) do { _Pragma("unroll") for (int m = 0; m < 4; ++m) _Pragma("unroll") for (int k = 0; k < 2; ++k) dst[m][k] = *(const PG8_LAS bf16x8*)(lds + PG8_SA(b, h) + aoff + m * 2048 + k * 1024); } while (0)
#define PG8_LDB(dst, b, h) do { _Pragma("unroll") for (int n = 0; n < 2; ++n) _Pragma("unroll") for (int k = 0; k < 2; ++k) dst[n][k] = *(const PG8_LAS bf16x8*)(lds + PG8_SB(b, h) + boff + n * 2048 + k * 1024); } while (0)
#define PG8_MMA(ai, bj, At, Bt) do { __builtin_amdgcn_s_setprio(1); _Pragma("unroll") for (int m = 0; m < 4; ++m) _Pragma("unroll") for (int n = 0; n < 2; ++n) _Pragma("unroll") for (int k = 0; k < 2; ++k) \
        acc[ai][bj][m][n] = __builtin_amdgcn_mfma_f32_16x16x32_bf16(Bt[n][k], At[m][k], acc[ai][bj][m][n], 0, 0, 0); __builtin_amdgcn_s_setprio(0); } while (0)
#define PG8_WAIT_V(n) asm volatile("s_waitcnt vmcnt(" #n ")" ::: "memory")
#define PG8_WAIT_L(n) asm volatile("s_waitcnt lgkmcnt(" #n ")" ::: "memory")
#define PG8_BAR __builtin_amdgcn_s_barrier()
#define PG8_SCHED __builtin_amdgcn_sched_barrier(0)
    Unit cur, nxt; int ui = 0;
    if (!S.next(0, cur)) return;
    f32x4 acc[2][2][4][2];
#pragma unroll
    for (int a = 0; a < 2; ++a)
#pragma unroll
        for (int b = 0; b < 2; ++b)
#pragma unroll
            for (int m = 0; m < 4; ++m)
#pragma unroll
                for (int n = 0; n < 2; ++n) acc[a][b][m][n] = (f32x4){0.f, 0.f, 0.f, 0.f};
    bf16x8 At[4][2], B0[2][2], B1[2][2];
    const char* cA = (const char*)g.A + (size_t)cur.pm * tstep + (size_t)cur.k0 * 2; const char* cB = (const char*)g.Bt + (size_t)cur.pn * tstep + (size_t)cur.k0 * 2;
    S.a_ready(cur);
    if constexpr (SP2) {
        PG8_STAGE(PG8_SB(0, 0), cB, voffB); PG8_STAGE(PG8_SB(0, 1), cB + hstep, voffB); PG8_STAGE(PG8_SA(0, 0), cA, voffA); PG8_STAGE(PG8_SA(0, 1), cA + hstep, voffA);
        if (wr == 1) PG8_BAR;
        PG8_WAIT_V(2); PG8_BAR;
        PG8_STAGE(PG8_SB(1, 0), cB + kstep, voffB); PG8_STAGE(PG8_SA(1, 0), cA + kstep, voffA); PG8_STAGE(PG8_SB(1, 1), cB + hstep + kstep, voffB);
        PG8_WAIT_V(6); PG8_BAR;
    } else {
        PG8_STAGE(PG8_SB(0, 0), cB, voffB); PG8_STAGE(PG8_SA(0, 0), cA, voffA); PG8_STAGE(PG8_SB(0, 1), cB + hstep, voffB); PG8_STAGE(PG8_SA(0, 1), cA + hstep, voffA);
        if (wr == 1) PG8_BAR;
        PG8_WAIT_V(4); PG8_BAR;
        PG8_STAGE(PG8_SB(1, 0), cB + kstep, voffB); PG8_STAGE(PG8_SA(1, 0), cA + kstep, voffA); PG8_STAGE(PG8_SB(1, 1), cB + hstep + kstep, voffB);
        PG8_WAIT_V(6); PG8_BAR;
    }
    for (;;) {
        const bool has_next = S.next(ui + 1, nxt);
        const char* nA = has_next ? (const char*)g.A + (size_t)nxt.pm * tstep + (size_t)nxt.k0 * 2 : cA; const char* nB = has_next ? (const char*)g.Bt + (size_t)nxt.pn * tstep + (size_t)nxt.k0 * 2 : cB;
        const int nt = cur.nt;
        for (int t = 0; t < nt; t += 2) {
            const bool last = (t == nt - 2);
            const char* a1 = cA + (size_t)(t + 1) * kstep;
            const char* a2 = last ? nA : cA + (size_t)(t + 2) * kstep; const char* b2 = last ? nB : cB + (size_t)(t + 2) * kstep;
            const char* a3 = a2 + kstep; const char* b3 = b2 + kstep;
            if (last && has_next) S.a_ready(nxt);
            if constexpr (SP2) {
            PG8_LDB(B0, 0, 0); PG8_LDB(B1, 0, 1); PG8_SCHED; PG8_LDA(At, 0, 0); PG8_STAGE(PG8_SA(1, 1), a1 + hstep, voffA);
            PG8_WAIT_V(8); PG8_WAIT_L(0); PG8_BAR; PG8_MMA(0, 0, At, B0); PG8_MMA(0, 1, At, B1); PG8_BAR; PG8_SCHED;
            PG8_LDA(At, 0, 1); PG8_STAGE(PG8_SB(0, 0), b2, voffB); PG8_STAGE(PG8_SB(0, 1), b2 + hstep, voffB); PG8_STAGE(PG8_SA(0, 0), a2, voffA);
            PG8_WAIT_V(8); PG8_WAIT_L(0); PG8_BAR; PG8_MMA(1, 0, At, B0); PG8_MMA(1, 1, At, B1); PG8_BAR; PG8_SCHED;
            PG8_LDB(B0, 1, 0); PG8_LDB(B1, 1, 1); PG8_SCHED; PG8_LDA(At, 1, 0); PG8_STAGE(PG8_SA(0, 1), a2 + hstep, voffA);
            PG8_WAIT_V(8); PG8_WAIT_L(0); PG8_BAR; PG8_MMA(0, 0, At, B0); PG8_MMA(0, 1, At, B1); PG8_BAR; PG8_SCHED;
            PG8_LDA(At, 1, 1); PG8_STAGE(PG8_SB(1, 0), b3, voffB); PG8_STAGE(PG8_SB(1, 1), b3 + hstep, voffB); PG8_STAGE(PG8_SA(1, 0), a3, voffA);
            PG8_WAIT_V(8); PG8_WAIT_L(0); PG8_BAR; PG8_MMA(1, 0, At, B0); PG8_MMA(1, 1, At, B1); PG8_BAR; PG8_SCHED;
            } else {
            PG8_LDB(B0, 0, 0); PG8_SCHED; PG8_LDA(At, 0, 0); PG8_STAGE(PG8_SA(1, 1), a1 + hstep, voffA);
            PG8_WAIT_L(8); PG8_BAR; PG8_WAIT_L(0); PG8_MMA(0, 0, At, B0); PG8_BAR; PG8_SCHED;
            PG8_LDB(B1, 0, 1); PG8_STAGE(PG8_SB(0, 0), b2, voffB);
            PG8_BAR; PG8_WAIT_L(0); PG8_MMA(0, 1, At, B1); PG8_BAR;
            PG8_LDA(At, 0, 1); PG8_STAGE(PG8_SA(0, 0), a2, voffA);
            PG8_BAR; PG8_WAIT_L(0); PG8_MMA(1, 0, At, B0); PG8_BAR; PG8_SCHED;
            PG8_STAGE(PG8_SB(0, 1), b2 + hstep, voffB);
            PG8_WAIT_V(6); PG8_BAR; PG8_MMA(1, 1, At, B1); PG8_BAR;
            PG8_LDB(B0, 1, 0); PG8_SCHED; PG8_LDA(At, 1, 0); PG8_STAGE(PG8_SA(0, 1), a2 + hstep, voffA);
            PG8_WAIT_L(8); PG8_BAR; PG8_WAIT_L(0); PG8_MMA(0, 0, At, B0); PG8_BAR; PG8_SCHED;
            PG8_LDB(B1, 1, 1); PG8_STAGE(PG8_SB(1, 0), b3, voffB);
            PG8_BAR; PG8_WAIT_L(0); PG8_MMA(0, 1, At, B1); PG8_BAR;
            PG8_LDA(At, 1, 1); PG8_STAGE(PG8_SA(1, 0), a3, voffA);
            PG8_BAR; PG8_WAIT_L(0); PG8_MMA(1, 0, At, B0); PG8_BAR; PG8_SCHED;
            PG8_STAGE(PG8_SB(1, 1), b3 + hstep, voffB);
            PG8_WAIT_V(6); PG8_BAR; PG8_MMA(1, 1, At, B1); PG8_BAR;
            }
        }
        if constexpr (ALIGN_EPI) { if (wr == 0) PG8_BAR; }
        if constexpr (!Epi::AFTER_DRAIN) { E(acc, cur, wr, wc, fr, fq); S.done(cur); }
        if (!has_next) break;
#pragma unroll
        for (int a = 0; a < 2; ++a)
#pragma unroll
            for (int b = 0; b < 2; ++b)
#pragma unroll
                for (int m = 0; m < 4; ++m)
#pragma unroll
                    for (int n = 0; n < 2; ++n) acc[a][b][m][n] = (f32x4){0.f, 0.f, 0.f, 0.f};
        cur = nxt; cA = nA; cB = nB; ++ui;
        if constexpr (ALIGN_EPI) { if (wr == 1) PG8_BAR; }
    }
    PG8_WAIT_V(0);
    if constexpr (!ALIGN_EPI) { if (wr == 0) PG8_BAR; }
    PG8_BAR;
    if constexpr (Epi::AFTER_DRAIN) { E.fused(acc, cur, wr, wc, fr, fq, lds, wid, lane); S.done(cur); }
#undef PG8_SA
#undef PG8_SB
#undef PG8_STAGE
#undef PG8_LDA
#undef PG8_LDB
#undef PG8_MMA
#undef PG8_WAIT_V
#undef PG8_WAIT_L
#undef PG8_BAR
#undef PG8_SCHED
}
}

#define XB_TMO      128
#define XB_XCNT(j)  (256  + 64 * (j))
#define XB_XSUB(j)  (1280 + 64 * (j))
#define XB_XGEN(j)  (2304 + 64 * (j))
#define XB_TOP      3328
#define XB_TOPGEN   3392
#define XCD_BAR_WORDS 3456
#define XB_SPIN_CAP (1u << 18)

__device__ __forceinline__ unsigned xb_ld(unsigned* p)              { return __hip_atomic_load(p, __ATOMIC_RELAXED, __HIP_MEMORY_SCOPE_AGENT); }
__device__ __forceinline__ unsigned xb_add(unsigned* p, unsigned v) { return __hip_atomic_fetch_add(p, v, __ATOMIC_RELAXED, __HIP_MEMORY_SCOPE_AGENT); }
__device__ __forceinline__ unsigned xb_xcc_id() { return (unsigned)__builtin_amdgcn_s_getreg((3 << 11) | 20) & 0xFu; }
#define XB_SPIN(cond, bar) do { unsigned _sp = 0; while (cond) { __builtin_amdgcn_s_sleep(1); \
    if ((++_sp & 255u) == 0u) { if (xb_ld(&(bar)[XB_TMO])) break; if (_sp > XB_SPIN_CAP) { atomicAdd(&(bar)[XB_TMO], 1u); break; } } } } while (0)

struct XcdBarrier {
    unsigned* bar; unsigned x;
    volatile LAS unsigned* st;
};

__device__ __forceinline__ XcdBarrier xcd_barrier_post(unsigned* bar, volatile LAS unsigned* st) {
    XcdBarrier b; b.bar = bar; b.x = xb_xcc_id(); b.st = st;
    if (threadIdx.x == 0) (void)xb_add(&bar[XB_XCNT(b.x)], 1u);
    return b;
}
__device__ __forceinline__ void xcd_barrier_complete(unsigned* bar, unsigned x, unsigned& nloc, unsigned& nx) {
    const unsigned G = gridDim.x * gridDim.y * gridDim.z;
    unsigned sum, cnt, mine, sp = 0u;
    for (;;) {
        sum = 0u; cnt = 0u; mine = 0u;
#pragma unroll
        for (unsigned j = 0; j < 16; ++j) { const unsigned c = xb_ld(&bar[XB_XCNT(j)]); sum += c; cnt += (c > 0u) ? 1u : 0u; mine = (j == x) ? c : mine; }
        if (sum == G) break;
        __builtin_amdgcn_s_sleep(1);
        if ((++sp & 255u) == 0u) { if (xb_ld(&bar[XB_TMO])) break; if (sp > XB_SPIN_CAP) { atomicAdd(&bar[XB_TMO], 1u); break; } }
    }
    nloc = mine > 0u ? mine : 1u; nx = cnt > 0u ? cnt : 1u;
}

__device__ __forceinline__ void xcd_barrier(const XcdBarrier& b) {
    asm volatile("s_waitcnt vmcnt(0)" ::: "memory");
    __syncthreads();
    if (threadIdx.x == 0) {
        unsigned* bar = b.bar;
        __builtin_amdgcn_s_waitcnt(0);
        unsigned nloc = b.st[0], nx = b.st[1];
        if (nloc == 0u) { xcd_barrier_complete(bar, b.x, nloc, nx); b.st[0] = nloc; b.st[1] = nx; }
        const unsigned old = xb_add(&bar[XB_XSUB(b.x)], 1u);
        const unsigned gen = old / nloc;
        if (old + 1u == (gen + 1u) * nloc) {
            __builtin_amdgcn_fence(__ATOMIC_RELEASE, "agent");
            asm volatile("s_waitcnt vmcnt(0)" ::: "memory");
            const unsigned og = xb_add(&bar[XB_TOP], 1u);
            const unsigned tg = og / nx;
            if (og + 1u == (tg + 1u) * nx) xb_add(&bar[XB_TOPGEN], 1u);
            else XB_SPIN(xb_ld(&bar[XB_TOPGEN]) == tg, bar);
            __builtin_amdgcn_fence(__ATOMIC_ACQUIRE, "agent");
            xb_add(&bar[XB_XGEN(b.x)], 1u);
            asm volatile("s_waitcnt vmcnt(0)" ::: "memory");
        } else {
            XB_SPIN(xb_ld(&bar[XB_XGEN(b.x)]) == gen, bar);
            __builtin_amdgcn_fence(__ATOMIC_ACQUIRE, "agent");
            asm volatile("s_waitcnt vmcnt(0)" ::: "memory");
        }
    }
    __syncthreads();
}

struct Args { const float* in[N_IN]; float* out; unsigned char* ws; int ph_lo, ph_hi; };
struct Frame {
    LAS unsigned char* lds;
    int tid, lane, wave, bid, G;
    unsigned long long pacc, pt0;
    const float* in[N_IN];
    float* out; unsigned char* ws;
};
#define probe_acc F.pacc
#define probe_t0 F.pt0
#define WSP(T, off) ((T*)(F.ws + (off)))
#define OUTB(T, off) ((T*)((unsigned char*)F.out + (off)))

__device__ __forceinline__ void transpose_item(const float* W, int K, int N, bf16* WT, int dst_row0, int k0, int n0, LAS float* scr, int lane) {
    float wv[32];
#pragma unroll
    for (int i = 0; i < 32; ++i) { const int kk = 2 * i + (lane >> 5), n = n0 + (lane & 31); wv[i] = n < N ? W[(size_t)(k0 + kk) * N + n] : 0.f; }
#pragma unroll
    for (int i = 0; i < 32; ++i) { const int kk = 2 * i + (lane >> 5); scr[kk * 33 + (lane & 31)] = wv[i]; }
    LDS_WAIT(); asm volatile("" ::: "memory");
    const int c = lane & 7;
#pragma unroll
    for (int j = 0; j < 4; ++j) { const int n = (lane >> 3) + 8 * j; const LAS float* s = scr + (8 * c) * 33 + n;
        u32x4 o; o.x = pk2(s[0 * 33], s[1 * 33]); o.y = pk2(s[2 * 33], s[3 * 33]); o.z = pk2(s[4 * 33], s[5 * 33]); o.w = pk2(s[6 * 33], s[7 * 33]);
        *(u32x4*)(WT + (size_t)(dst_row0 + n) * K + k0 + 8 * c) = o; }
    LDS_WAIT(); asm volatile("" ::: "memory");
}

__device__ __forceinline__ void p0_prologue(Frame& F) {
    const int gw = F.bid * NWAVES + F.wave, NGW = F.G * NWAVES;
    {
        LAS float* scr = (LAS float*)(F.lds + 49152 + F.wave * 8704);
        constexpr int NB = NPAD / 32, NITEMS = 16 * NB;
        for (int it = gw; it < NITEMS; it += NGW) { const int kb = it / NB, nb = it % NB; transpose_item(F.in[I_WIN], 1024, DPROJ, WSP(bf16, WS_WIN), 32 * nb, 64 * kb, 32 * nb, scr, F.lane); }
    }
    {
        LAS float* sc = (LAS float*)F.lds;
        LAS float* red = (LAS float*)(F.lds + 20480);
        for (int idx = F.tid; idx < 5 * 1024; idx += NTHR) { const int r = idx >> 10, k = idx & 1023; const float v = r == 0 ? F.in[I_CCTX][k] : F.in[I_C][(r - 1) * 1024 + k]; sc[idx] = siluf(v); }
        __syncthreads();
        const float* wada = F.in[I_WADA]; const float* bada = F.in[I_BADA]; float* mod = WSP(float, WS_MOD);
        for (int it = F.bid; it < 256; it += F.G) {
            const int kg = it >> 3, cg = it & 7, c4 = F.tid % 192, rh = F.tid / 192;
            float acc[5][4];
#pragma unroll
            for (int r = 0; r < 5; ++r)
#pragma unroll
                for (int e = 0; e < 4; ++e) acc[r][e] = 0.f;
            if (rh < 2) {
                const float* wp = wada + (size_t)(32 * kg + 16 * rh) * 6144 + 768 * cg + 4 * c4;
                f32x4 wr[16];
#pragma unroll
                for (int kk = 0; kk < 16; ++kk) wr[kk] = *(const f32x4*)(wp + (size_t)kk * 6144);
#pragma unroll
                for (int kk = 0; kk < 16; ++kk) {
                    const f32x4 w = wr[kk];
                    const int k = 32 * kg + 16 * rh + kk;
#pragma unroll
                    for (int r = 0; r < 5; ++r) { const float s = sc[r * 1024 + k]; acc[r][0] += s * w.x; acc[r][1] += s * w.y; acc[r][2] += s * w.z; acc[r][3] += s * w.w; }
                }
            }
            if (rh == 1) {
#pragma unroll
                for (int r = 0; r < 5; ++r)
#pragma unroll
                    for (int e = 0; e < 4; ++e) red[c4 * 20 + r * 4 + e] = acc[r][e];
            }
            __syncthreads();
            if (rh == 0) {
                const int col = 768 * cg + 4 * c4;
#pragma unroll
                for (int r = 0; r < 5; ++r)
#pragma unroll
                    for (int e = 0; e < 4; ++e) { float v = acc[r][e] + red[c4 * 20 + r * 4 + e]; if (kg == 0) v += bada[col + e]; atomicAdd(mod + r * 6144 + col + e, v); }
            }
            __syncthreads();
        }
    }
}

template <bool XBF>
__device__ __forceinline__ void modnorm_rows(Frame& F, const float* x0, const float* x1, const bf16* xb, const float* nw, int sh_off, int sc_off, bf16* H) {
    const int gw = F.bid * NWAVES + F.wave, NGW = F.G * NWAVES;
    const float* mod = WSP(float, WS_MOD);
    f32x4 v[2][4], vn[2][4];
#define MN_LOAD(dst, M0) do { _Pragma("unroll") for (int u = 0; u < 2; ++u) { const int m_ = (M0) + u * NGW; if (m_ < NT) { \
        if (XBF) { _Pragma("unroll") for (int j = 0; j < 4; ++j) { const u32x2 w_ = *(const u32x2*)(xb + (size_t)m_ * DM + 4 * F.lane + 256 * j); dst[u][j] = (f32x4){bflo(w_.x), bfhi(w_.x), bflo(w_.y), bfhi(w_.y)}; } } \
        else { const float* xr_ = m_ < NCTX ? x0 + (size_t)m_ * DM : x1 + (size_t)(m_ - NCTX) * DM; \
        _Pragma("unroll") for (int j = 0; j < 4; ++j) dst[u][j] = *(const f32x4*)(xr_ + 4 * F.lane + 256 * j); } } } } while (0)
    MN_LOAD(vn, gw);
    for (int m0 = gw; m0 < NT; m0 += 2 * NGW) {
#pragma unroll
        for (int u = 0; u < 2; ++u)
#pragma unroll
            for (int j = 0; j < 4; ++j) v[u][j] = vn[u][j];
        if (m0 + 2 * NGW < NT) MN_LOAD(vn, m0 + 2 * NGW);
#pragma unroll
        for (int u = 0; u < 2; ++u) { const int m = m0 + u * NGW; if (m < NT) {
            const int mr = m < NCTX ? 0 : 1 + ((m - NCTX) >> 12);
            const float* mp = mod + (size_t)mr * 6144;
            float s = 0.f;
#pragma unroll
            for (int j = 0; j < 4; ++j) s += (v[u][j].x * v[u][j].x + v[u][j].y * v[u][j].y) + (v[u][j].z * v[u][j].z + v[u][j].w * v[u][j].w);
            const float rstd = __builtin_amdgcn_rsqf(wave_sum(s) * (1.f / DM) + EPS);
#pragma unroll
            for (int j = 0; j < 4; ++j) {
                const int c = 4 * F.lane + 256 * j;
                const f32x4 w = *(const f32x4*)(nw + c), sc = *(const f32x4*)(mp + sc_off + c), sh = *(const f32x4*)(mp + sh_off + c);
                const f32x4 h = (v[u][j] * rstd * w) * (sc + 1.f) + sh;
                u32x2 o; o.x = pk2(h.x, h.y); o.y = pk2(h.z, h.w);
                *(u32x2*)(H + (size_t)m * DM + c) = o;
            } } }
    }
#undef MN_LOAD
}

__device__ __forceinline__ void final_norm(Frame& F) {
    const int gw = F.bid * NWAVES + F.wave, NGW = F.G * NWAVES;
    const float* nf = F.in[I_NF];
    f32x4 w[4];
#pragma unroll
    for (int j = 0; j < 4; ++j) w[j] = *(const f32x4*)(nf + 4 * F.lane + 256 * j);
    for (int m0 = gw; m0 < NT; m0 += 2 * NGW) {
        f32x4 v[2][4];
#pragma unroll
        for (int u = 0; u < 2; ++u) { const int m = m0 + u * NGW; if (m < NT) {
#pragma unroll
            for (int j = 0; j < 4; ++j) { const u32x2 w_ = *(const u32x2*)(WSP(bf16, WS_XR) + (size_t)m * DM + 4 * F.lane + 256 * j); v[u][j] = (f32x4){bflo(w_.x), bfhi(w_.x), bflo(w_.y), bfhi(w_.y)}; } } }
#pragma unroll
        for (int u = 0; u < 2; ++u) { const int m = m0 + u * NGW; if (m < NT) {
            float s = 0.f;
#pragma unroll
            for (int j = 0; j < 4; ++j) s += (v[u][j].x * v[u][j].x + v[u][j].y * v[u][j].y) + (v[u][j].z * v[u][j].z + v[u][j].w * v[u][j].w);
            const float rstd = __builtin_amdgcn_rsqf(wave_sum(s) * (1.f / DM) + EPS);
#pragma unroll
            for (int j = 0; j < 4; ++j) *(f32x4*)(F.out + (size_t)m * DM + 4 * F.lane + 256 * j) = v[u][j] * rstd * w[j]; } }
    }
}

__device__ __forceinline__ void late_weights(Frame& F, const int gw, const int NGW) {
    {
        LAS float* scr = (LAS float*)(F.lds + F.wave * 8704);
        constexpr int I_O = 16 * 32, I_G = 16 * 88, I_D = 44 * 32, NITEMS = I_O + 2 * I_G + I_D;
        for (int it = gw; it < NITEMS; it += NGW) {
            int r = it;
            if (r < I_O) { const int kb = r / 32, nb = r % 32; transpose_item(F.in[I_WOUT], 1024, 1024, WSP(bf16, WS_WOUT), 32 * nb, 64 * kb, 32 * nb, scr, F.lane); continue; } r -= I_O;
            if (r < I_G) { const int kb = r / 88, nb = r % 88, n0 = 32 * nb; transpose_item(F.in[I_WGATE], 1024, DFF, WSP(bf16, WS_WGU), 256 * (n0 >> 7) + (n0 & 127), 64 * kb, n0, scr, F.lane); continue; } r -= I_G;
            if (r < I_G) { const int kb = r / 88, nb = r % 88, n0 = 32 * nb; transpose_item(F.in[I_WUP], 1024, DFF, WSP(bf16, WS_WGU), 256 * (n0 >> 7) + 128 + (n0 & 127), 64 * kb, n0, scr, F.lane); continue; } r -= I_G;
            { const int kb = r / 32, nb = r % 32; transpose_item(F.in[I_WDOWN], DFF, 1024, WSP(bf16, WS_WDN), 32 * nb, 64 * kb, 32 * nb, scr, F.lane); }
        }
    }
}

__device__ __forceinline__ void p5_headnorm(Frame& F) {
    const int gw = F.bid * NWAVES + F.wave, NGW = F.G * NWAVES;
    const bf16* OA0 = OUTB(bf16, OUT_OA); const bf16* OA1 = OUTB(bf16, OUT_OA + 20 * MiB);
    const bf16* OB0 = WSP(bf16, WS_OB);   const bf16* OB1 = WSP(bf16, WS_OB + 20 * MiB);
    const bf16* AG = WSP(bf16, WS_AG);    const bf16* BZ = WSP(bf16, WS_BZ);
    bf16* Y = WSP(bf16, WS_YIN);
    const int half = F.lane >> 5, c = 16 * (F.lane & 31);
    const float* nw = (half ? F.in[I_GNORM] : F.in[I_HNORM]) + c;
    f32x4 wn[4];
#pragma unroll
    for (int q = 0; q < 4; ++q) wn[q] = *(const f32x4*)(nw + 4 * q);
    u32x4 ra[2], rb[2], rg[2], na[2], nb2[2], ng[2];
#define P5_LOAD(A, B, Gt, M) do { const size_t off_ = (size_t)(M) * 512 + c; \
        _Pragma("unroll") for (int q = 0; q < 2; ++q) { A[q] = *(const u32x4*)((half ? OB0 : OA0) + off_ + 8 * q); B[q] = *(const u32x4*)((half ? OB1 : OA1) + off_ + 8 * q); Gt[q] = *(const u32x4*)((half ? BZ : AG) + off_ + 8 * q); } } while (0)
    if (gw < NT) P5_LOAD(na, nb2, ng, gw);
    for (int m = gw; m < NT; m += NGW) {
#pragma unroll
        for (int q = 0; q < 2; ++q) { ra[q] = na[q]; rb[q] = nb2[q]; rg[q] = ng[q]; }
        if (m + NGW < NT) P5_LOAD(na, nb2, ng, m + NGW);
        float o[16]; float ss = 0.f;
#pragma unroll
        for (int q = 0; q < 2; ++q)
#pragma unroll
            for (int e = 0; e < 4; ++e) { o[8 * q + 2 * e] = bflo(ra[q][e]) + bflo(rb[q][e]); o[8 * q + 2 * e + 1] = bfhi(ra[q][e]) + bfhi(rb[q][e]); }
#pragma unroll
        for (int e = 0; e < 16; ++e) ss += o[e] * o[e];
        ss += __shfl_xor(ss, 1); ss += __shfl_xor(ss, 2); ss += __shfl_xor(ss, 4);
        const float rstd = __builtin_amdgcn_rsqf(ss * (1.f / 128.f) + EPS);
#pragma unroll
        for (int q = 0; q < 2; ++q) {
            float y[8];
#pragma unroll
            for (int e = 0; e < 4; ++e) { y[2 * e] = o[8 * q + 2 * e] * rstd * wn[2 * q + (e >> 1)][2 * (e & 1)] * bflo(rg[q][e]); y[2 * e + 1] = o[8 * q + 2 * e + 1] * rstd * wn[2 * q + (e >> 1)][2 * (e & 1) + 1] * bfhi(rg[q][e]); }
            u32x4 w; w.x = pk2(y[0], y[1]); w.y = pk2(y[2], y[3]); w.z = pk2(y[4], y[5]); w.w = pk2(y[6], y[7]);
            *(u32x4*)(Y + (size_t)m * DM + half * 512 + c + 8 * q) = w;
        }
    }
#undef P5_LOAD
}

__device__ __forceinline__ int uc_index(int s, int n, int h, int dir) { return ((chunk_base(s) + n) * 4 + h) * 2 + dir; }
__device__ __forceinline__ unsigned char* grec_ptr(Frame& F, int uc) { return uc < N1G ? F.ws + WS_I + (size_t)uc * GREC : (unsigned char*)F.out + OUT_GOVF + (size_t)(uc - N1G) * GREC; }
__device__ __forceinline__ unsigned char* hrec_ptr(Frame& F, int uc) { return F.ws + WS_I + (size_t)uc * HREC; }
__device__ __forceinline__ bool allowed(int dir, int t, int s) { return dir ? (s >= t) : (s <= t); }

__device__ __forceinline__ void write_qd_image(Frame& F, const LAS bf16* X, int pitch, const LAS float* rowscale, unsigned char* dst) {
    const int r = F.lane & 15, g = F.lane >> 4, mt = F.wave >> 1;
#pragma unroll
    for (int q = 0; q < 2; ++q) {
        const int ks = 2 * (F.wave & 1) + q, row = 16 * mt + r;
        const u32x2 a = *(const LAS u32x2*)(X + row * pitch + 32 * ks + 4 * g), b = *(const LAS u32x2*)(X + row * pitch + 32 * ks + 16 + 4 * g);
        u32x4 o;
        if (rowscale) { const float sc = rowscale[row];
            o.x = pk2(bflo(a.x) * sc, bfhi(a.x) * sc); o.y = pk2(bflo(a.y) * sc, bfhi(a.y) * sc); o.z = pk2(bflo(b.x) * sc, bfhi(b.x) * sc); o.w = pk2(bflo(b.y) * sc, bfhi(b.y) * sc);
        } else { o.x = a.x; o.y = a.y; o.z = b.x; o.w = b.y; }
        *(u32x4*)(dst + ((mt * 4 + ks) * 64 + F.lane) * 16) = o;
    }
}
__device__ __forceinline__ void write_at_image(Frame& F, const LAS bf16* KA, const LAS bf16* QB, int pitch, const LAS float* Cs, int dir, unsigned char* dst) {
    const int r = F.lane & 15, g = F.lane >> 4, mt = F.wave >> 1, ks2 = F.wave & 1;
    f32x4 a0 = {0.f, 0.f, 0.f, 0.f}, a1 = {0.f, 0.f, 0.f, 0.f};
#pragma unroll
    for (int kd = 0; kd < 4; ++kd) {
        const bf16x8 bq = as_frag(*(const LAS u32x4*)(QB + (16 * mt + r) * pitch + 32 * kd + 8 * g));
        const bf16x8 k0 = as_frag(*(const LAS u32x4*)(KA + (32 * ks2 + r) * pitch + 32 * kd + 8 * g));
        const bf16x8 k1 = as_frag(*(const LAS u32x4*)(KA + (32 * ks2 + 16 + r) * pitch + 32 * kd + 8 * g));
        a0 = mfma16(k0, bq, a0); a1 = mfma16(k1, bq, a1);
    }
    const int t = 16 * mt + r; const float ct = Cs ? Cs[t] : 0.f;
    f32x4 cs0 = {0.f, 0.f, 0.f, 0.f}, cs1 = {0.f, 0.f, 0.f, 0.f};
    if (Cs) { cs0 = *(const LAS f32x4*)(Cs + 32 * ks2 + 4 * g); cs1 = *(const LAS f32x4*)(Cs + 32 * ks2 + 16 + 4 * g); }
    float v[8];
#pragma unroll
    for (int j = 0; j < 8; ++j) {
        const int s = 32 * ks2 + kperm(g, j); const bool ok = allowed(dir, t, s);
        float x = (j < 4) ? a0[j & 3] : a1[j & 3];
        if (Cs) { const float e = __expf(ok ? ct - ((j < 4) ? cs0[j & 3] : cs1[j & 3]) : 0.f); x *= e; }
        v[j] = ok ? x : 0.f;
    }
    u32x4 o; o.x = pk2(v[0], v[1]); o.y = pk2(v[2], v[3]); o.z = pk2(v[4], v[5]); o.w = pk2(v[6], v[7]);
    *(u32x4*)(dst + ((mt * 2 + ks2) * 64 + F.lane) * 16) = o;
}

__device__ __forceinline__ void p3h_load(Frame& F, int task, unsigned (&gw)[8], unsigned (&qw)[8], unsigned (&vw)[8]) {
    const int dir = task & 1, h = (task >> 1) & 3, cidx = task >> 3;
    int s, n; if (cidx < 64) { s = cidx >> 2; n = cidx & 3; } else { s = 16 + ((cidx - 64) >> 6); n = (cidx - 64) & 63; }
    const bf16* Gd = OUTB(bf16, dir ? OUT_GB : OUT_GF); const bf16* QA = OUTB(bf16, OUT_QA); const bf16* VA = OUTB(bf16, OUT_VA);
    const int c0 = 2 * (F.tid & 63), re = F.tid >> 6;
#pragma unroll
    for (int e = 0; e < 8; ++e) {
        const size_t off = (size_t)tok_a(s, n, 8 * re + e) * 512 + h * 128 + c0;
        gw[e] = *(const unsigned*)(Gd + off); qw[e] = *(const unsigned*)(QA + off);
        if (dir == ((task >> 8) & 1)) vw[e] = *(const unsigned*)(VA + off);
    }
}
__device__ __forceinline__ void p3_hgrn(Frame& F) {
    constexpr int PITCH = 136;
    LAS bf16* QDb = (LAS bf16*)(F.lds);
    LAS bf16* KDb = (LAS bf16*)(F.lds + 17408);
    LAS unsigned char* KTi = F.lds + 34816;
    LAS float* part = (LAS float*)(F.lds + 51200);
    LAS float* etot = (LAS float*)(F.lds + 55296);
    LAS bf16* Vb = (LAS bf16*)(F.lds + 56320);
    unsigned ngw[8], nqw[8], nvw[8];
    if (F.bid < NUC) p3h_load(F, F.bid, ngw, nqw, nvw);
    for (int task = F.bid; task < NUC; task += F.G) {
        const int dir = task & 1, h = (task >> 1) & 3, cidx = task >> 3;
        int s, n; if (cidx < 64) { s = cidx >> 2; n = cidx & 3; } else { s = 16 + ((cidx - 64) >> 6); n = (cidx - 64) & 63; }
        PROBE_BEGIN(61);
        unsigned char* rec = hrec_ptr(F, task);
        const int cp = F.tid & 63, re = F.tid >> 6, c0 = 2 * cp;
        float f0[8], f1[8], q0[8], q1[8], p0[8], p1[8];
#pragma unroll
        for (int e = 0; e < 8; ++e) {
            f0[e] = __expf(bflo(ngw[e])); f1[e] = __expf(bfhi(ngw[e])); q0[e] = bflo(nqw[e]); q1[e] = bfhi(nqw[e]);
            if (dir == ((task >> 8) & 1)) *(LAS unsigned*)(Vb + (8 * re + e) * PITCH + c0) = nvw[e];
        }
        if (task + F.G < NUC) p3h_load(F, task + F.G, ngw, nqw, nvw);
        if (dir == 0) { float a = 1.f, b = 1.f;
#pragma unroll
            for (int e = 0; e < 8; ++e) { a *= f0[e]; b *= f1[e]; p0[e] = a; p1[e] = b; }
            part[re * 128 + c0] = a; part[re * 128 + c0 + 1] = b;
        } else { float a = 1.f, b = 1.f;
#pragma unroll
            for (int e = 7; e >= 0; --e) { a *= f0[e]; b *= f1[e]; p0[e] = a; p1[e] = b; }
            part[re * 128 + c0] = a; part[re * 128 + c0 + 1] = b;
        }
        __syncthreads();
        PROBE_END(61); PROBE_BEGIN(62);
        float o0 = 1.f, o1 = 1.f, t0 = 1.f, t1 = 1.f;
#pragma unroll
        for (int r2 = 0; r2 < 8; ++r2) { const float a = part[r2 * 128 + c0], b = part[r2 * 128 + c0 + 1]; t0 *= a; t1 *= b; const bool pre = dir ? (r2 > re) : (r2 < re); if (pre) { o0 *= a; o1 *= b; } }
        if (re == 0) { etot[c0] = t0; etot[c0 + 1] = t1; }
        float kt0[8], kt1[8];
#pragma unroll
        for (int e = 0; e < 8; ++e) {
            const float E0 = o0 * p0[e], E1 = o1 * p1[e];
            const float k0 = 1.f - f0[e], k1 = 1.f - f1[e];
            const float kd0 = k0 * __builtin_amdgcn_rcpf(E0), kd1 = k1 * __builtin_amdgcn_rcpf(E1);
            const int row = 8 * re + e;
            *(LAS unsigned*)(QDb + row * PITCH + c0) = pk2(q0[e] * E0, q1[e] * E1);
            *(LAS unsigned*)(KDb + row * PITCH + c0) = pk2(kd0, kd1);
            kt0[e] = kd0 * t0; kt1[e] = kd1 * t1;
        }
        {
            const int ks = re >> 2, hf = (re >> 1) & 1;
#pragma unroll
            for (int cc = 0; cc < 2; ++cc) {
                const int c = c0 + cc, kt = c >> 4, r = c & 15;
#pragma unroll
                for (int p = 0; p < 2; ++p) {
                    const int g = 2 * (re & 1) + p;
                    u32x2 w;
                    if (cc == 0) { w.x = pk2(kt0[4 * p], kt0[4 * p + 1]); w.y = pk2(kt0[4 * p + 2], kt0[4 * p + 3]); } else { w.x = pk2(kt1[4 * p], kt1[4 * p + 1]); w.y = pk2(kt1[4 * p + 2], kt1[4 * p + 3]); }
                    *(LAS u32x2*)(KTi + ((kt * 2 + ks) * 64 + g * 16 + r) * 16 + 8 * hf) = w;
                }
            }
        }
        __syncthreads();
        PROBE_END(62); PROBE_BEGIN(63);
        write_qd_image(F, QDb, PITCH, nullptr, rec);
        write_at_image(F, KDb, QDb, PITCH, nullptr, dir, rec + 16384);
        for (int i = F.tid; i < 1024; i += NTHR) *(u32x4*)(rec + 24576 + i * 16) = *(const LAS u32x4*)(KTi + i * 16);
        if (F.tid < 32) *(f32x4*)(rec + 40960 + F.tid * 16) = *(const LAS f32x4*)((LAS unsigned char*)etot + F.tid * 16);
        if (dir == ((task >> 8) & 1)) {
            unsigned char* vb = F.ws + WS_HVB + (size_t)(task >> 1) * 16384;
            const int c = F.lane & 15, g = F.lane >> 4, w = F.wave;
#pragma unroll
            for (int ks2 = 0; ks2 < 2; ++ks2) {
                unsigned short x[8];
#pragma unroll
                for (int j = 0; j < 8; ++j) x[j] = Vb[(32 * ks2 + kperm(g, j)) * PITCH + 16 * w + c];
                u32x4 o; o.x = x[0] | ((unsigned)x[1] << 16); o.y = x[2] | ((unsigned)x[3] << 16); o.z = x[4] | ((unsigned)x[5] << 16); o.w = x[6] | ((unsigned)x[7] << 16);
                *(u32x4*)(vb + ((w * 2 + ks2) * 64 + F.lane) * 16) = o;
            }
        }
        __syncthreads();
        PROBE_END(63);
    }
}

__device__ __forceinline__ int lp_rowoff(int a) { if (a == 0) return 0; const int A = a - 1, m = A >> 2, r = A & 3; return 8 * m * (m + 1) + 4 * r * (m + 1); }

__device__ __forceinline__ void p3g_invert(LAS float* Lp, int dir, int lane) {
    float T[64];
    const int j = lane;
#pragma unroll
    for (int t = 0; t < 64; ++t) {
        float a0 = 0.f, a1 = 0.f, a2 = 0.f, a3 = 0.f;
        const LAS float* lrow = Lp + lp_rowoff(t);
#pragma unroll
        for (int s4 = 0; s4 < (t + 3) / 4; ++s4) {
            const f32x4 l = *(const LAS f32x4*)(lrow + 4 * s4);
            if (4 * s4 + 0 < t) a0 += l[0] * T[4 * s4 + 0];
            if (4 * s4 + 1 < t) a1 += l[1] * T[4 * s4 + 1];
            if (4 * s4 + 2 < t) a2 += l[2] * T[4 * s4 + 2];
            if (4 * s4 + 3 < t) a3 += l[3] * T[4 * s4 + 3];
        }
        int jj = j; asm volatile("" : "+v"(jj));
        T[t] = (t == jj ? 1.f : 0.f) - ((a0 + a1) + (a2 + a3));
        asm volatile("" ::: "memory");
    }
    LAS bf16* Tb = (LAS bf16*)Lp;
    if (dir == 0) { LAS bf16* tp = Tb + j;
#pragma unroll
        for (int t = 0; t < 64; ++t) tp[t * 72] = (bf16)f2bf(T[t]);
    } else { LAS bf16* tp = Tb + (63 - j);
#pragma unroll
        for (int t = 0; t < 64; ++t) tp[(63 - t) * 72] = (bf16)f2bf(T[t]);
    }
}

__device__ __forceinline__ void p3g_load(Frame& F, int task, const bf16* BQ, const bf16* BK, const bf16* BV, const float* BETA, const float* GGp, u32x4 (&raw)[18], float& gbeta, float& ggate) {
    const int dir = task & 1, h = (task >> 1) & 3, cidx = task >> 3;
    int s, n; if (cidx < 64) { s = cidx >> 2; n = cidx & 3; } else { s = 16 + ((cidx - 64) >> 6); n = (cidx - 64) & 63; }
    const int i = F.tid >> 3, m = tok_b(s, n, i);
    int pos, len, dlt; if (s < 16) { pos = 64 * n + i; len = 256; dlt = 1; } else { pos = i; len = 64; dlt = 64; }
    const bool hasp = pos > 0, hasn = pos + 1 < len; const u32x4 zz = {0u, 0u, 0u, 0u};
#pragma unroll
    for (int a = 0; a < 3; ++a) {
        const bf16* src = (a == 0 ? BQ : (a == 1 ? BK : BV)) + (size_t)m * 512 + h * 128 + 16 * (F.tid & 7);
#pragma unroll
        for (int q = 0; q < 2; ++q) {
            raw[a * 6 + q * 3 + 0] = hasp ? *(const u32x4*)(src - (ptrdiff_t)dlt * 512 + 8 * q) : zz;
            raw[a * 6 + q * 3 + 1] = *(const u32x4*)(src + 8 * q);
            raw[a * 6 + q * 3 + 2] = hasn ? *(const u32x4*)(src + (ptrdiff_t)dlt * 512 + 8 * q) : zz;
        }
    }
    if (F.wave == 0) { const int mg = tok_b(s, n, F.lane); gbeta = BETA[(size_t)mg * 8 + dir * 4 + h]; ggate = GGp[(size_t)mg * 8 + dir * 4 + h]; }
}

__device__ __forceinline__ void p3_gdn(Frame& F, const int t0, const int tn, const int rank, const int nranks) {
    constexpr int PITCH = 136, TP = 72, NBMAX = 10, LSLOT = 9216;
    LAS unsigned char* slots = F.lds + 40960;
    LAS float* Cs = (LAS float*)(F.lds + 512);
    LAS float* Bs = Cs + 64;
    LAS float* Es = Cs + 128;
    LAS float* Ets = Cs + 192;
    LAS float* Sc = Cs + 256;
    LAS bf16* Qb = (LAS bf16*)(F.lds + 2048);
    LAS bf16* Kb = (LAS bf16*)(F.lds + 19456);
    LAS bf16* VT = (LAS bf16*)(F.lds + 2048);
    LAS bf16* KGT = (LAS bf16*)(F.lds + 20480);
    LAS float* Wc = (LAS float*)(F.lds + 133120);
    int wc_head = -1;
    const bf16* BQ = WSP(bf16, WS_BQ); const bf16* BK = WSP(bf16, WS_BK); const bf16* BV = WSP(bf16, WS_BV);
    const float* BETA = WSP(float, WS_BETA); const float* GGp = WSP(float, WS_GG);
    const float* convw = F.in[I_CONV];
    const int ntask = rank < tn ? (tn - rank + nranks - 1) / nranks : 0;
    for (int b0 = 0; b0 < ntask; b0 += NBMAX) {
      const int nb = ntask - b0 < NBMAX ? ntask - b0 : NBMAX;
      PROBE_BEGIN(51);
      u32x4 raw[18]; float gbeta = 0.f, ggate = 0.f;
#define P3G_LOAD(JT) p3g_load(F, t0 + rank + (b0 + (JT)) * nranks, BQ, BK, BV, BETA, GGp, raw, gbeta, ggate)
      if (nb > 0) P3G_LOAD(0);
      for (int jt = 0; jt < nb; ++jt) {
        const int task = t0 + rank + (b0 + jt) * nranks;
        const int dir = task & 1, h = (task >> 1) & 3, cidx = task >> 3;
        int s, n; if (cidx < 64) { s = cidx >> 2; n = cidx & 3; } else { s = 16 + ((cidx - 64) >> 6); n = (cidx - 64) & 63; }
        unsigned char* rec = grec_ptr(F, task);
        LAS float* Lp = (LAS float*)(slots + jt * LSLOT);
        if (h != wc_head) {
            __syncthreads();
            for (int idx = F.tid; idx < 1152; idx += NTHR) { const int a = idx / 384, r2 = idx % 384, tap = r2 >> 7, ch = r2 & 127; Wc[idx] = convw[tap * 1536 + a * 512 + h * 128 + ch]; }
            wc_head = h;
        }
        PROBE_BEGIN(54);
        if (F.wave == 0) {
            const float beta = gbeta;
            float c = ggate;
#pragma unroll
            for (int d = 1; d < 64; d <<= 1) { const float o = dir ? __shfl_down(c, d) : __shfl_up(c, d); const bool ok = dir ? (F.lane + d < 64) : (F.lane >= d); c += ok ? o : 0.f; }
            const float ctot = __shfl(c, dir ? 0 : 63);
            Cs[F.lane] = c; Bs[F.lane] = beta; Es[F.lane] = __expf(c); Ets[F.lane] = __expf(ctot - c);
            if (F.lane == 0) Sc[0] = __expf(ctot);
        }
        __syncthreads();
        PROBE_END(54); PROBE_BEGIN(55);
        {
            const int i = F.tid >> 3, seg = F.tid & 7, ch0 = 16 * seg;
            const float beta = Bs[i], kg = -beta * Es[i];
#pragma unroll
            for (int a = 0; a < 3; ++a) {
                float val[16];
                const LAS float* wc = Wc + a * 384 + ch0;
#pragma unroll
                for (int q = 0; q < 2; ++q) {
                    const u32x4 xm = raw[a * 6 + q * 3 + 0], x0 = raw[a * 6 + q * 3 + 1], xp = raw[a * 6 + q * 3 + 2];
                    f32x4 w0[2], w1[2], w2[2];
#pragma unroll
                    for (int hh = 0; hh < 2; ++hh) { w0[hh] = *(const LAS f32x4*)(wc + 8 * q + 4 * hh); w1[hh] = *(const LAS f32x4*)(wc + 128 + 8 * q + 4 * hh); w2[hh] = *(const LAS f32x4*)(wc + 256 + 8 * q + 4 * hh); }
#pragma unroll
                    for (int e = 0; e < 4; ++e) {
                        const int ch = 8 * q + 2 * e, hh = e >> 1, ee = 2 * (e & 1);
                        const float y0 = bflo(xm[e]) * w0[hh][ee] + bflo(x0[e]) * w1[hh][ee] + bflo(xp[e]) * w2[hh][ee];
                        const float y1 = bfhi(xm[e]) * w0[hh][ee + 1] + bfhi(x0[e]) * w1[hh][ee + 1] + bfhi(xp[e]) * w2[hh][ee + 1];
                        val[ch] = siluf(y0); val[ch + 1] = siluf(y1);
                    }
                }
                if (a < 2) {
                    float ss = 0.f;
#pragma unroll
                    for (int e = 0; e < 16; ++e) ss += val[e] * val[e];
                    ss += __shfl_xor(ss, 1); ss += __shfl_xor(ss, 2); ss += __shfl_xor(ss, 4);
                    const float rn = __builtin_amdgcn_rsqf(ss + EPS) * (a == 0 ? 0.08838834764831845f : 1.f);
                    unsigned pw[8];
#pragma unroll
                    for (int e = 0; e < 8; ++e) pw[e] = pk2(val[2 * e] * rn, val[2 * e + 1] * rn);
                    LAS bf16* dstp = (a == 0 ? Qb : Kb) + i * PITCH + ch0;
                    *(LAS u32x4*)(dstp) = (u32x4){pw[0], pw[1], pw[2], pw[3]}; *(LAS u32x4*)(dstp + 8) = (u32x4){pw[4], pw[5], pw[6], pw[7]};
                    if (a == 1) {
                        unsigned gw[8];
#pragma unroll
                        for (int e = 0; e < 8; ++e) gw[e] = pk2(kg * val[2 * e] * rn, kg * val[2 * e + 1] * rn);
                        u32x4* gp = (u32x4*)(rec + L_WN + (i * 128 + ch0) * 2);
                        gp[0] = (u32x4){gw[0], gw[1], gw[2], gw[3]}; gp[1] = (u32x4){gw[4], gw[5], gw[6], gw[7]};
                    }
                } else {
                    unsigned vw[8];
#pragma unroll
                    for (int e = 0; e < 8; ++e) vw[e] = pk2(beta * val[2 * e], beta * val[2 * e + 1]);
                    u32x4* vp = (u32x4*)(rec + L_U + (i * 128 + ch0) * 2);
                    vp[0] = (u32x4){vw[0], vw[1], vw[2], vw[3]}; vp[1] = (u32x4){vw[4], vw[5], vw[6], vw[7]};
                }
                asm volatile("" ::: "memory");
            }
            if (jt + 1 < nb) P3G_LOAD(jt + 1);
        }
        PROBE_END(55); PROBE_BEGIN(56);
        __syncthreads();
        {
            const int r = F.lane & 15, g = F.lane >> 4, tt = F.wave >> 1, sp = F.wave & 1;
            f32x4 a0 = {0.f, 0.f, 0.f, 0.f}, a1 = {0.f, 0.f, 0.f, 0.f};
#pragma unroll
            for (int kd = 0; kd < 4; ++kd) {
                const bf16x8 at = as_frag(*(const LAS u32x4*)(Kb + (16 * tt + r) * PITCH + 32 * kd + 8 * g));
                const bf16x8 b0 = as_frag(*(const LAS u32x4*)(Kb + (32 * sp + r) * PITCH + 32 * kd + 8 * g));
                const bf16x8 b1 = as_frag(*(const LAS u32x4*)(Kb + (32 * sp + 16 + r) * PITCH + 32 * kd + 8 * g));
                a0 = mfma16(at, b0, a0); a1 = mfma16(at, b1, a1);
            }
            const f32x4 ct4 = *(const LAS f32x4*)(Cs + 16 * tt + 4 * g), bt4 = *(const LAS f32x4*)(Bs + 16 * tt + 4 * g);
            const float csx0 = Cs[32 * sp + r], csx1 = Cs[32 * sp + 16 + r];
#pragma unroll
            for (int q = 0; q < 2; ++q)
#pragma unroll
                for (int i = 0; i < 4; ++i) {
                    const int t = 16 * tt + 4 * g + i, sx = 32 * sp + 16 * q + r;
                    const bool ok = dir ? (sx > t) : (sx < t);
                    const float v = bt4[i] * (q ? a1[i] : a0[i]) * __expf(ok ? ct4[i] - (q ? csx1 : csx0) : 0.f);
                    const int a = dir ? 63 - t : t, b = dir ? 63 - sx : sx;
                    if (ok) Lp[lp_rowoff(a) + b] = v;
                }
        }
        write_at_image(F, Kb, Qb, PITCH, Cs, dir, rec + L_AT);
        write_qd_image(F, Qb, PITCH, Es, rec + L_QD);
        {
            const int r = F.lane & 15, g = F.lane >> 4, kt = F.wave;
#pragma unroll
            for (int ks2 = 0; ks2 < 2; ++ks2) {
                float v[8];
                const f32x4 e0 = *(const LAS f32x4*)(Ets + 32 * ks2 + 4 * g), e1 = *(const LAS f32x4*)(Ets + 32 * ks2 + 16 + 4 * g);
#pragma unroll
                for (int j = 0; j < 8; ++j) { const int sx = 32 * ks2 + kperm(g, j); v[j] = bf2f(Kb[sx * PITCH + 16 * kt + r]) * ((j < 4) ? e0[j & 3] : e1[j & 3]); }
                u32x4 o; o.x = pk2(v[0], v[1]); o.y = pk2(v[2], v[3]); o.z = pk2(v[4], v[5]); o.w = pk2(v[6], v[7]);
                *(u32x4*)(rec + L_KT + ((kt * 2 + ks2) * 64 + F.lane) * 16) = o;
            }
        }
        if (F.tid == 0) *(float*)(rec + L_SC) = Sc[0];
        __syncthreads();
        PROBE_END(56);
      }
#undef P3G_LOAD
      PROBE_END(51); PROBE_BEGIN(52);
      asm volatile("s_waitcnt vmcnt(0)" ::: "memory");
      for (int jt = F.wave; jt < nb; jt += NWAVES) { const int task = t0 + rank + (b0 + jt) * nranks; p3g_invert((LAS float*)(slots + jt * LSLOT), task & 1, F.lane); }
      __syncthreads();
      PROBE_END(52); PROBE_BEGIN(53);
      u32x4 pv[2], pk[2];
      { unsigned char* rec0 = grec_ptr(F, t0 + rank + b0 * nranks);
#pragma unroll
        for (int q = 0; q < 2; ++q) { const int p = F.lane * 16 + F.wave + 8 * q; pv[q] = *(const u32x4*)(rec0 + L_U + p * 16); pk[q] = *(const u32x4*)(rec0 + L_WN + p * 16); } }
      for (int jt = 0; jt < nb; ++jt) {
        const int task = t0 + rank + (b0 + jt) * nranks;
        unsigned char* rec = grec_ptr(F, task);
        const LAS bf16* Tm = (const LAS bf16*)(slots + jt * LSLOT);
        PROBE_BEGIN(57);
#pragma unroll
        for (int q = 0; q < 2; ++q) {
            const int i = F.lane, c8 = (F.wave + 8 * q) * 8;
            const u32x4 vv = pv[q], kk = pk[q];
            LAS bf16* vt = VT + c8 * TP + i; LAS bf16* kt = KGT + c8 * TP + i;
#pragma unroll
            for (int e = 0; e < 4; ++e) { vt[(2 * e) * TP] = (bf16)(vv[e] & 0xffffu); vt[(2 * e + 1) * TP] = (bf16)(vv[e] >> 16); kt[(2 * e) * TP] = (bf16)(kk[e] & 0xffffu); kt[(2 * e + 1) * TP] = (bf16)(kk[e] >> 16); }
        }
        if (jt + 1 < nb) { unsigned char* rec1 = grec_ptr(F, task + nranks);
#pragma unroll
            for (int q = 0; q < 2; ++q) { const int p = F.lane * 16 + F.wave + 8 * q; pv[q] = *(const u32x4*)(rec1 + L_U + p * 16); pk[q] = *(const u32x4*)(rec1 + L_WN + p * 16); } }
        __syncthreads();
        PROBE_END(57); PROBE_BEGIN(58);
        {
            const int r = F.lane & 15, g = F.lane >> 4;
            {
                const int w = F.wave;
                bf16x8 bv[2];
#pragma unroll
                for (int ks2 = 0; ks2 < 2; ++ks2) bv[ks2] = as_frag(*(const LAS u32x4*)(VT + (16 * w + r) * TP + 32 * ks2 + 8 * g));
#pragma unroll
                for (int mt = 0; mt < 4; ++mt) {
                    f32x4 a = {0.f, 0.f, 0.f, 0.f};
#pragma unroll
                    for (int ks2 = 0; ks2 < 2; ++ks2) a = mfma16(as_frag(*(const LAS u32x4*)(Tm + (16 * mt + r) * TP + 32 * ks2 + 8 * g)), bv[ks2], a);
                    u32x2 o; o.x = pk2(a[0], a[1]); o.y = pk2(a[2], a[3]);
                    *(u32x2*)(rec + L_U + ((w * 4 + mt) * 64 + F.lane) * 8) = o;
                }
            }
            {
                const int mt = F.wave >> 1;
                bf16x8 bt[2];
#pragma unroll
                for (int ks2 = 0; ks2 < 2; ++ks2) bt[ks2] = as_frag(*(const LAS u32x4*)(Tm + (16 * mt + r) * TP + 32 * ks2 + 8 * g));
#pragma unroll
                for (int q = 0; q < 2; ++q) {
                    const int ks = 2 * (F.wave & 1) + q;
                    f32x4 a0 = {0.f, 0.f, 0.f, 0.f}, a1 = {0.f, 0.f, 0.f, 0.f};
#pragma unroll
                    for (int ks2 = 0; ks2 < 2; ++ks2) {
                        a0 = mfma16(as_frag(*(const LAS u32x4*)(KGT + (32 * ks + r) * TP + 32 * ks2 + 8 * g)), bt[ks2], a0);
                        a1 = mfma16(as_frag(*(const LAS u32x4*)(KGT + (32 * ks + 16 + r) * TP + 32 * ks2 + 8 * g)), bt[ks2], a1);
                    }
                    u32x4 o; o.x = pk2(a0[0], a0[1]); o.y = pk2(a0[2], a0[3]); o.z = pk2(a1[0], a1[1]); o.w = pk2(a1[2], a1[3]);
                    *(u32x4*)(rec + L_WN + ((mt * 4 + ks) * 64 + F.lane) * 16) = o;
                }
            }
        }
        __syncthreads();
        PROBE_END(58);
      }
      PROBE_END(53);
    }
}

template <bool GDN>
__device__ __forceinline__ void p4_chain(Frame& F) {
    LAS unsigned char* img = F.lds;
    const int c = F.lane & 15, g = F.lane >> 4;
    const float* st_in = F.in[GDN ? I_SG : I_SH];
    float* st_out = F.out + OUT_Y_FLOATS + (GDN ? STATE_FLOATS : 0);
    bf16* Obase = GDN ? WSP(bf16, WS_OB) : OUTB(bf16, OUT_OA);
    constexpr int N16 = GDN ? GREC / 16 : HREC / 16;
    constexpr int NPC = ((GDN ? GREC : HREC) + 1023) / 1024;
    gu32* prog = (gu32*)(F.ws + WS_CTL) + (GDN ? CW_PROG_G : CW_PROG_H);
    const bool roles = (F.G == 256);
    if (roles && F.bid >= 64 && F.bid < 128) {
        const int hb = F.bid - 64, u = hb & 31, j0 = hb >> 5;
        const int s = 16 + (u >> 3), h = (u >> 1) & 3, dir = u & 1, N = 64;
        u32x4 dummy = {0u, 0u, 0u, 0u};
        for (int st = j0; st < N; st += 2) {
            for (unsigned sp = 0; sp < (1u << 15); ++sp) { const unsigned p = __hip_atomic_load(prog + 64 * u, RLX_AGENT); if ((int)p + P4_PD > st) break; __builtin_amdgcn_s_sleep(8); }
            const int n = dir ? N - 1 - st : st; const int uc = uc_index(s, n, h, dir);
            const unsigned char* rec = GDN ? grec_ptr(F, uc) : hrec_ptr(F, uc);
            for (int idx = F.tid; idx < N16; idx += NTHR) { const unsigned char* p = rec + (size_t)idx * 16; asm volatile("global_load_dwordx4 %0, %1, off" : "+v"(dummy) : "v"(p) : "memory"); }
            if (!GDN) { const unsigned char* vb = F.ws + WS_HVB + (size_t)(uc >> 1) * 16384;
                for (int idx = F.tid; idx < 1024; idx += NTHR) { const unsigned char* p = vb + (size_t)idx * 16; asm volatile("global_load_dwordx4 %0, %1, off" : "+v"(dummy) : "v"(p) : "memory"); } }
        }
        asm volatile("s_waitcnt vmcnt(0)" : "+v"(dummy) :: "memory");
        return;
    }
    for (int uidx0 = F.bid; uidx0 < (roles ? 256 : 160); uidx0 += F.G) {
        int uidx = uidx0, ncw = 8, sl0 = 0;
        if (roles) { if (uidx0 >= 128) uidx = uidx0 - 96; else { uidx = uidx0 & 31; ncw = 4; sl0 = 4 * (uidx0 >> 5); } }
        const bool lead = roles && uidx0 < 32;
        const int w = sl0 + F.wave; const bool comp = F.wave < ncw;
        const int dwn = ncw < 8 ? 8 - ncw : 8, dw0 = ncw < 8 ? F.wave - ncw : F.wave;
        int s, h, dir;
        if (uidx < 32) { s = 16 + (uidx >> 3); h = (uidx >> 1) & 3; dir = uidx & 1; } else { const int j = uidx - 32; s = j >> 3; h = (j >> 1) & 3; dir = j & 1; }
        const int N = seq_nchunk(s), bq = s < 16 ? s : s - 16;
        f32x4 S[8];
        if (!comp) {
#pragma unroll
            for (int kt = 0; kt < 8; ++kt) S[kt] = (f32x4){0.f, 0.f, 0.f, 0.f};
        } else if (s >= 16) {
            const float* sp = st_in + (size_t)((bq * 2 + dir) * 4 + h) * 16384 + 16 * w + c;
#pragma unroll
            for (int kt = 0; kt < 8; ++kt)
#pragma unroll
                for (int i = 0; i < 4; ++i) S[kt][i] = sp[(16 * kt + 4 * g + i) * 128];
        } else {
#pragma unroll
            for (int kt = 0; kt < 8; ++kt) S[kt] = (f32x4){0.f, 0.f, 0.f, 0.f};
        }
#define P4_DMA(STEP, BUF) do { \
            const int n_ = dir ? N - 1 - (STEP) : (STEP); const int uc_ = uc_index(s, n_, h, dir); \
            const unsigned char* rec_ = (GDN ? grec_ptr(F, uc_) : hrec_ptr(F, uc_)) + F.lane * 16; \
            LAS unsigned char* dst_ = F.lds + (BUF) * P4_BUF + (GDN ? 0 : L_QD); \
            for (int p = dw0; p < NPC; p += dwn) { if (GDN && ncw < 8 && (p >> 3) == 7 + (1 - (sl0 >> 2))) continue; __builtin_amdgcn_global_load_lds((const unsigned*)(rec_ + (size_t)p * 1024), (LAS unsigned*)(dst_ + p * 1024), 16, 0, 0); } \
            if (!GDN) { const unsigned char* vb_ = F.ws + WS_HVB + (size_t)(uc_ >> 1) * 16384 + F.lane * 16; LAS unsigned char* dv_ = F.lds + (BUF) * P4_BUF + L_WN; \
                for (int p = dw0; p < 16; p += dwn) { if (ncw < 8 && (p >> 3) == 1 - (sl0 >> 2)) continue; __builtin_amdgcn_global_load_lds((const unsigned*)(vb_ + (size_t)p * 1024), (LAS unsigned*)(dv_ + p * 1024), 16, 0, 0); } } \
        } while (0)
#define FRAG(off, idx) (*(const LAS u32x4*)(img + (off) + ((idx) * 64 + F.lane) * 16))
        if (dw0 >= 0) P4_DMA(0, 0);
        asm volatile("s_waitcnt vmcnt(0)" ::: "memory");
        __syncthreads();
        for (int step = 0; step < N; ++step) {
            PROBE_BEGIN(GDN ? 2 : 12);
            const int cur = step & 1;
            LAS unsigned char* img = F.lds + cur * P4_BUF;
            if (lead && F.tid == 0) __hip_atomic_store(prog + 64 * uidx, (unsigned)(step + 1), RLX_AGENT);
            PROBE_BEGIN(GDN ? 21 : 31);
            if (step + 1 < N && dw0 >= 0) P4_DMA(step + 1, cur ^ 1);
            PROBE_END(GDN ? 21 : 31);
            const int n = dir ? N - 1 - step : step;
            if (comp) {
            PROBE_BEGIN(GDN ? 22 : 32);
            bf16x8 Sb[4];
#pragma unroll
            for (int ks = 0; ks < 4; ++ks) { u32x4 o; o.x = pk2(S[2 * ks][0], S[2 * ks][1]); o.y = pk2(S[2 * ks][2], S[2 * ks][3]); o.z = pk2(S[2 * ks + 1][0], S[2 * ks + 1][1]); o.w = pk2(S[2 * ks + 1][2], S[2 * ks + 1][3]); Sb[ks] = as_frag(o); }
            bf16x8 Xb[2];
            u32x4 fa[8], fb[8];
            f32x4 O[4];
            if (GDN) {
                f32x4 X[4];
#pragma unroll
                for (int mt = 0; mt < 4; ++mt)
#pragma unroll
                    for (int k = 0; k < 2; ++k) fa[mt * 2 + k] = FRAG(L_WN, mt * 4 + k);
#pragma unroll
                for (int mt = 0; mt < 4; ++mt)
#pragma unroll
                    for (int k = 0; k < 2; ++k) fb[mt * 2 + k] = FRAG(L_WN, mt * 4 + 2 + k);
#pragma unroll
                for (int mt = 0; mt < 4; ++mt) { const u32x2 uu = *(const LAS u32x2*)(img + L_U + ((w * 4 + mt) * 64 + F.lane) * 8); X[mt] = (f32x4){bflo(uu.x), bfhi(uu.x), bflo(uu.y), bfhi(uu.y)}; }
#pragma unroll
                for (int k = 0; k < 2; ++k)
#pragma unroll
                    for (int mt = 0; mt < 4; ++mt) X[mt] = mfma16(as_frag(fa[mt * 2 + k]), Sb[k], X[mt]);
#pragma unroll
                for (int mt = 0; mt < 4; ++mt)
#pragma unroll
                    for (int k = 0; k < 2; ++k) fa[mt * 2 + k] = FRAG(L_QD, mt * 4 + k);
#pragma unroll
                for (int k = 0; k < 2; ++k)
#pragma unroll
                    for (int mt = 0; mt < 4; ++mt) X[mt] = mfma16(as_frag(fb[mt * 2 + k]), Sb[2 + k], X[mt]);
#pragma unroll
                for (int k2 = 0; k2 < 2; ++k2) { u32x4 o; o.x = pk2(X[2 * k2][0], X[2 * k2][1]); o.y = pk2(X[2 * k2][2], X[2 * k2][3]); o.z = pk2(X[2 * k2 + 1][0], X[2 * k2 + 1][1]); o.w = pk2(X[2 * k2 + 1][2], X[2 * k2 + 1][3]); Xb[k2] = as_frag(o); }
            } else {
#pragma unroll
                for (int k2 = 0; k2 < 2; ++k2) Xb[k2] = as_frag(FRAG(L_WN, w * 2 + k2));
#pragma unroll
                for (int mt = 0; mt < 4; ++mt)
#pragma unroll
                    for (int k = 0; k < 2; ++k) fa[mt * 2 + k] = FRAG(L_QD, mt * 4 + k);
            }
            PROBE_END(GDN ? 22 : 32); PROBE_BEGIN(GDN ? 23 : 33);
#pragma unroll
            for (int mt = 0; mt < 4; ++mt)
#pragma unroll
                for (int k = 0; k < 2; ++k) fb[mt * 2 + k] = FRAG(L_QD, mt * 4 + 2 + k);
#pragma unroll
            for (int mt = 0; mt < 4; ++mt) O[mt] = (f32x4){0.f, 0.f, 0.f, 0.f};
#pragma unroll
            for (int k = 0; k < 2; ++k)
#pragma unroll
                for (int mt = 0; mt < 4; ++mt) O[mt] = mfma16(Sb[k], as_frag(fa[mt * 2 + k]), O[mt]);
#pragma unroll
            for (int i = 0; i < 8; ++i) fa[i] = FRAG(L_AT, i);
#pragma unroll
            for (int k = 0; k < 2; ++k)
#pragma unroll
                for (int mt = 0; mt < 4; ++mt) O[mt] = mfma16(Sb[2 + k], as_frag(fb[mt * 2 + k]), O[mt]);
#pragma unroll
            for (int i = 0; i < 8; ++i) fb[i] = FRAG(L_KT, i);
#pragma unroll
            for (int k2 = 0; k2 < 2; ++k2)
#pragma unroll
                for (int mt = 0; mt < 4; ++mt) O[mt] = mfma16(Xb[k2], as_frag(fa[mt * 2 + k2]), O[mt]);
#pragma unroll
            for (int i = 0; i < 8; ++i) fa[i] = FRAG(L_KT, 8 + i);
            PROBE_END(GDN ? 23 : 33); PROBE_BEGIN(GDN ? 24 : 34);
            {
                f32x4 d[8];
                if (GDN) { const float ds = *(const LAS float*)(img + L_SC);
#pragma unroll
                    for (int kt = 0; kt < 8; ++kt) d[kt] = (f32x4){ds, ds, ds, ds}; }
                else {
#pragma unroll
                    for (int kt = 0; kt < 8; ++kt) d[kt] = *(const LAS f32x4*)(img + L_U + (16 * kt + 4 * g) * 4); }
#pragma unroll
                for (int kt = 0; kt < 8; ++kt) S[kt] = S[kt] * d[kt];
            }
#pragma unroll
            for (int k2 = 0; k2 < 2; ++k2)
#pragma unroll
                for (int kt = 0; kt < 4; ++kt) S[kt] = mfma16(as_frag(fb[kt * 2 + k2]), Xb[k2], S[kt]);
#pragma unroll
            for (int k2 = 0; k2 < 2; ++k2)
#pragma unroll
                for (int kt = 0; kt < 4; ++kt) S[4 + kt] = mfma16(as_frag(fa[kt * 2 + k2]), Xb[k2], S[4 + kt]);
            PROBE_END(GDN ? 24 : 34); PROBE_BEGIN(GDN ? 25 : 35);
#pragma unroll
            for (int mt = 0; mt < 4; ++mt) {
                const int li = 16 * mt + c;
                const int m = GDN ? tok_b(s, n, li) : tok_a(s, n, li);
                u32x2 o; o.x = pk2(O[mt][0], O[mt][1]); o.y = pk2(O[mt][2], O[mt][3]);
                *(u32x2*)(Obase + (size_t)dir * (10 * MiB) + (size_t)m * 512 + h * 128 + 16 * w + 4 * g) = o;
            }
            PROBE_END(GDN ? 25 : 35);
            }
            PROBE_END(GDN ? 2 : 12); PROBE_BEGIN(GDN ? 3 : 13);
            asm volatile("s_waitcnt vmcnt(0)" ::: "memory");
            __syncthreads();
            PROBE_END(GDN ? 3 : 13);
        }
#undef P4_DMA
#undef FRAG
        if (s < 16 && comp) {
            float* sp = st_out + (size_t)((bq * 2 + dir) * 4 + h) * 16384 + 16 * w + c;
#pragma unroll
            for (int kt = 0; kt < 8; ++kt)
#pragma unroll
                for (int i = 0; i < 4; ++i) sp[(16 * kt + 4 * g + i) * 128] = S[kt][i];
        }
    }
    if (GDN && roles && F.bid >= 128) { __syncthreads(); late_weights(F, (F.bid - 128) * NWAVES + F.wave, 128 * NWAVES); }
    if (!GDN && roles && F.bid >= 128) { __syncthreads(); p3_gdn(F, NUC - NR_EARLY, NR_EARLY, F.bid - 128, 128); }
}

constexpr int NPHASE = 13;
__global__ void __launch_bounds__(NTHR, 2) mk_fwd(Args args) {
    extern __shared__ __attribute__((aligned(16))) unsigned char lds_raw[];
    Frame F;
    F.lds = (LAS unsigned char*)lds_raw;
    F.tid = threadIdx.x; F.lane = F.tid & 63; F.wave = __builtin_amdgcn_readfirstlane(F.tid >> 6);
    F.bid = blockIdx.x; F.G = gridDim.x;
#pragma unroll
    for (int i = 0; i < N_IN; ++i) F.in[i] = args.in[i];
    F.out = args.out; F.ws = args.ws; F.pacc = 0ull; F.pt0 = 0ull;
    volatile LAS unsigned* MISC = (volatile LAS unsigned*)(F.lds + MISC_OFF);
    for (int u = F.tid; u < (LDS_BYTES - LDSCTL_OFF) / 4; u += NTHR) ((LAS unsigned*)(F.lds + LDSCTL_OFF))[u] = 0u;
    __syncthreads();
    const int lo = args.ph_lo, hi = args.ph_hi;
    const bool multi = (hi - lo) > 1;
    XcdBarrier bar; bar.bar = (unsigned*)(F.ws + WS_CTL) + CW_BAR; bar.x = 0; bar.st = nullptr;
    if (multi) bar = xcd_barrier_post((unsigned*)(F.ws + WS_CTL) + CW_BAR, MISC + 8);
#ifndef PH_MASK
#define PH_MASK 0x1fff
#endif
#define IN(k) (((PH_MASK >> (k)) & 1) && lo <= (k) && (k) < hi)
#define SEAM(k) do { if (IN(k) && IN((k) + 1)) xcd_barrier(bar); } while (0)
#define NREP(k) ((((REP_MASK) >> (k)) & 1) ? 2 : 1)
#define REPSYNC(k) do { if (((REP_MASK) >> (k)) & 1) xcd_barrier(bar); } while (0)

    PROBE_BEGIN(100);
    if (IN(0)) for (int rep = 0; rep < NREP(0); ++rep) { if (rep) REPSYNC(0); p0_prologue(F); } SEAM(0); PROBE_END(100);
    PROBE_BEGIN(101);
    if (IN(1)) for (int rep = 0; rep < NREP(1); ++rep) { if (rep) REPSYNC(1); modnorm_rows<false>(F, F.in[I_XP], F.in[I_XS], nullptr, F.in[I_N1], 0, 1024, WSP(bf16, WS_H)); } SEAM(1); PROBE_END(101);
    PROBE_BEGIN(102);
    if (IN(2)) for (int rep = 0; rep < NREP(2); ++rep) { if (rep) REPSYNC(2);
        pg8::Gemm g{WSP(bf16, WS_H), WSP(bf16, WS_WIN), NT, NPAD, DM}; pg8::StaticOrder S; S.init(NT, NPAD, DM, F.G, F.bid);
        pg8::EpiProj E;
        E.d0 = OUTB(bf16, OUT_QA); E.d1 = OUTB(bf16, OUT_GF); E.d2 = OUTB(bf16, OUT_GB); E.d3 = OUTB(bf16, OUT_VA); E.d4 = WSP(bf16, WS_AG);
        E.d5 = WSP(bf16, WS_BQ); E.d6 = WSP(bf16, WS_BK); E.d7 = WSP(bf16, WS_BV); E.d8 = WSP(bf16, WS_BZ);
        E.BETA = WSP(float, WS_BETA); E.GG = WSP(float, WS_GG); E.lbraw = F.in[I_LB]; E.Alog = F.in[I_ALOG]; E.dtb = F.in[I_DTB];
        pg8::gemm_phase<pg8::EpiProj, pg8::StaticOrder, true, true>(F.lds, g, S, E);
    } SEAM(2); PROBE_END(102);
    PROBE_BEGIN(103);
    if (IN(3)) for (int rep = 0; rep < NREP(3); ++rep) { if (rep) REPSYNC(3); p3_hgrn(F); } SEAM(3); PROBE_END(103);
    PROBE_BEGIN(104);
    if (IN(4)) for (int rep = 0; rep < NREP(4); ++rep) { if (rep) REPSYNC(4); p4_chain<false>(F); } SEAM(4); PROBE_END(104);
    PROBE_BEGIN(105);
    if (IN(5)) for (int rep = 0; rep < NREP(5); ++rep) { if (rep) REPSYNC(5); p3_gdn(F, 0, (F.G == 256) ? NUC - NR_EARLY : NUC, F.bid, F.G); } SEAM(5); PROBE_END(105);
    PROBE_BEGIN(106);
    if (IN(6)) for (int rep = 0; rep < NREP(6); ++rep) { if (rep) REPSYNC(6); p4_chain<true>(F); } SEAM(6); PROBE_END(106);
    PROBE_BEGIN(107);
    if (IN(7)) for (int rep = 0; rep < NREP(7); ++rep) { if (rep) REPSYNC(7); if (F.G != 256) late_weights(F, F.bid * NWAVES + F.wave, F.G * NWAVES); p5_headnorm(F); } SEAM(7); PROBE_END(107);
    PROBE_BEGIN(108);
    if (IN(8)) for (int rep = 0; rep < NREP(8); ++rep) { if (rep) REPSYNC(8);
        pg8::Gemm g{WSP(bf16, WS_YIN), WSP(bf16, WS_WOUT), NT, DM, DM}; pg8::SplitOrder S; S.init(NT, DM, DM, F.G, F.bid);
        pg8::EpiSplit<pg8::EpiRes<false>> E{{F.in[I_XP], F.in[I_XS], nullptr, WSP(bf16, WS_XR), WSP(float, WS_MOD), 2048, nullptr, nullptr, nullptr}, WSP(float, WS_SLAB), (unsigned*)(F.ws + WS_CTL) + CW_SPLIT6, (LAS unsigned*)(F.lds + MISC_OFF + 64)};
        pg8::gemm_phase<pg8::EpiSplit<pg8::EpiRes<false>>, pg8::SplitOrder, true, true>(F.lds, g, S, E);
    } SEAM(8); PROBE_END(108);
    PROBE_BEGIN(109);
    if (IN(9)) for (int rep = 0; rep < NREP(9); ++rep) { if (rep) REPSYNC(9); modnorm_rows<true>(F, nullptr, nullptr, WSP(bf16, WS_XR), F.in[I_N2], 3072, 4096, WSP(bf16, WS_H2)); } SEAM(9); PROBE_END(109);
    PROBE_BEGIN(110);
    if (IN(10)) for (int rep = 0; rep < NREP(10); ++rep) { if (rep) REPSYNC(10);
        pg8::Gemm g{WSP(bf16, WS_H2), WSP(bf16, WS_WGU), NT, 2 * DFF, DM}; pg8::StaticOrder S; S.init(NT, 2 * DFF, DM, F.G, F.bid);
        pg8::EpiGU E{WSP(bf16, WS_GU)};
        pg8::gemm_phase<pg8::EpiGU, pg8::StaticOrder, true, true>(F.lds, g, S, E);
    } SEAM(10); PROBE_END(110);
    PROBE_BEGIN(111);
    if (IN(11)) for (int rep = 0; rep < NREP(11); ++rep) { if (rep) REPSYNC(11);
        pg8::Gemm g{WSP(bf16, WS_GU), WSP(bf16, WS_WDN), NT, DM, DFF}; pg8::SplitOrder S; S.init(NT, DM, DFF, F.G, F.bid);
        pg8::EpiSplit<pg8::EpiRes<true>> E{{nullptr, nullptr, WSP(bf16, WS_XR), WSP(bf16, WS_XR), WSP(float, WS_MOD), 5120, nullptr, nullptr, nullptr}, WSP(float, WS_SLAB), (unsigned*)(F.ws + WS_CTL) + CW_SPLIT9, (LAS unsigned*)(F.lds + MISC_OFF + 64)};
        pg8::gemm_phase<pg8::EpiSplit<pg8::EpiRes<true>>, pg8::SplitOrder, true, true>(F.lds, g, S, E);
    } SEAM(11); PROBE_END(111);
    PROBE_BEGIN(112);
    if (IN(12)) for (int rep = 0; rep < NREP(12); ++rep) { if (rep) REPSYNC(12); final_norm(F); }
    PROBE_END(112);
    if (PROBE_ID != 0 && blockIdx.x == PROBE_BLK && threadIdx.x == 0) { const unsigned long long t0 = __builtin_amdgcn_s_memrealtime(), dt = F.pacc * PROBE_K; while (__builtin_amdgcn_s_memrealtime() - t0 < dt) __builtin_amdgcn_s_sleep(16); }
#undef IN
#undef SEAM
}

extern "C" void kernel_launch(void* const* d_in, const int* in_sizes, int n_in, void* d_out, int out_size, void* d_ws, size_t ws_size, hipStream_t stream) {
    static int grid = 0;
    if (grid == 0) {
        if (n_in != N_IN || ws_size < WS_END) { fprintf(stderr, "kernel_launch: unexpected n_in %d / ws %zu\n", n_in, ws_size); grid = -1; return; }
        int dev = 0, cus = 0;
        if (hipGetDevice(&dev) != hipSuccess || hipDeviceGetAttribute(&cus, hipDeviceAttributeMultiprocessorCount, dev) != hipSuccess) { grid = -1; return; }
        if (hipFuncSetAttribute((const void*)mk_fwd, hipFuncAttributeMaxDynamicSharedMemorySize, LDS_BYTES) != hipSuccess) { fprintf(stderr, "kernel_launch: hipFuncSetAttribute failed\n"); grid = -1; return; }
        int per_cu = 0;
        if (hipOccupancyMaxActiveBlocksPerMultiprocessor(&per_cu, (const void*)mk_fwd, NTHR, LDS_BYTES) != hipSuccess || per_cu < 1) { fprintf(stderr, "kernel_launch: occupancy query reports %d\n", per_cu); }
        (void)hipGetLastError();
        grid = cus < 256 ? cus : 256;
    }
    if (grid < 0) return;
    (void)hipMemsetAsync((char*)d_ws + WS_CTL, 0, CTL_ZERO_BYTES, stream);
    Args a{};
    for (int i = 0; i < N_IN; ++i) a.in[i] = (const float*)d_in[i];
    a.out = (float*)d_out; a.ws = (unsigned char*)d_ws;
#if MK_ONE_LAUNCH
    a.ph_lo = 0; a.ph_hi = NPHASE;
    hipLaunchKernelGGL(mk_fwd, dim3(grid), dim3(NTHR), LDS_BYTES, stream, a);
#else
    for (int k = 0; k < NPHASE; ++k) { a.ph_lo = k; a.ph_hi = k + 1; hipLaunchKernelGGL(mk_fwd, dim3(grid), dim3(NTHR), LDS_BYTES, stream, a); }
#endif
}
```

```cpp
#include <hip/hip_runtime.h>
#include <cstdio>
#include <cstdint>

#ifndef REP_MASK
#define REP_MASK 0x0
#endif
#ifndef PROBE_ID
#define PROBE_ID 0
#endif
#define PROBE_K 1
#ifndef PROBE_BLK
#define PROBE_BLK 0
#endif
#ifndef MK_ONE_LAUNCH
#define MK_ONE_LAUNCH 1
#endif

#define LAS __attribute__((address_space(3)))
#define GAS __attribute__((address_space(1)))
typedef unsigned short bf16;
typedef short bf16x8 __attribute__((ext_vector_type(8)));
typedef float f32x4 __attribute__((ext_vector_type(4)));
typedef float f32x2 __attribute__((ext_vector_type(2)));
typedef unsigned u32x4 __attribute__((ext_vector_type(4)));
typedef unsigned u32x2 __attribute__((ext_vector_type(2)));
typedef GAS unsigned gu32;

constexpr int NT = 20480, NCTX = 4096, DM = 1024, DPROJ = 4624, NPAD = 4864, DFF = 2816, NSEQ = 20;
constexpr float EPS = 1e-6f;
constexpr int NWAVES = 8, NTHR = 512;
enum { I_XP = 0, I_XS, I_C, I_SH, I_SG, I_CCTX, I_WADA, I_BADA, I_N1, I_N2, I_WIN, I_CONV, I_LB, I_ALOG, I_DTB, I_HNORM, I_GNORM, I_WOUT, I_WGATE, I_WUP, I_WDOWN, I_NF, N_IN };

constexpr size_t MiB = 1u << 20;
constexpr size_t WS_CTL = 0, CTL_ZERO_BYTES = 2 * MiB;
constexpr size_t WS_MOD = 1 * MiB;
constexpr size_t WS_BETA = 2 * MiB, WS_GG = 3 * MiB;
constexpr size_t WS_BQ = 4 * MiB, WS_BK = 24 * MiB, WS_BV = 44 * MiB;
constexpr size_t WS_OB = 4 * MiB;
constexpr size_t WS_AG = 64 * MiB, WS_BZ = 84 * MiB;
constexpr size_t WS_I = 104 * MiB;
constexpr size_t WS_H = 104 * MiB;
constexpr size_t WS_WIN = 144 * MiB;
constexpr size_t WS_YIN = 104 * MiB;
constexpr size_t WS_WOUT = 44 * MiB, WS_WGU = 46 * MiB, WS_WDN = 57 * MiB;
constexpr size_t WS_H2 = 4 * MiB;
constexpr size_t WS_GU = 64 * MiB;
constexpr size_t WS_SLAB = 160 * MiB;
constexpr size_t WS_XR = 176 * MiB;
constexpr size_t WS_END = 256 * MiB;
constexpr size_t OUT_QA = 0, OUT_VA = 20 * MiB, OUT_GF = 40 * MiB, OUT_GB = 60 * MiB, OUT_OA = 0, OUT_GOVF = 40 * MiB;
constexpr size_t OUT_Y_FLOATS = (size_t)NT * DM, STATE_FLOATS = (size_t)16 * 2 * 4 * 128 * 128;
constexpr int HREC = 41472;
constexpr int GREC = 73984;
constexpr int NUC = 2560, NVB = 1280;
constexpr size_t WS_HVB = WS_I + (size_t)NUC * HREC;
constexpr int N1G = 2154;
static_assert((size_t)N1G * GREC <= 152 * MiB && (size_t)(NUC - N1G) * GREC <= 40 * MiB, "GDN image split");
constexpr int NR_EARLY = 768;
static_assert(WS_I + (size_t)(NUC - NR_EARLY) * GREC >= WS_I + (size_t)NUC * HREC + (size_t)NVB * 16384, "early GDN records must not touch the HGRN images");
static_assert(WS_HVB + (size_t)NVB * 16384 <= WS_END, "HGRN images fit");
constexpr int L_WN = 0, L_QD = 16384, L_AT = 32768, L_KT = 40960, L_U = 57344, L_SC = 73728;

constexpr int CW_BAR = 4096;
constexpr int CW_PROG_H = 16384, CW_PROG_G = 16384 + 64 * 32;
constexpr int P4_PD = 4;
constexpr int CW_SPLIT6 = 32768, CW_SPLIT9 = 32768 + 64 * 64;
constexpr int P4_BUF = 74752;
constexpr int RING_BYTES = 2 * P4_BUF, LDSCTL_OFF = RING_BYTES, MISC_OFF = LDSCTL_OFF + 320, LDS_BYTES = RING_BYTES + 1024;
static_assert(RING_BYTES >= 131072 && LDS_BYTES <= 163840, "LDS map");

#define PROBE_BEGIN(id) do { if (PROBE_ID == (id) && blockIdx.x == PROBE_BLK && threadIdx.x == 0) probe_t0 = __builtin_amdgcn_s_memrealtime(); } while (0)
#define PROBE_END(id) do { if (PROBE_ID == (id) && blockIdx.x == PROBE_BLK && threadIdx.x == 0) probe_acc += __builtin_amdgcn_s_memrealtime() - probe_t0; } while (0)
#define LDS_WAIT() asm volatile("s_waitcnt lgkmcnt(0)" ::: "memory")
#define VM_WAIT() asm volatile("s_waitcnt vmcnt(0)" ::: "memory")
#define RLX_AGENT __ATOMIC_RELAXED, __HIP_MEMORY_SCOPE_AGENT
typedef float f32x2_t __attribute__((ext_vector_type(2)));
typedef __bf16 bf16x2_t __attribute__((ext_vector_type(2)));
__device__ __forceinline__ unsigned pk2(float lo, float hi) { const f32x2_t v = {lo, hi}; const bf16x2_t b = __builtin_convertvector(v, bf16x2_t); return __builtin_bit_cast(unsigned, b); }
__device__ __forceinline__ unsigned f2bf(float f) { return pk2(f, 0.f) & 0xffffu; }
__device__ __forceinline__ float bflo(unsigned w) { return __builtin_bit_cast(float, w << 16); }
__device__ __forceinline__ float bfhi(unsigned w) { return __builtin_bit_cast(float, w & 0xffff0000u); }
__device__ __forceinline__ float bf2f(unsigned short h) { return __builtin_bit_cast(float, (unsigned)h << 16); }
__device__ __forceinline__ float siluf(float x) { return x * __builtin_amdgcn_rcpf(1.f + __expf(-x)); }
__device__ __forceinline__ float sigmf(float x) { return __builtin_amdgcn_rcpf(1.f + __expf(-x)); }
__device__ __forceinline__ f32x4 mfma16(bf16x8 a, bf16x8 b, f32x4 c) { return __builtin_amdgcn_mfma_f32_16x16x32_bf16(a, b, c, 0, 0, 0); }
__device__ __forceinline__ bf16x8 as_frag(u32x4 v) { return __builtin_bit_cast(bf16x8, v); }
__device__ __forceinline__ float wave_sum(float v) {
#pragma unroll
    for (int o = 1; o < 64; o <<= 1) v += __shfl_xor(v, o);
    return v;
}
__device__ __forceinline__ int seq_base(int s) { return s < 16 ? s * 256 : NCTX + (s - 16) * 4096; }
__device__ __forceinline__ int seq_nchunk(int s) { return s < 16 ? 4 : 64; }
__device__ __forceinline__ int chunk_base(int s) { return s < 16 ? 4 * s : 64 + 64 * (s - 16); }
__device__ __forceinline__ int tok_a(int s, int n, int i) { return seq_base(s) + 64 * n + i; }
__device__ __forceinline__ int tok_b(int s, int n, int i) { return s < 16 ? s * 256 + 64 * n + i : NCTX + (s - 16) * 4096 + 64 * i + n; }
__device__ __forceinline__ int kperm(int g, int j) { return 16 * (j >> 2) + 4 * g + (j & 3); }

namespace pg8 {
#define PG8_LAS __attribute__((address_space(3)))
typedef unsigned short bf16_t;
typedef short bf16x8 __attribute__((ext_vector_type(8)));
typedef float f32x4 __attribute__((ext_vector_type(4)));
typedef unsigned u32x4 __attribute__((ext_vector_type(4)));
constexpr int BM = 256, BK = 64, HALF = 128, HTB = HALF * BK * 2  , STAGE_BYTES = 8 * HTB, NXCD = 8, WGM = 8;

__host__ __device__ __forceinline__ int lds_byte(int r, int c) { const int st = (r >> 4) * 2 + (c >> 5), rr = r & 15, cc = c & 31, ob = rr * 64 + cc * 2; return st * 1024 + (ob ^ (((ob >> 9) & 1) << 5)); }
__host__ __device__ __forceinline__ void stage_rc(int b, int& R, int& C) { const int st = b / 1024, sb = b % 1024, swz = sb ^ (((sb >> 9) & 1) << 5); R = (st >> 1) * 16 + swz / 64; C = (st & 1) * 32 + (swz % 64) / 2; }
__host__ __device__ __forceinline__ int perm32(int rho) { const int n = rho >> 4, i = rho & 15; return 8 * (i >> 2) + 4 * n + (i & 3); }

struct Unit { int pm, pn, k0, nt, ns, su, sl; };
struct Gemm { const bf16_t* A; const bf16_t* Bt; int M, N, K; };

struct StaticOrder {
    int nM, nN, nwg, G, c, K;
    __host__ __device__ void init(int M, int N, int K_, int G_, int c_) { nM = M / BM; nN = N / BM; nwg = nM * nN; G = G_; c = c_; K = K_; }
    __host__ __device__ bool next(int i, Unit& u) const {
        const long L = (long)i * G + c; if (L >= nwg) return false;
        int wgid = (int)L; { const int q = nwg / NXCD, r = nwg % NXCD, xcd = wgid % NXCD, off = wgid / NXCD; wgid = (xcd < r ? xcd * (q + 1) : r * (q + 1) + (xcd - r) * q) + off; }
        const int nig = WGM * nN, gid = wgid / nig, fm = gid * WGM, gsz = (nM - fm) < WGM ? (nM - fm) : WGM;
        u.pm = fm + ((wgid % nig) % gsz); u.pn = (wgid % nig) / gsz; u.k0 = 0; u.nt = K / BK; u.ns = 1; u.su = 0; u.sl = 0; return true;
    }
    __device__ __forceinline__ void a_ready(const Unit&) const {}
    __device__ __forceinline__ void done(const Unit&) const {}
};

struct SplitOrder {
    StaticOrder so; bool split;
    __host__ __device__ void init(int M, int N, int K_, int G_, int c_) { so.init(M, N, K_, G_, c_); split = false && (G_ == 256 && so.nwg == 320); }
    __host__ __device__ bool next(int i, Unit& u) const {
        if (!split) return so.next(i, u);
        if (i == 0) return so.next(0, u);
        if (i > 1) return false;
        StaticOrder t = so; t.c = 256 + (so.c >> 2); t.G = 1 << 20; if (!t.next(0, u)) return false;
        const int ntt = so.K / BK, sl = so.c & 3, q = ((ntt / 4) + 1) & ~1;
        const int big = (ntt - 4 * (q - 2)) / 2;
        const int t0 = sl < big ? sl * q : big * q + (sl - big) * (q - 2), tn = sl < big ? q : q - 2;
        u.k0 = t0 * BK; u.nt = tn; u.ns = 4; u.su = so.c >> 2; u.sl = sl; return true;
    }
    __device__ __forceinline__ void a_ready(const Unit&) const {}
    __device__ __forceinline__ void done(const Unit&) const {}
};

__device__ __forceinline__ unsigned pkbf(float lo, float hi) { return ::pk2(lo, hi); }

struct EpiProj {
    static constexpr bool PERM = true, AFTER_DRAIN = false;
    bf16_t *d0, *d1, *d2, *d3, *d4, *d5, *d6, *d7, *d8;
    float* BETA; float* GG;
    const float* lbraw;
    const float* Alog; const float* dtb;
    __device__ __forceinline__ void operator()(const f32x4 (&acc)[2][2][4][2], const Unit& u, int wr, int wc, int fr, int fq) const {
        const int pn = u.pn, row0 = u.pm * BM + wr * 64 + fr;
        if (pn < 18) {
            const int seg = pn >> 1;
            bf16_t* base = seg == 0 ? d0 : seg == 1 ? d1 : seg == 2 ? d2 : seg == 3 ? d3 : seg == 4 ? d4 : seg == 5 ? d5 : seg == 6 ? d6 : seg == 7 ? d7 : d8;
            const int mode = (seg == 0 || seg == 4 || seg == 8) ? 1 : ((seg == 1 || seg == 2) ? 2 : 0);
#pragma unroll
            for (int bj = 0; bj < 2; ++bj) {
                const int c0 = (pn & 1) * 256 + bj * HALF + wc * 32 + 8 * fq;
                float lb[8];
                if (mode == 2) {
                    const int dir = seg - 1;
#pragma unroll
                    for (int e = 0; e < 8; ++e) { const float x0 = lbraw[dir * 512 + c0 + e], x1 = lbraw[1024 + dir * 512 + c0 + e]; lb[e] = 1.f / (1.f + __expf(x1 - x0)); }
                }
#pragma unroll
                for (int ai = 0; ai < 2; ++ai)
#pragma unroll
                    for (int m = 0; m < 4; ++m) {
                        float v[8];
#pragma unroll
                        for (int e = 0; e < 4; ++e) { v[e] = acc[ai][bj][m][0][e]; v[4 + e] = acc[ai][bj][m][1][e]; }
                        if (mode == 1) {
#pragma unroll
                            for (int e = 0; e < 8; ++e) v[e] = ::siluf(v[e]);
                        } else if (mode == 2) {
#pragma unroll
                            for (int e = 0; e < 8; ++e) { const float f = lb[e] + (1.f - lb[e]) * ::sigmf(v[e]); v[e] = __logf(f); }
                        }
                        u32x4 w; w.x = pkbf(v[0], v[1]); w.y = pkbf(v[2], v[3]); w.z = pkbf(v[4], v[5]); w.w = pkbf(v[6], v[7]);
                        *(u32x4*)(base + (size_t)(row0 + ai * HALF + m * 16) * 512 + c0) = w;
                    }
            }
        } else {
            if (wc == 0 && fq < 2) {
                float al[8], db[8];
                if (fq == 1) {
#pragma unroll
                    for (int e = 0; e < 8; ++e) { al[e] = -__expf(Alog[e]); db[e] = dtb[e]; }
                }
#pragma unroll
                for (int ai = 0; ai < 2; ++ai)
#pragma unroll
                    for (int m = 0; m < 4; ++m) {
                        const int row = row0 + ai * HALF + m * 16;
                        float v[8];
#pragma unroll
                        for (int e = 0; e < 4; ++e) { v[e] = acc[ai][0][m][0][e]; v[4 + e] = acc[ai][0][m][1][e]; }
                        if (fq == 0) {
#pragma unroll
                            for (int e = 0; e < 8; ++e) v[e] = ::sigmf(v[e]);
                            *(f32x4*)(BETA + (size_t)row * 8) = (f32x4){v[0], v[1], v[2], v[3]};
                            *(f32x4*)(BETA + (size_t)row * 8 + 4) = (f32x4){v[4], v[5], v[6], v[7]};
                        } else {
#pragma unroll
                            for (int e = 0; e < 8; ++e) { const float x = v[e] + db[e]; const float sp = x > 15.f ? x : log1pf(__expf(x)); v[e] = al[e] * sp; }
                            *(f32x4*)(GG + (size_t)row * 8) = (f32x4){v[0], v[1], v[2], v[3]};
                            *(f32x4*)(GG + (size_t)row * 8 + 4) = (f32x4){v[4], v[5], v[6], v[7]};
                        }
                    }
            }
        }
    }
};

template <bool BASE_BF16> struct EpiRes {
    static constexpr bool PERM = true, AFTER_DRAIN = false;
    const float* base0; const float* base1;
    const bf16_t* baseb;
    bf16_t* out; const float* mod; int goff;
    const float *p1 = nullptr, *p2 = nullptr, *p3 = nullptr;
    __device__ __forceinline__ void operator()(const f32x4 (&acc)[2][2][4][2], const Unit& u, int wr, int wc, int fr, int fq) const {
        const int row0 = u.pm * BM + wr * 64 + fr;
        const int mr = u.pm < 16 ? 0 : 1 + ((u.pm - 16) >> 4);
        const float* gp = mod + (size_t)mr * 6144 + goff;
#pragma unroll
        for (int bj = 0; bj < 2; ++bj) {
            const int c0 = u.pn * BM + bj * HALF + wc * 32 + 8 * fq;
            const f32x4 g0 = *(const f32x4*)(gp + c0), g1 = *(const f32x4*)(gp + c0 + 4);
#pragma unroll
            for (int ai = 0; ai < 2; ++ai)
#pragma unroll
                for (int m = 0; m < 4; ++m) {
                    const int row = row0 + ai * HALF + m * 16;
                    f32x4 b0, b1;
                    if (BASE_BF16) { const u32x4 bw = *(const u32x4*)(baseb + (size_t)row * 1024 + c0);
                        b0 = (f32x4){::bflo(bw.x), ::bfhi(bw.x), ::bflo(bw.y), ::bfhi(bw.y)}; b1 = (f32x4){::bflo(bw.z), ::bfhi(bw.z), ::bflo(bw.w), ::bfhi(bw.w)}; }
                    else { const float* bp = (row < 4096 ? base0 + (size_t)row * 1024 : base1 + (size_t)(row - 4096) * 1024) + c0; b0 = *(const f32x4*)bp; b1 = *(const f32x4*)(bp + 4); }
                    f32x4 a0 = acc[ai][bj][m][0], a1 = acc[ai][bj][m][1];
                    if (p1) { const float *q1 = p1 + threadIdx.x * 4, *q2 = p2 + threadIdx.x * 4, *q3 = p3 + threadIdx.x * 4; asm volatile("" : "+v"(q1), "+v"(q2), "+v"(q3));
                        const int i0 = (((ai * 2 + bj) * 4 + m) * 2) * 2048, i1 = i0 + 2048;
                        a0 = a0 + (*(const f32x4*)(q1 + i0) + *(const f32x4*)(q2 + i0)) + *(const f32x4*)(q3 + i0); a1 = a1 + (*(const f32x4*)(q1 + i1) + *(const f32x4*)(q2 + i1)) + *(const f32x4*)(q3 + i1); }
                    const f32x4 o0 = b0 + g0 * a0, o1 = b1 + g1 * a1;
                    u32x4 w; w.x = pkbf(o0[0], o0[1]); w.y = pkbf(o0[2], o0[3]); w.z = pkbf(o1[0], o1[1]); w.w = pkbf(o1[2], o1[3]);
                    *(u32x4*)(out + (size_t)row * 1024 + c0) = w;
                }
        }
    }
};

struct EpiGU {
    static constexpr bool PERM = true, AFTER_DRAIN = false;
    bf16_t* GU;
    __device__ __forceinline__ void operator()(const f32x4 (&acc)[2][2][4][2], const Unit& u, int wr, int wc, int fr, int fq) const {
        const int row0 = u.pm * BM + wr * 64 + fr, c0 = u.pn * HALF + wc * 32 + 8 * fq;
#pragma unroll
        for (int ai = 0; ai < 2; ++ai)
#pragma unroll
            for (int m = 0; m < 4; ++m) {
                float v[8];
#pragma unroll
                for (int e = 0; e < 4; ++e) { v[e] = ::siluf(acc[ai][0][m][0][e]) * acc[ai][1][m][0][e]; v[4 + e] = ::siluf(acc[ai][0][m][1][e]) * acc[ai][1][m][1][e]; }
                u32x4 w; w.x = pkbf(v[0], v[1]); w.y = pkbf(v[2], v[3]); w.z = pkbf(v[4], v[5]); w.w = pkbf(v[6], v[7]);
                *(u32x4*)(GU + (size_t)(row0 + ai * HALF + m * 16) * 2816 + c0) = w;
            }
    }
};

template <class Inner> struct EpiSplit {
    static constexpr bool PERM = Inner::PERM, AFTER_DRAIN = false;
    Inner in; float* slab; unsigned* cnt; PG8_LAS unsigned* flag;
    __device__ __forceinline__ void operator()(const f32x4 (&acc)[2][2][4][2], const Unit& u, int wr, int wc, int fr, int fq) const {
        if (u.ns == 1) { in(acc, u, wr, wc, fr, fq); return; }
        const int tid = threadIdx.x;
        float* my = slab + (size_t)(u.su * 4 + u.sl) * 65536;
        const __amdgpu_buffer_rsrc_t rs = __builtin_amdgcn_make_buffer_rsrc(my, 0, 262144, 0x00020000);
#pragma unroll
        for (int ai = 0; ai < 2; ++ai)
#pragma unroll
            for (int bj = 0; bj < 2; ++bj)
#pragma unroll
                for (int m = 0; m < 4; ++m)
#pragma unroll
                    for (int n = 0; n < 2; ++n) __builtin_amdgcn_raw_buffer_store_b128(__builtin_bit_cast(u32x4, acc[ai][bj][m][n]), rs, (unsigned)(tid * 16), (unsigned)((((ai * 2 + bj) * 4 + m) * 2 + n) * 8192), 16);
        asm volatile("s_waitcnt vmcnt(0)" ::: "memory");
        __builtin_amdgcn_s_barrier();
        if (tid == 0) {
            const unsigned old = __hip_atomic_fetch_add(cnt + 64 * u.su, 1u, __ATOMIC_RELAXED, __HIP_MEMORY_SCOPE_AGENT);
            const unsigned last = (old == 3u) ? 1u : 0u;
            if (last) { __builtin_amdgcn_fence(__ATOMIC_ACQUIRE, "agent"); asm volatile("s_waitcnt vmcnt(0)" ::: "memory"); }
            *flag = last;
        }
        asm volatile("s_waitcnt lgkmcnt(0)" ::: "memory");
        __builtin_amdgcn_s_barrier();
        const unsigned last = *flag;
        if (last) {
            Inner in2 = in;
            in2.p1 = slab + (size_t)(u.su * 4 + ((u.sl + 1) & 3)) * 65536; in2.p2 = slab + (size_t)(u.su * 4 + ((u.sl + 2) & 3)) * 65536; in2.p3 = slab + (size_t)(u.su * 4 + ((u.sl + 3) & 3)) * 65536;
            in2(acc, u, wr, wc, fr, fq);
        }
    }
};
template <class Epi, class Sched, bool ALIGN_EPI = false, bool SP2 = false>
__device__ __forceinline__ void gemm_phase(PG8_LAS unsigned char* lds, const Gemm g, const Sched& S, const Epi& E) {
    const int tid = threadIdx.x, wid = __builtin_amdgcn_readfirstlane(tid >> 6), lane = tid & 63, wr = wid >> 2, wc = wid & 3, fr = lane & 15, fq = lane >> 4;
    const int K = g.K;
    unsigned voffA[2], voffB[2];
#pragma unroll
    for (int i = 0; i < 2; ++i) { int R, C; stage_rc(tid * 16 + i * 8192, R, C); const int Rb = Epi::PERM ? ((R & ~31) + perm32(R & 31)) : R;
        voffA[i] = (unsigned)(R * K + C) * 2u; voffB[i] = (unsigned)(Rb * K + C) * 2u; }
    const size_t kstep = (size_t)(BK * 2);
    const size_t hstep = (size_t)HALF * K * 2;
    const size_t tstep = 2 * hstep;
    const unsigned ldsw = (unsigned)wid * 1024u;
    const int aoff = lds_byte(wr * 64 + fr, fq * 8), boff = lds_byte(wc * 32 + fr, fq * 8);
#define PG8_SA(b, h) (((b) * 2 + (h)) * HTB)
#define PG8_SB(b, h) ((4 + (b) * 2 + (h)) * HTB)
#define PG8_STAGE(bufoff, gbase, voff) do { _Pragma("unroll") for (int _i = 0; _i < 2; ++_i) \
        __builtin_amdgcn_global_load_lds((const unsigned*)((const char*)(gbase) + (voff)[_i]), (PG8_LAS unsigned*)(lds + (bufoff) + ldsw + _i * 8192), 16, 0, 0); } while (0)
#define PG8_LDA(dst, b, h) do { _Pragma("unroll") for (int m = 0; m < 4; ++m) _Pragma("unroll") for (int k = 0; k < 2; ++k) dst[m][k] = *(const PG8_LAS bf16x8*)(lds + PG8_SA(b, h) + aoff + m * 2048 + k * 1024); } while (0)
#define PG8_LDB(dst, b, h) do { _Pragma("unroll") for (int n = 0; n < 2; ++n) _Pragma("unroll") for (int k = 0; k < 2; ++k) dst[n][k] = *(const PG8_LAS bf16x8*)(lds + PG8_SB(b, h) + boff + n * 2048 + k * 1024); } while (0)
#define PG8_MMA(ai, bj, At, Bt) do { __builtin_amdgcn_s_setprio(1); _Pragma("unroll") for (int m = 0; m < 4; ++m) _Pragma("unroll") for (int n = 0; n < 2; ++n) _Pragma("unroll") for (int k = 0; k < 2; ++k) \
        acc[ai][bj][m][n] = __builtin_amdgcn_mfma_f32_16x16x32_bf16(Bt[n][k], At[m][k], acc[ai][bj][m][n], 0, 0, 0); __builtin_amdgcn_s_setprio(0); } while (0)
#define PG8_WAIT_V(n) asm volatile("s_waitcnt vmcnt(" #n ")" ::: "memory")
#define PG8_WAIT_L(n) asm volatile("s_waitcnt lgkmcnt(" #n ")" ::: "memory")
#define PG8_BAR __builtin_amdgcn_s_barrier()
#define PG8_SCHED __builtin_amdgcn_sched_barrier(0)
    Unit cur, nxt; int ui = 0;
    if (!S.next(0, cur)) return;
    f32x4 acc[2][2][4][2];
#pragma unroll
    for (int a = 0; a < 2; ++a)
#pragma unroll
        for (int b = 0; b < 2; ++b)
#pragma unroll
            for (int m = 0; m < 4; ++m)
#pragma unroll
                for (int n = 0; n < 2; ++n) acc[a][b][m][n] = (f32x4){0.f, 0.f, 0.f, 0.f};
    bf16x8 At[4][2], B0[2][2], B1[2][2];
    const char* cA = (const char*)g.A + (size_t)cur.pm * tstep + (size_t)cur.k0 * 2; const char* cB = (const char*)g.Bt + (size_t)cur.pn * tstep + (size_t)cur.k0 * 2;
    S.a_ready(cur);
    if constexpr (SP2) {
        PG8_STAGE(PG8_SB(0, 0), cB, voffB); PG8_STAGE(PG8_SB(0, 1), cB + hstep, voffB); PG8_STAGE(PG8_SA(0, 0), cA, voffA); PG8_STAGE(PG8_SA(0, 1), cA + hstep, voffA);
        if (wr == 1) PG8_BAR;
        PG8_WAIT_V(2); PG8_BAR;
        PG8_STAGE(PG8_SB(1, 0), cB + kstep, voffB); PG8_STAGE(PG8_SA(1, 0), cA + kstep, voffA); PG8_STAGE(PG8_SB(1, 1), cB + hstep + kstep, voffB);
        PG8_WAIT_V(6); PG8_BAR;
    } else {
        PG8_STAGE(PG8_SB(0, 0), cB, voffB); PG8_STAGE(PG8_SA(0, 0), cA, voffA); PG8_STAGE(PG8_SB(0, 1), cB + hstep, voffB); PG8_STAGE(PG8_SA(0, 1), cA + hstep, voffA);
        if (wr == 1) PG8_BAR;
        PG8_WAIT_V(4); PG8_BAR;
        PG8_STAGE(PG8_SB(1, 0), cB + kstep, voffB); PG8_STAGE(PG8_SA(1, 0), cA + kstep, voffA); PG8_STAGE(PG8_SB(1, 1), cB + hstep + kstep, voffB);
        PG8_WAIT_V(6); PG8_BAR;
    }
    for (;;) {
        const bool has_next = S.next(ui + 1, nxt);
        const char* nA = has_next ? (const char*)g.A + (size_t)nxt.pm * tstep + (size_t)nxt.k0 * 2 : cA; const char* nB = has_next ? (const char*)g.Bt + (size_t)nxt.pn * tstep + (size_t)nxt.k0 * 2 : cB;
        const int nt = cur.nt;
        for (int t = 0; t < nt; t += 2) {
            const bool last = (t == nt - 2);
            const char* a1 = cA + (size_t)(t + 1) * kstep;
            const char* a2 = last ? nA : cA + (size_t)(t + 2) * kstep; const char* b2 = last ? nB : cB + (size_t)(t + 2) * kstep;
            const char* a3 = a2 + kstep; const char* b3 = b2 + kstep;
            if (last && has_next) S.a_ready(nxt);
            if constexpr (SP2) {
            PG8_LDB(B0, 0, 0); PG8_LDB(B1, 0, 1); PG8_SCHED; PG8_LDA(At, 0, 0); PG8_STAGE(PG8_SA(1, 1), a1 + hstep, voffA);
            PG8_WAIT_V(8); PG8_WAIT_L(0); PG8_BAR; PG8_MMA(0, 0, At, B0); PG8_MMA(0, 1, At, B1); PG8_BAR; PG8_SCHED;
            PG8_LDA(At, 0, 1); PG8_STAGE(PG8_SB(0, 0), b2, voffB); PG8_STAGE(PG8_SB(0, 1), b2 + hstep, voffB); PG8_STAGE(PG8_SA(0, 0), a2, voffA);
            PG8_WAIT_V(8); PG8_WAIT_L(0); PG8_BAR; PG8_MMA(1, 0, At, B0); PG8_MMA(1, 1, At, B1); PG8_BAR; PG8_SCHED;
            PG8_LDB(B0, 1, 0); PG8_LDB(B1, 1, 1); PG8_SCHED; PG8_LDA(At, 1, 0); PG8_STAGE(PG8_SA(0, 1), a2 + hstep, voffA);
            PG8_WAIT_V(8); PG8_WAIT_L(0); PG8_BAR; PG8_MMA(0, 0, At, B0); PG8_MMA(0, 1, At, B1); PG8_BAR; PG8_SCHED;
            PG8_LDA(At, 1, 1); PG8_STAGE(PG8_SB(1, 0), b3, voffB); PG8_STAGE(PG8_SB(1, 1), b3 + hstep, voffB); PG8_STAGE(PG8_SA(1, 0), a3, voffA);
            PG8_WAIT_V(8); PG8_WAIT_L(0); PG8_BAR; PG8_MMA(1, 0, At, B0); PG8_MMA(1, 1, At, B1); PG8_BAR; PG8_SCHED;
            } else {
            PG8_LDB(B0, 0, 0); PG8_SCHED; PG8_LDA(At, 0, 0); PG8_STAGE(PG8_SA(1, 1), a1 + hstep, voffA);
            PG8_WAIT_L(8); PG8_BAR; PG8_WAIT_L(0); PG8_MMA(0, 0, At, B0); PG8_BAR; PG8_SCHED;
            PG8_LDB(B1, 0, 1); PG8_STAGE(PG8_SB(0, 0), b2, voffB);
            PG8_BAR; PG8_WAIT_L(0); PG8_MMA(0, 1, At, B1); PG8_BAR;
            PG8_LDA(At, 0, 1); PG8_STAGE(PG8_SA(0, 0), a2, voffA);
            PG8_BAR; PG8_WAIT_L(0); PG8_MMA(1, 0, At, B0); PG8_BAR; PG8_SCHED;
            PG8_STAGE(PG8_SB(0, 1), b2 + hstep, voffB);
            PG8_WAIT_V(6); PG8_BAR; PG8_MMA(1, 1, At, B1); PG8_BAR;
            PG8_LDB(B0, 1, 0); PG8_SCHED; PG8_LDA(At, 1, 0); PG8_STAGE(PG8_SA(0, 1), a2 + hstep, voffA);
            PG8_WAIT_L(8); PG8_BAR; PG8_WAIT_L(0); PG8_MMA(0, 0, At, B0); PG8_BAR; PG8_SCHED;
            PG8_LDB(B1, 1, 1); PG8_STAGE(PG8_SB(1, 0), b3, voffB);
            PG8_BAR; PG8_WAIT_L(0); PG8_MMA(0, 1, At, B1); PG8_BAR;
            PG8_LDA(At, 1, 1); PG8_STAGE(PG8_SA(1, 0), a3, voffA);
            PG8_BAR; PG8_WAIT_L(0); PG8_MMA(1, 0, At, B0); PG8_BAR; PG8_SCHED;
            PG8_STAGE(PG8_SB(1, 1), b3 + hstep, voffB);
            PG8_WAIT_V(6); PG8_BAR; PG8_MMA(1, 1, At, B1); PG8_BAR;
            }
        }
        if constexpr (ALIGN_EPI) { if (wr == 0) PG8_BAR; }
        if constexpr (!Epi::AFTER_DRAIN) { E(acc, cur, wr, wc, fr, fq); S.done(cur); }
        if (!has_next) break;
#pragma unroll
        for (int a = 0; a < 2; ++a)
#pragma unroll
            for (int b = 0; b < 2; ++b)
#pragma unroll
                for (int m = 0; m < 4; ++m)
#pragma unroll
                    for (int n = 0; n < 2; ++n) acc[a][b][m][n] = (f32x4){0.f, 0.f, 0.f, 0.f};
        cur = nxt; cA = nA; cB = nB; ++ui;
        if constexpr (ALIGN_EPI) { if (wr == 1) PG8_BAR; }
    }
    PG8_WAIT_V(0);
    if constexpr (!ALIGN_EPI) { if (wr == 0) PG8_BAR; }
    PG8_BAR;
    if constexpr (Epi::AFTER_DRAIN) { E.fused(acc, cur, wr, wc, fr, fq, lds, wid, lane); S.done(cur); }
#undef PG8_SA
#undef PG8_SB
#undef PG8_STAGE
#undef PG8_LDA
#undef PG8_LDB
#undef PG8_MMA
#undef PG8_WAIT_V
#undef PG8_WAIT_L
#undef PG8_BAR
#undef PG8_SCHED
}
}

#define XB_TMO      128
#define XB_XCNT(j)  (256  + 64 * (j))
#define XB_XSUB(j)  (1280 + 64 * (j))
#define XB_XGEN(j)  (2304 + 64 * (j))
#define XB_TOP      3328
#define XB_TOPGEN   3392
#define XCD_BAR_WORDS 3456
#define XB_SPIN_CAP (1u << 18)

__device__ __forceinline__ unsigned xb_ld(unsigned* p)              { return __hip_atomic_load(p, __ATOMIC_RELAXED, __HIP_MEMORY_SCOPE_AGENT); }
__device__ __forceinline__ unsigned xb_add(unsigned* p, unsigned v) { return __hip_atomic_fetch_add(p, v, __ATOMIC_RELAXED, __HIP_MEMORY_SCOPE_AGENT); }
__device__ __forceinline__ unsigned xb_xcc_id() { return (unsigned)__builtin_amdgcn_s_getreg((3 << 11) | 20) & 0xFu; }
#define XB_SPIN(cond, bar) do { unsigned _sp = 0; while (cond) { __builtin_amdgcn_s_sleep(1); \
    if ((++_sp & 255u) == 0u) { if (xb_ld(&(bar)[XB_TMO])) break; if (_sp > XB_SPIN_CAP) { atomicAdd(&(bar)[XB_TMO], 1u); break; } } } } while (0)

struct XcdBarrier {
    unsigned* bar; unsigned x;
    volatile LAS unsigned* st;
};

__device__ __forceinline__ XcdBarrier xcd_barrier_post(unsigned* bar, volatile LAS unsigned* st) {
    XcdBarrier b; b.bar = bar; b.x = xb_xcc_id(); b.st = st;
    if (threadIdx.x == 0) (void)xb_add(&bar[XB_XCNT(b.x)], 1u);
    return b;
}
__device__ __forceinline__ void xcd_barrier_complete(unsigned* bar, unsigned x, unsigned& nloc, unsigned& nx) {
    const unsigned G = gridDim.x * gridDim.y * gridDim.z;
    unsigned sum, cnt, mine, sp = 0u;
    for (;;) {
        sum = 0u; cnt = 0u; mine = 0u;
#pragma unroll
        for (unsigned j = 0; j < 16; ++j) { const unsigned c = xb_ld(&bar[XB_XCNT(j)]); sum += c; cnt += (c > 0u) ? 1u : 0u; mine = (j == x) ? c : mine; }
        if (sum == G) break;
        __builtin_amdgcn_s_sleep(1);
        if ((++sp & 255u) == 0u) { if (xb_ld(&bar[XB_TMO])) break; if (sp > XB_SPIN_CAP) { atomicAdd(&bar[XB_TMO], 1u); break; } }
    }
    nloc = mine > 0u ? mine : 1u; nx = cnt > 0u ? cnt : 1u;
}

__device__ __forceinline__ void xcd_barrier(const XcdBarrier& b) {
    asm volatile("s_waitcnt vmcnt(0)" ::: "memory");
    __syncthreads();
    if (threadIdx.x == 0) {
        unsigned* bar = b.bar;
        __builtin_amdgcn_s_waitcnt(0);
        unsigned nloc = b.st[0], nx = b.st[1];
        if (nloc == 0u) { xcd_barrier_complete(bar, b.x, nloc, nx); b.st[0] = nloc; b.st[1] = nx; }
        const unsigned old = xb_add(&bar[XB_XSUB(b.x)], 1u);
        const unsigned gen = old / nloc;
        if (old + 1u == (gen + 1u) * nloc) {
            __builtin_amdgcn_fence(__ATOMIC_RELEASE, "agent");
            asm volatile("s_waitcnt vmcnt(0)" ::: "memory");
            const unsigned og = xb_add(&bar[XB_TOP], 1u);
            const unsigned tg = og / nx;
            if (og + 1u == (tg + 1u) * nx) xb_add(&bar[XB_TOPGEN], 1u);
            else XB_SPIN(xb_ld(&bar[XB_TOPGEN]) == tg, bar);
            __builtin_amdgcn_fence(__ATOMIC_ACQUIRE, "agent");
            xb_add(&bar[XB_XGEN(b.x)], 1u);
            asm volatile("s_waitcnt vmcnt(0)" ::: "memory");
        } else {
            XB_SPIN(xb_ld(&bar[XB_XGEN(b.x)]) == gen, bar);
            __builtin_amdgcn_fence(__ATOMIC_ACQUIRE, "agent");
            asm volatile("s_waitcnt vmcnt(0)" ::: "memory");
        }
    }
    __syncthreads();
}

struct Args { const float* in[N_IN]; float* out; unsigned char* ws; int ph_lo, ph_hi; };
struct Frame {
    LAS unsigned char* lds;
    int tid, lane, wave, bid, G;
    unsigned long long pacc, pt0;
    const float* in[N_IN];
    float* out; unsigned char* ws;
};
#define probe_acc F.pacc
#define probe_t0 F.pt0
#define WSP(T, off) ((T*)(F.ws + (off)))
#define OUTB(T, off) ((T*)((unsigned char*)F.out + (off)))

__device__ __forceinline__ void transpose_item(const float* W, int K, int N, bf16* WT, int dst_row0, int k0, int n0, LAS float* scr, int lane) {
    float wv[32];
#pragma unroll
    for (int i = 0; i < 32; ++i) { const int kk = 2 * i + (lane >> 5), n = n0 + (lane & 31); wv[i] = n < N ? W[(size_t)(k0 + kk) * N + n] : 0.f; }
#pragma unroll
    for (int i = 0; i < 32; ++i) { const int kk = 2 * i + (lane >> 5); scr[kk * 33 + (lane & 31)] = wv[i]; }
    LDS_WAIT(); asm volatile("" ::: "memory");
    const int c = lane & 7;
#pragma unroll
    for (int j = 0; j < 4; ++j) { const int n = (lane >> 3) + 8 * j; const LAS float* s = scr + (8 * c) * 33 + n;
        u32x4 o; o.x = pk2(s[0 * 33], s[1 * 33]); o.y = pk2(s[2 * 33], s[3 * 33]); o.z = pk2(s[4 * 33], s[5 * 33]); o.w = pk2(s[6 * 33], s[7 * 33]);
        *(u32x4*)(WT + (size_t)(dst_row0 + n) * K + k0 + 8 * c) = o; }
    LDS_WAIT(); asm volatile("" ::: "memory");
}

__device__ __forceinline__ void p0_prologue(Frame& F) {
    const int gw = F.bid * NWAVES + F.wave, NGW = F.G * NWAVES;
    {
        LAS float* scr = (LAS float*)(F.lds + 49152 + F.wave * 8704);
        constexpr int NB = NPAD / 32, NITEMS = 16 * NB;
        for (int it = gw; it < NITEMS; it += NGW) { const int kb = it / NB, nb = it % NB; transpose_item(F.in[I_WIN], 1024, DPROJ, WSP(bf16, WS_WIN), 32 * nb, 64 * kb, 32 * nb, scr, F.lane); }
    }
    {
        LAS float* sc = (LAS float*)F.lds;
        LAS float* red = (LAS float*)(F.lds + 20480);
        for (int idx = F.tid; idx < 5 * 1024; idx += NTHR) { const int r = idx >> 10, k = idx & 1023; const float v = r == 0 ? F.in[I_CCTX][k] : F.in[I_C][(r - 1) * 1024 + k]; sc[idx] = siluf(v); }
        __syncthreads();
        const float* wada = F.in[I_WADA]; const float* bada = F.in[I_BADA]; float* mod = WSP(float, WS_MOD);
        for (int it = F.bid; it < 256; it += F.G) {
            const int kg = it >> 3, cg = it & 7, c4 = F.tid % 192, rh = F.tid / 192;
            float acc[5][4];
#pragma unroll
            for (int r = 0; r < 5; ++r)
#pragma unroll
                for (int e = 0; e < 4; ++e) acc[r][e] = 0.f;
            if (rh < 2) {
                const float* wp = wada + (size_t)(32 * kg + 16 * rh) * 6144 + 768 * cg + 4 * c4;
                f32x4 wr[16];
#pragma unroll
                for (int kk = 0; kk < 16; ++kk) wr[kk] = *(const f32x4*)(wp + (size_t)kk * 6144);
#pragma unroll
                for (int kk = 0; kk < 16; ++kk) {
                    const f32x4 w = wr[kk];
                    const int k = 32 * kg + 16 * rh + kk;
#pragma unroll
                    for (int r = 0; r < 5; ++r) { const float s = sc[r * 1024 + k]; acc[r][0] += s * w.x; acc[r][1] += s * w.y; acc[r][2] += s * w.z; acc[r][3] += s * w.w; }
                }
            }
            if (rh == 1) {
#pragma unroll
                for (int r = 0; r < 5; ++r)
#pragma unroll
                    for (int e = 0; e < 4; ++e) red[c4 * 20 + r * 4 + e] = acc[r][e];
            }
            __syncthreads();
            if (rh == 0) {
                const int col = 768 * cg + 4 * c4;
#pragma unroll
                for (int r = 0; r < 5; ++r)
#pragma unroll
                    for (int e = 0; e < 4; ++e) { float v = acc[r][e] + red[c4 * 20 + r * 4 + e]; if (kg == 0) v += bada[col + e]; atomicAdd(mod + r * 6144 + col + e, v); }
            }
            __syncthreads();
        }
    }
}

template <bool XBF>
__device__ __forceinline__ void modnorm_rows(Frame& F, const float* x0, const float* x1, const bf16* xb, const float* nw, int sh_off, int sc_off, bf16* H) {
    const int gw = F.bid * NWAVES + F.wave, NGW = F.G * NWAVES;
    const float* mod = WSP(float, WS_MOD);
    f32x4 v[2][4], vn[2][4];
#define MN_LOAD(dst, M0) do { _Pragma("unroll") for (int u = 0; u < 2; ++u) { const int m_ = (M0) + u * NGW; if (m_ < NT) { \
        if (XBF) { _Pragma("unroll") for (int j = 0; j < 4; ++j) { const u32x2 w_ = *(const u32x2*)(xb + (size_t)m_ * DM + 4 * F.lane + 256 * j); dst[u][j] = (f32x4){bflo(w_.x), bfhi(w_.x), bflo(w_.y), bfhi(w_.y)}; } } \
        else { const float* xr_ = m_ < NCTX ? x0 + (size_t)m_ * DM : x1 + (size_t)(m_ - NCTX) * DM; \
        _Pragma("unroll") for (int j = 0; j < 4; ++j) dst[u][j] = *(const f32x4*)(xr_ + 4 * F.lane + 256 * j); } } } } while (0)
    MN_LOAD(vn, gw);
    for (int m0 = gw; m0 < NT; m0 += 2 * NGW) {
#pragma unroll
        for (int u = 0; u < 2; ++u)
#pragma unroll
            for (int j = 0; j < 4; ++j) v[u][j] = vn[u][j];
        if (m0 + 2 * NGW < NT) MN_LOAD(vn, m0 + 2 * NGW);
#pragma unroll
        for (int u = 0; u < 2; ++u) { const int m = m0 + u * NGW; if (m < NT) {
            const int mr = m < NCTX ? 0 : 1 + ((m - NCTX) >> 12);
            const float* mp = mod + (size_t)mr * 6144;
            float s = 0.f;
#pragma unroll
            for (int j = 0; j < 4; ++j) s += (v[u][j].x * v[u][j].x + v[u][j].y * v[u][j].y) + (v[u][j].z * v[u][j].z + v[u][j].w * v[u][j].w);
            const float rstd = __builtin_amdgcn_rsqf(wave_sum(s) * (1.f / DM) + EPS);
#pragma unroll
            for (int j = 0; j < 4; ++j) {
                const int c = 4 * F.lane + 256 * j;
                const f32x4 w = *(const f32x4*)(nw + c), sc = *(const f32x4*)(mp + sc_off + c), sh = *(const f32x4*)(mp + sh_off + c);
                const f32x4 h = (v[u][j] * rstd * w) * (sc + 1.f) + sh;
                u32x2 o; o.x = pk2(h.x, h.y); o.y = pk2(h.z, h.w);
                *(u32x2*)(H + (size_t)m * DM + c) = o;
            } } }
    }
#undef MN_LOAD
}

__device__ __forceinline__ void final_norm(Frame& F) {
    const int gw = F.bid * NWAVES + F.wave, NGW = F.G * NWAVES;
    const float* nf = F.in[I_NF];
    f32x4 w[4];
#pragma unroll
    for (int j = 0; j < 4; ++j) w[j] = *(const f32x4*)(nf + 4 * F.lane + 256 * j);
    for (int m0 = gw; m0 < NT; m0 += 2 * NGW) {
        f32x4 v[2][4];
#pragma unroll
        for (int u = 0; u < 2; ++u) { const int m = m0 + u * NGW; if (m < NT) {
#pragma unroll
            for (int j = 0; j < 4; ++j) { const u32x2 w_ = *(const u32x2*)(WSP(bf16, WS_XR) + (size_t)m * DM + 4 * F.lane + 256 * j); v[u][j] = (f32x4){bflo(w_.x), bfhi(w_.x), bflo(w_.y), bfhi(w_.y)}; } } }
#pragma unroll
        for (int u = 0; u < 2; ++u) { const int m = m0 + u * NGW; if (m < NT) {
            float s = 0.f;
#pragma unroll
            for (int j = 0; j < 4; ++j) s += (v[u][j].x * v[u][j].x + v[u][j].y * v[u][j].y) + (v[u][j].z * v[u][j].z + v[u][j].w * v[u][j].w);
            const float rstd = __builtin_amdgcn_rsqf(wave_sum(s) * (1.f / DM) + EPS);
#pragma unroll
            for (int j = 0; j < 4; ++j) *(f32x4*)(F.out + (size_t)m * DM + 4 * F.lane + 256 * j) = v[u][j] * rstd * w[j]; } }
    }
}

__device__ __forceinline__ void late_weights(Frame& F, const int gw, const int NGW) {
    {
        LAS float* scr = (LAS float*)(F.lds + F.wave * 8704);
        constexpr int I_O = 16 * 32, I_G = 16 * 88, I_D = 44 * 32, NITEMS = I_O + 2 * I_G + I_D;
        for (int it = gw; it < NITEMS; it += NGW) {
            int r = it;
            if (r < I_O) { const int kb = r / 32, nb = r % 32; transpose_item(F.in[I_WOUT], 1024, 1024, WSP(bf16, WS_WOUT), 32 * nb, 64 * kb, 32 * nb, scr, F.lane); continue; } r -= I_O;
            if (r < I_G) { const int kb = r / 88, nb = r % 88, n0 = 32 * nb; transpose_item(F.in[I_WGATE], 1024, DFF, WSP(bf16, WS_WGU), 256 * (n0 >> 7) + (n0 & 127), 64 * kb, n0, scr, F.lane); continue; } r -= I_G;
            if (r < I_G) { const int kb = r / 88, nb = r % 88, n0 = 32 * nb; transpose_item(F.in[I_WUP], 1024, DFF, WSP(bf16, WS_WGU), 256 * (n0 >> 7) + 128 + (n0 & 127), 64 * kb, n0, scr, F.lane); continue; } r -= I_G;
            { const int kb = r / 32, nb = r % 32; transpose_item(F.in[I_WDOWN], DFF, 1024, WSP(bf16, WS_WDN), 32 * nb, 64 * kb, 32 * nb, scr, F.lane); }
        }
    }
}

__device__ __forceinline__ void p5_headnorm(Frame& F) {
    const int gw = F.bid * NWAVES + F.wave, NGW = F.G * NWAVES;
    const bf16* OA0 = OUTB(bf16, OUT_OA); const bf16* OA1 = OUTB(bf16, OUT_OA + 20 * MiB);
    const bf16* OB0 = WSP(bf16, WS_OB);   const bf16* OB1 = WSP(bf16, WS_OB + 20 * MiB);
    const bf16* AG = WSP(bf16, WS_AG);    const bf16* BZ = WSP(bf16, WS_BZ);
    bf16* Y = WSP(bf16, WS_YIN);
    const int half = F.lane >> 5, c = 16 * (F.lane & 31);
    const float* nw = (half ? F.in[I_GNORM] : F.in[I_HNORM]) + c;
    f32x4 wn[4];
#pragma unroll
    for (int q = 0; q < 4; ++q) wn[q] = *(const f32x4*)(nw + 4 * q);
    u32x4 ra[2], rb[2], rg[2], na[2], nb2[2], ng[2];
#define P5_LOAD(A, B, Gt, M) do { const size_t off_ = (size_t)(M) * 512 + c; \
        _Pragma("unroll") for (int q = 0; q < 2; ++q) { A[q] = *(const u32x4*)((half ? OB0 : OA0) + off_ + 8 * q); B[q] = *(const u32x4*)((half ? OB1 : OA1) + off_ + 8 * q); Gt[q] = *(const u32x4*)((half ? BZ : AG) + off_ + 8 * q); } } while (0)
    if (gw < NT) P5_LOAD(na, nb2, ng, gw);
    for (int m = gw; m < NT; m += NGW) {
#pragma unroll
        for (int q = 0; q < 2; ++q) { ra[q] = na[q]; rb[q] = nb2[q]; rg[q] = ng[q]; }
        if (m + NGW < NT) P5_LOAD(na, nb2, ng, m + NGW);
        float o[16]; float ss = 0.f;
#pragma unroll
        for (int q = 0; q < 2; ++q)
#pragma unroll
            for (int e = 0; e < 4; ++e) { o[8 * q + 2 * e] = bflo(ra[q][e]) + bflo(rb[q][e]); o[8 * q + 2 * e + 1] = bfhi(ra[q][e]) + bfhi(rb[q][e]); }
#pragma unroll
        for (int e = 0; e < 16; ++e) ss += o[e] * o[e];
        ss += __shfl_xor(ss, 1); ss += __shfl_xor(ss, 2); ss += __shfl_xor(ss, 4);
        const float rstd = __builtin_amdgcn_rsqf(ss * (1.f / 128.f) + EPS);
#pragma unroll
        for (int q = 0; q < 2; ++q) {
            float y[8];
#pragma unroll
            for (int e = 0; e < 4; ++e) { y[2 * e] = o[8 * q + 2 * e] * rstd * wn[2 * q + (e >> 1)][2 * (e & 1)] * bflo(rg[q][e]); y[2 * e + 1] = o[8 * q + 2 * e + 1] * rstd * wn[2 * q + (e >> 1)][2 * (e & 1) + 1] * bfhi(rg[q][e]); }
            u32x4 w; w.x = pk2(y[0], y[1]); w.y = pk2(y[2], y[3]); w.z = pk2(y[4], y[5]); w.w = pk2(y[6], y[7]);
            *(u32x4*)(Y + (size_t)m * DM + half * 512 + c + 8 * q) = w;
        }
    }
#undef P5_LOAD
}

__device__ __forceinline__ int uc_index(int s, int n, int h, int dir) { return ((chunk_base(s) + n) * 4 + h) * 2 + dir; }
__device__ __forceinline__ unsigned char* grec_ptr(Frame& F, int uc) { return uc < N1G ? F.ws + WS_I + (size_t)uc * GREC : (unsigned char*)F.out + OUT_GOVF + (size_t)(uc - N1G) * GREC; }
__device__ __forceinline__ unsigned char* hrec_ptr(Frame& F, int uc) { return F.ws + WS_I + (size_t)uc * HREC; }
__device__ __forceinline__ bool allowed(int dir, int t, int s) { return dir ? (s >= t) : (s <= t); }

__device__ __forceinline__ void write_qd_image(Frame& F, const LAS bf16* X, int pitch, const LAS float* rowscale, unsigned char* dst) {
    const int r = F.lane & 15, g = F.lane >> 4, mt = F.wave >> 1;
#pragma unroll
    for (int q = 0; q < 2; ++q) {
        const int ks = 2 * (F.wave & 1) + q, row = 16 * mt + r;
        const u32x2 a = *(const LAS u32x2*)(X + row * pitch + 32 * ks + 4 * g), b = *(const LAS u32x2*)(X + row * pitch + 32 * ks + 16 + 4 * g);
        u32x4 o;
        if (rowscale) { const float sc = rowscale[row];
            o.x = pk2(bflo(a.x) * sc, bfhi(a.x) * sc); o.y = pk2(bflo(a.y) * sc, bfhi(a.y) * sc); o.z = pk2(bflo(b.x) * sc, bfhi(b.x) * sc); o.w = pk2(bflo(b.y) * sc, bfhi(b.y) * sc);
        } else { o.x = a.x; o.y = a.y; o.z = b.x; o.w = b.y; }
        *(u32x4*)(dst + ((mt * 4 + ks) * 64 + F.lane) * 16) = o;
    }
}
__device__ __forceinline__ void write_at_image(Frame& F, const LAS bf16* KA, const LAS bf16* QB, int pitch, const LAS float* Cs, int dir, unsigned char* dst) {
    const int r = F.lane & 15, g = F.lane >> 4, mt = F.wave >> 1, ks2 = F.wave & 1;
    f32x4 a0 = {0.f, 0.f, 0.f, 0.f}, a1 = {0.f, 0.f, 0.f, 0.f};
#pragma unroll
    for (int kd = 0; kd < 4; ++kd) {
        const bf16x8 bq = as_frag(*(const LAS u32x4*)(QB + (16 * mt + r) * pitch + 32 * kd + 8 * g));
        const bf16x8 k0 = as_frag(*(const LAS u32x4*)(KA + (32 * ks2 + r) * pitch + 32 * kd + 8 * g));
        const bf16x8 k1 = as_frag(*(const LAS u32x4*)(KA + (32 * ks2 + 16 + r) * pitch + 32 * kd + 8 * g));
        a0 = mfma16(k0, bq, a0); a1 = mfma16(k1, bq, a1);
    }
    const int t = 16 * mt + r; const float ct = Cs ? Cs[t] : 0.f;
    f32x4 cs0 = {0.f, 0.f, 0.f, 0.f}, cs1 = {0.f, 0.f, 0.f, 0.f};
    if (Cs) { cs0 = *(const LAS f32x4*)(Cs + 32 * ks2 + 4 * g); cs1 = *(const LAS f32x4*)(Cs + 32 * ks2 + 16 + 4 * g); }
    float v[8];
#pragma unroll
    for (int j = 0; j < 8; ++j) {
        const int s = 32 * ks2 + kperm(g, j); const bool ok = allowed(dir, t, s);
        float x = (j < 4) ? a0[j & 3] : a1[j & 3];
        if (Cs) { const float e = __expf(ok ? ct - ((j < 4) ? cs0[j & 3] : cs1[j & 3]) : 0.f); x *= e; }
        v[j] = ok ? x : 0.f;
    }
    u32x4 o; o.x = pk2(v[0], v[1]); o.y = pk2(v[2], v[3]); o.z = pk2(v[4], v[5]); o.w = pk2(v[6], v[7]);
    *(u32x4*)(dst + ((mt * 2 + ks2) * 64 + F.lane) * 16) = o;
}

__device__ __forceinline__ void p3h_load(Frame& F, int task, unsigned (&gw)[8], unsigned (&qw)[8], unsigned (&vw)[8]) {
    const int dir = task & 1, h = (task >> 1) & 3, cidx = task >> 3;
    int s, n; if (cidx < 64) { s = cidx >> 2; n = cidx & 3; } else { s = 16 + ((cidx - 64) >> 6); n = (cidx - 64) & 63; }
    const bf16* Gd = OUTB(bf16, dir ? OUT_GB : OUT_GF); const bf16* QA = OUTB(bf16, OUT_QA); const bf16* VA = OUTB(bf16, OUT_VA);
    const int c0 = 2 * (F.tid & 63), re = F.tid >> 6;
#pragma unroll
    for (int e = 0; e < 8; ++e) {
        const size_t off = (size_t)tok_a(s, n, 8 * re + e) * 512 + h * 128 + c0;
        gw[e] = *(const unsigned*)(Gd + off); qw[e] = *(const unsigned*)(QA + off);
        if (dir == ((task >> 8) & 1)) vw[e] = *(const unsigned*)(VA + off);
    }
}
__device__ __forceinline__ void p3_hgrn(Frame& F) {
    constexpr int PITCH = 136;
    LAS bf16* QDb = (LAS bf16*)(F.lds);
    LAS bf16* KDb = (LAS bf16*)(F.lds + 17408);
    LAS unsigned char* KTi = F.lds + 34816;
    LAS float* part = (LAS float*)(F.lds + 51200);
    LAS float* etot = (LAS float*)(F.lds + 55296);
    LAS bf16* Vb = (LAS bf16*)(F.lds + 56320);
    unsigned ngw[8], nqw[8], nvw[8];
    if (F.bid < NUC) p3h_load(F, F.bid, ngw, nqw, nvw);
    for (int task = F.bid; task < NUC; task += F.G) {
        const int dir = task & 1, h = (task >> 1) & 3, cidx = task >> 3;
        int s, n; if (cidx < 64) { s = cidx >> 2; n = cidx & 3; } else { s = 16 + ((cidx - 64) >> 6); n = (cidx - 64) & 63; }
        PROBE_BEGIN(61);
        unsigned char* rec = hrec_ptr(F, task);
        const int cp = F.tid & 63, re = F.tid >> 6, c0 = 2 * cp;
        float f0[8], f1[8], q0[8], q1[8], p0[8], p1[8];
#pragma unroll
        for (int e = 0; e < 8; ++e) {
            f0[e] = __expf(bflo(ngw[e])); f1[e] = __expf(bfhi(ngw[e])); q0[e] = bflo(nqw[e]); q1[e] = bfhi(nqw[e]);
            if (dir == ((task >> 8) & 1)) *(LAS unsigned*)(Vb + (8 * re + e) * PITCH + c0) = nvw[e];
        }
        if (task + F.G < NUC) p3h_load(F, task + F.G, ngw, nqw, nvw);
        if (dir == 0) { float a = 1.f, b = 1.f;
#pragma unroll
            for (int e = 0; e < 8; ++e) { a *= f0[e]; b *= f1[e]; p0[e] = a; p1[e] = b; }
            part[re * 128 + c0] = a; part[re * 128 + c0 + 1] = b;
        } else { float a = 1.f, b = 1.f;
#pragma unroll
            for (int e = 7; e >= 0; --e) { a *= f0[e]; b *= f1[e]; p0[e] = a; p1[e] = b; }
            part[re * 128 + c0] = a; part[re * 128 + c0 + 1] = b;
        }
        __syncthreads();
        PROBE_END(61); PROBE_BEGIN(62);
        float o0 = 1.f, o1 = 1.f, t0 = 1.f, t1 = 1.f;
#pragma unroll
        for (int r2 = 0; r2 < 8; ++r2) { const float a = part[r2 * 128 + c0], b = part[r2 * 128 + c0 + 1]; t0 *= a; t1 *= b; const bool pre = dir ? (r2 > re) : (r2 < re); if (pre) { o0 *= a; o1 *= b; } }
        if (re == 0) { etot[c0] = t0; etot[c0 + 1] = t1; }
        float kt0[8], kt1[8];
#pragma unroll
        for (int e = 0; e < 8; ++e) {
            const float E0 = o0 * p0[e], E1 = o1 * p1[e];
            const float k0 = 1.f - f0[e], k1 = 1.f - f1[e];
            const float kd0 = k0 * __builtin_amdgcn_rcpf(E0), kd1 = k1 * __builtin_amdgcn_rcpf(E1);
            const int row = 8 * re + e;
            *(LAS unsigned*)(QDb + row * PITCH + c0) = pk2(q0[e] * E0, q1[e] * E1);
            *(LAS unsigned*)(KDb + row * PITCH + c0) = pk2(kd0, kd1);
            kt0[e] = kd0 * t0; kt1[e] = kd1 * t1;
        }
        {
            const int ks = re >> 2, hf = (re >> 1) & 1;
#pragma unroll
            for (int cc = 0; cc < 2; ++cc) {
                const int c = c0 + cc, kt = c >> 4, r = c & 15;
#pragma unroll
                for (int p = 0; p < 2; ++p) {
                    const int g = 2 * (re & 1) + p;
                    u32x2 w;
                    if (cc == 0) { w.x = pk2(kt0[4 * p], kt0[4 * p + 1]); w.y = pk2(kt0[4 * p + 2], kt0[4 * p + 3]); } else { w.x = pk2(kt1[4 * p], kt1[4 * p + 1]); w.y = pk2(kt1[4 * p + 2], kt1[4 * p + 3]); }
                    *(LAS u32x2*)(KTi + ((kt * 2 + ks) * 64 + g * 16 + r) * 16 + 8 * hf) = w;
                }
            }
        }
        __syncthreads();
        PROBE_END(62); PROBE_BEGIN(63);
        write_qd_image(F, QDb, PITCH, nullptr, rec);
        write_at_image(F, KDb, QDb, PITCH, nullptr, dir, rec + 16384);
        for (int i = F.tid; i < 1024; i += NTHR) *(u32x4*)(rec + 24576 + i * 16) = *(const LAS u32x4*)(KTi + i * 16);
        if (F.tid < 32) *(f32x4*)(rec + 40960 + F.tid * 16) = *(const LAS f32x4*)((LAS unsigned char*)etot + F.tid * 16);
        if (dir == ((task >> 8) & 1)) {
            unsigned char* vb = F.ws + WS_HVB + (size_t)(task >> 1) * 16384;
            const int c = F.lane & 15, g = F.lane >> 4, w = F.wave;
#pragma unroll
            for (int ks2 = 0; ks2 < 2; ++ks2) {
                unsigned short x[8];
#pragma unroll
                for (int j = 0; j < 8; ++j) x[j] = Vb[(32 * ks2 + kperm(g, j)) * PITCH + 16 * w + c];
                u32x4 o; o.x = x[0] | ((unsigned)x[1] << 16); o.y = x[2] | ((unsigned)x[3] << 16); o.z = x[4] | ((unsigned)x[5] << 16); o.w = x[6] | ((unsigned)x[7] << 16);
                *(u32x4*)(vb + ((w * 2 + ks2) * 64 + F.lane) * 16) = o;
            }
        }
        __syncthreads();
        PROBE_END(63);
    }
}

__device__ __forceinline__ int lp_rowoff(int a) { if (a == 0) return 0; const int A = a - 1, m = A >> 2, r = A & 3; return 8 * m * (m + 1) + 4 * r * (m + 1); }

__device__ __forceinline__ void p3g_invert(LAS float* Lp, int dir, int lane) {
    float T[64];
    const int j = lane;
#pragma unroll
    for (int t = 0; t < 64; ++t) {
        float a0 = 0.f, a1 = 0.f, a2 = 0.f, a3 = 0.f;
        const LAS float* lrow = Lp + lp_rowoff(t);
#pragma unroll
        for (int s4 = 0; s4 < (t + 3) / 4; ++s4) {
            const f32x4 l = *(const LAS f32x4*)(lrow + 4 * s4);
            if (4 * s4 + 0 < t) a0 += l[0] * T[4 * s4 + 0];
            if (4 * s4 + 1 < t) a1 += l[1] * T[4 * s4 + 1];
            if (4 * s4 + 2 < t) a2 += l[2] * T[4 * s4 + 2];
            if (4 * s4 + 3 < t) a3 += l[3] * T[4 * s4 + 3];
        }
        int jj = j; asm volatile("" : "+v"(jj));
        T[t] = (t == jj ? 1.f : 0.f) - ((a0 + a1) + (a2 + a3));
        asm volatile("" ::: "memory");
    }
    LAS bf16* Tb = (LAS bf16*)Lp;
    if (dir == 0) { LAS bf16* tp = Tb + j;
#pragma unroll
        for (int t = 0; t < 64; ++t) tp[t * 72] = (bf16)f2bf(T[t]);
    } else { LAS bf16* tp = Tb + (63 - j);
#pragma unroll
        for (int t = 0; t < 64; ++t) tp[(63 - t) * 72] = (bf16)f2bf(T[t]);
    }
}

__device__ __forceinline__ void p3g_load(Frame& F, int task, const bf16* BQ, const bf16* BK, const bf16* BV, const float* BETA, const float* GGp, u32x4 (&raw)[18], float& gbeta, float& ggate) {
    const int dir = task & 1, h = (task >> 1) & 3, cidx = task >> 3;
    int s, n; if (cidx < 64) { s = cidx >> 2; n = cidx & 3; } else { s = 16 + ((cidx - 64) >> 6); n = (cidx - 64) & 63; }
    const int i = F.tid >> 3, m = tok_b(s, n, i);
    int pos, len, dlt; if (s < 16) { pos = 64 * n + i; len = 256; dlt = 1; } else { pos = i; len = 64; dlt = 64; }
    const bool hasp = pos > 0, hasn = pos + 1 < len; const u32x4 zz = {0u, 0u, 0u, 0u};
#pragma unroll
    for (int a = 0; a < 3; ++a) {
        const bf16* src = (a == 0 ? BQ : (a == 1 ? BK : BV)) + (size_t)m * 512 + h * 128 + 16 * (F.tid & 7);
#pragma unroll
        for (int q = 0; q < 2; ++q) {
            raw[a * 6 + q * 3 + 0] = hasp ? *(const u32x4*)(src - (ptrdiff_t)dlt * 512 + 8 * q) : zz;
            raw[a * 6 + q * 3 + 1] = *(const u32x4*)(src + 8 * q);
            raw[a * 6 + q * 3 + 2] = hasn ? *(const u32x4*)(src + (ptrdiff_t)dlt * 512 + 8 * q) : zz;
        }
    }
    if (F.wave == 0) { const int mg = tok_b(s, n, F.lane); gbeta = BETA[(size_t)mg * 8 + dir * 4 + h]; ggate = GGp[(size_t)mg * 8 + dir * 4 + h]; }
}

__device__ __forceinline__ void p3_gdn(Frame& F, const int t0, const int tn, const int rank, const int nranks) {
    constexpr int PITCH = 136, TP = 72, NBMAX = 10, LSLOT = 9216;
    LAS unsigned char* slots = F.lds + 40960;
    LAS float* Cs = (LAS float*)(F.lds + 512);
    LAS float* Bs = Cs + 64;
    LAS float* Es = Cs + 128;
    LAS float* Ets = Cs + 192;
    LAS float* Sc = Cs + 256;
    LAS bf16* Qb = (LAS bf16*)(F.lds + 2048);
    LAS bf16* Kb = (LAS bf16*)(F.lds + 19456);
    LAS bf16* VT = (LAS bf16*)(F.lds + 2048);
    LAS bf16* KGT = (LAS bf16*)(F.lds + 20480);
    LAS float* Wc = (LAS float*)(F.lds + 133120);
    int wc_head = -1;
    const bf16* BQ = WSP(bf16, WS_BQ); const bf16* BK = WSP(bf16, WS_BK); const bf16* BV = WSP(bf16, WS_BV);
    const float* BETA = WSP(float, WS_BETA); const float* GGp = WSP(float, WS_GG);
    const float* convw = F.in[I_CONV];
    const int ntask = rank < tn ? (tn - rank + nranks - 1) / nranks : 0;
    for (int b0 = 0; b0 < ntask; b0 += NBMAX) {
      const int nb = ntask - b0 < NBMAX ? ntask - b0 : NBMAX;
      PROBE_BEGIN(51);
      u32x4 raw[18]; float gbeta = 0.f, ggate = 0.f;
#define P3G_LOAD(JT) p3g_load(F, t0 + rank + (b0 + (JT)) * nranks, BQ, BK, BV, BETA, GGp, raw, gbeta, ggate)
      if (nb > 0) P3G_LOAD(0);
      for (int jt = 0; jt < nb; ++jt) {
        const int task = t0 + rank + (b0 + jt) * nranks;
        const int dir = task & 1, h = (task >> 1) & 3, cidx = task >> 3;
        int s, n; if (cidx < 64) { s = cidx >> 2; n = cidx & 3; } else { s = 16 + ((cidx - 64) >> 6); n = (cidx - 64) & 63; }
        unsigned char* rec = grec_ptr(F, task);
        LAS float* Lp = (LAS float*)(slots + jt * LSLOT);
        if (h != wc_head) {
            __syncthreads();
            for (int idx = F.tid; idx < 1152; idx += NTHR) { const int a = idx / 384, r2 = idx % 384, tap = r2 >> 7, ch = r2 & 127; Wc[idx] = convw[tap * 1536 + a * 512 + h * 128 + ch]; }
            wc_head = h;
        }
        PROBE_BEGIN(54);
        if (F.wave == 0) {
            const float beta = gbeta;
            float c = ggate;
#pragma unroll
            for (int d = 1; d < 64; d <<= 1) { const float o = dir ? __shfl_down(c, d) : __shfl_up(c, d); const bool ok = dir ? (F.lane + d < 64) : (F.lane >= d); c += ok ? o : 0.f; }
            const float ctot = __shfl(c, dir ? 0 : 63);
            Cs[F.lane] = c; Bs[F.lane] = beta; Es[F.lane] = __expf(c); Ets[F.lane] = __expf(ctot - c);
            if (F.lane == 0) Sc[0] = __expf(ctot);
        }
        __syncthreads();
        PROBE_END(54); PROBE_BEGIN(55);
        {
            const int i = F.tid >> 3, seg = F.tid & 7, ch0 = 16 * seg;
            const float beta = Bs[i], kg = -beta * Es[i];
#pragma unroll
            for (int a = 0; a < 3; ++a) {
                float val[16];
                const LAS float* wc = Wc + a * 384 + ch0;
#pragma unroll
                for (int q = 0; q < 2; ++q) {
                    const u32x4 xm = raw[a * 6 + q * 3 + 0], x0 = raw[a * 6 + q * 3 + 1], xp = raw[a * 6 + q * 3 + 2];
                    f32x4 w0[2], w1[2], w2[2];
#pragma unroll
                    for (int hh = 0; hh < 2; ++hh) { w0[hh] = *(const LAS f32x4*)(wc + 8 * q + 4 * hh); w1[hh] = *(const LAS f32x4*)(wc + 128 + 8 * q + 4 * hh); w2[hh] = *(const LAS f32x4*)(wc + 256 + 8 * q + 4 * hh); }
#pragma unroll
                    for (int e = 0; e < 4; ++e) {
                        const int ch = 8 * q + 2 * e, hh = e >> 1, ee = 2 * (e & 1);
                        const float y0 = bflo(xm[e]) * w0[hh][ee] + bflo(x0[e]) * w1[hh][ee] + bflo(xp[e]) * w2[hh][ee];
                        const float y1 = bfhi(xm[e]) * w0[hh][ee + 1] + bfhi(x0[e]) * w1[hh][ee + 1] + bfhi(xp[e]) * w2[hh][ee + 1];
                        val[ch] = siluf(y0); val[ch + 1] = siluf(y1);
                    }
                }
                if (a < 2) {
                    float ss = 0.f;
#pragma unroll
                    for (int e = 0; e < 16; ++e) ss += val[e] * val[e];
                    ss += __shfl_xor(ss, 1); ss += __shfl_xor(ss, 2); ss += __shfl_xor(ss, 4);
                    const float rn = __builtin_amdgcn_rsqf(ss + EPS) * (a == 0 ? 0.08838834764831845f : 1.f);
                    unsigned pw[8];
#pragma unroll
                    for (int e = 0; e < 8; ++e) pw[e] = pk2(val[2 * e] * rn, val[2 * e + 1] * rn);
                    LAS bf16* dstp = (a == 0 ? Qb : Kb) + i * PITCH + ch0;
                    *(LAS u32x4*)(dstp) = (u32x4){pw[0], pw[1], pw[2], pw[3]}; *(LAS u32x4*)(dstp + 8) = (u32x4){pw[4], pw[5], pw[6], pw[7]};
                    if (a == 1) {
                        unsigned gw[8];
#pragma unroll
                        for (int e = 0; e < 8; ++e) gw[e] = pk2(kg * val[2 * e] * rn, kg * val[2 * e + 1] * rn);
                        u32x4* gp = (u32x4*)(rec + L_WN + (i * 128 + ch0) * 2);
                        gp[0] = (u32x4){gw[0], gw[1], gw[2], gw[3]}; gp[1] = (u32x4){gw[4], gw[5], gw[6], gw[7]};
                    }
                } else {
                    unsigned vw[8];
#pragma unroll
                    for (int e = 0; e < 8; ++e) vw[e] = pk2(beta * val[2 * e], beta * val[2 * e + 1]);
                    u32x4* vp = (u32x4*)(rec + L_U + (i * 128 + ch0) * 2);
                    vp[0] = (u32x4){vw[0], vw[1], vw[2], vw[3]}; vp[1] = (u32x4){vw[4], vw[5], vw[6], vw[7]};
                }
                asm volatile("" ::: "memory");
            }
            if (jt + 1 < nb) P3G_LOAD(jt + 1);
        }
        PROBE_END(55); PROBE_BEGIN(56);
        __syncthreads();
        {
            const int r = F.lane & 15, g = F.lane >> 4, tt = F.wave >> 1, sp = F.wave & 1;
            f32x4 a0 = {0.f, 0.f, 0.f, 0.f}, a1 = {0.f, 0.f, 0.f, 0.f};
#pragma unroll
            for (int kd = 0; kd < 4; ++kd) {
                const bf16x8 at = as_frag(*(const LAS u32x4*)(Kb + (16 * tt + r) * PITCH + 32 * kd + 8 * g));
                const bf16x8 b0 = as_frag(*(const LAS u32x4*)(Kb + (32 * sp + r) * PITCH + 32 * kd + 8 * g));
                const bf16x8 b1 = as_frag(*(const LAS u32x4*)(Kb + (32 * sp + 16 + r) * PITCH + 32 * kd + 8 * g));
                a0 = mfma16(at, b0, a0); a1 = mfma16(at, b1, a1);
            }
            const f32x4 ct4 = *(const LAS f32x4*)(Cs + 16 * tt + 4 * g), bt4 = *(const LAS f32x4*)(Bs + 16 * tt + 4 * g);
            const float csx0 = Cs[32 * sp + r], csx1 = Cs[32 * sp + 16 + r];
#pragma unroll
            for (int q = 0; q < 2; ++q)
#pragma unroll
                for (int i = 0; i < 4; ++i) {
                    const int t = 16 * tt + 4 * g + i, sx = 32 * sp + 16 * q + r;
                    const bool ok = dir ? (sx > t) : (sx < t);
                    const float v = bt4[i] * (q ? a1[i] : a0[i]) * __expf(ok ? ct4[i] - (q ? csx1 : csx0) : 0.f);
                    const int a = dir ? 63 - t : t, b = dir ? 63 - sx : sx;
                    if (ok) Lp[lp_rowoff(a) + b] = v;
                }
        }
        write_at_image(F, Kb, Qb, PITCH, Cs, dir, rec + L_AT);
        write_qd_image(F, Qb, PITCH, Es, rec + L_QD);
        {
            const int r = F.lane & 15, g = F.lane >> 4, kt = F.wave;
#pragma unroll
            for (int ks2 = 0; ks2 < 2; ++ks2) {
                float v[8];
                const f32x4 e0 = *(const LAS f32x4*)(Ets + 32 * ks2 + 4 * g), e1 = *(const LAS f32x4*)(Ets + 32 * ks2 + 16 + 4 * g);
#pragma unroll
                for (int j = 0; j < 8; ++j) { const int sx = 32 * ks2 + kperm(g, j); v[j] = bf2f(Kb[sx * PITCH + 16 * kt + r]) * ((j < 4) ? e0[j & 3] : e1[j & 3]); }
                u32x4 o; o.x = pk2(v[0], v[1]); o.y = pk2(v[2], v[3]); o.z = pk2(v[4], v[5]); o.w = pk2(v[6], v[7]);
                *(u32x4*)(rec + L_KT + ((kt * 2 + ks2) * 64 + F.lane) * 16) = o;
            }
        }
        if (F.tid == 0) *(float*)(rec + L_SC) = Sc[0];
        __syncthreads();
        PROBE_END(56);
      }
#undef P3G_LOAD
      PROBE_END(51); PROBE_BEGIN(52);
      asm volatile("s_waitcnt vmcnt(0)" ::: "memory");
      for (int jt = F.wave; jt < nb; jt += NWAVES) { const int task = t0 + rank + (b0 + jt) * nranks; p3g_invert((LAS float*)(slots + jt * LSLOT), task & 1, F.lane); }
      __syncthreads();
      PROBE_END(52); PROBE_BEGIN(53);
      u32x4 pv[2], pk[2];
      { unsigned char* rec0 = grec_ptr(F, t0 + rank + b0 * nranks);
#pragma unroll
        for (int q = 0; q < 2; ++q) { const int p = F.lane * 16 + F.wave + 8 * q; pv[q] = *(const u32x4*)(rec0 + L_U + p * 16); pk[q] = *(const u32x4*)(rec0 + L_WN + p * 16); } }
      for (int jt = 0; jt < nb; ++jt) {
        const int task = t0 + rank + (b0 + jt) * nranks;
        unsigned char* rec = grec_ptr(F, task);
        const LAS bf16* Tm = (const LAS bf16*)(slots + jt * LSLOT);
        PROBE_BEGIN(57);
#pragma unroll
        for (int q = 0; q < 2; ++q) {
            const int i = F.lane, c8 = (F.wave + 8 * q) * 8;
            const u32x4 vv = pv[q], kk = pk[q];
            LAS bf16* vt = VT + c8 * TP + i; LAS bf16* kt = KGT + c8 * TP + i;
#pragma unroll
            for (int e = 0; e < 4; ++e) { vt[(2 * e) * TP] = (bf16)(vv[e] & 0xffffu); vt[(2 * e + 1) * TP] = (bf16)(vv[e] >> 16); kt[(2 * e) * TP] = (bf16)(kk[e] & 0xffffu); kt[(2 * e + 1) * TP] = (bf16)(kk[e] >> 16); }
        }
        if (jt + 1 < nb) { unsigned char* rec1 = grec_ptr(F, task + nranks);
#pragma unroll
            for (int q = 0; q < 2; ++q) { const int p = F.lane * 16 + F.wave + 8 * q; pv[q] = *(const u32x4*)(rec1 + L_U + p * 16); pk[q] = *(const u32x4*)(rec1 + L_WN + p * 16); } }
        __syncthreads();
        PROBE_END(57); PROBE_BEGIN(58);
        {
            const int r = F.lane & 15, g = F.lane >> 4;
            {
                const int w = F.wave;
                bf16x8 bv[2];
#pragma unroll
                for (int ks2 = 0; ks2 < 2; ++ks2) bv[ks2] = as_frag(*(const LAS u32x4*)(VT + (16 * w + r) * TP + 32 * ks2 + 8 * g));
#pragma unroll
                for (int mt = 0; mt < 4; ++mt) {
                    f32x4 a = {0.f, 0.f, 0.f, 0.f};
#pragma unroll
                    for (int ks2 = 0; ks2 < 2; ++ks2) a = mfma16(as_frag(*(const LAS u32x4*)(Tm + (16 * mt + r) * TP + 32 * ks2 + 8 * g)), bv[ks2], a);
                    u32x2 o; o.x = pk2(a[0], a[1]); o.y = pk2(a[2], a[3]);
                    *(u32x2*)(rec + L_U + ((w * 4 + mt) * 64 + F.lane) * 8) = o;
                }
            }
            {
                const int mt = F.wave >> 1;
                bf16x8 bt[2];
#pragma unroll
                for (int ks2 = 0; ks2 < 2; ++ks2) bt[ks2] = as_frag(*(const LAS u32x4*)(Tm + (16 * mt + r) * TP + 32 * ks2 + 8 * g));
#pragma unroll
                for (int q = 0; q < 2; ++q) {
                    const int ks = 2 * (F.wave & 1) + q;
                    f32x4 a0 = {0.f, 0.f, 0.f, 0.f}, a1 = {0.f, 0.f, 0.f, 0.f};
#pragma unroll
                    for (int ks2 = 0; ks2 < 2; ++ks2) {
                        a0 = mfma16(as_frag(*(const LAS u32x4*)(KGT + (32 * ks + r) * TP + 32 * ks2 + 8 * g)), bt[ks2], a0);
                        a1 = mfma16(as_frag(*(const LAS u32x4*)(KGT + (32 * ks + 16 + r) * TP + 32 * ks2 + 8 * g)), bt[ks2], a1);
                    }
                    u32x4 o; o.x = pk2(a0[0], a0[1]); o.y = pk2(a0[2], a0[3]); o.z = pk2(a1[0], a1[1]); o.w = pk2(a1[2], a1[3]);
                    *(u32x4*)(rec + L_WN + ((mt * 4 + ks) * 64 + F.lane) * 16) = o;
                }
            }
        }
        __syncthreads();
        PROBE_END(58);
      }
      PROBE_END(53);
    }
}

template <bool GDN>
__device__ __forceinline__ void p4_chain(Frame& F) {
    LAS unsigned char* img = F.lds;
    const int c = F.lane & 15, g = F.lane >> 4;
    const float* st_in = F.in[GDN ? I_SG : I_SH];
    float* st_out = F.out + OUT_Y_FLOATS + (GDN ? STATE_FLOATS : 0);
    bf16* Obase = GDN ? WSP(bf16, WS_OB) : OUTB(bf16, OUT_OA);
    constexpr int N16 = GDN ? GREC / 16 : HREC / 16;
    constexpr int NPC = ((GDN ? GREC : HREC) + 1023) / 1024;
    gu32* prog = (gu32*)(F.ws + WS_CTL) + (GDN ? CW_PROG_G : CW_PROG_H);
    const bool roles = (F.G == 256);
    if (roles && F.bid >= 64 && F.bid < 128) {
        const int hb = F.bid - 64, u = hb & 31, j0 = hb >> 5;
        const int s = 16 + (u >> 3), h = (u >> 1) & 3, dir = u & 1, N = 64;
        u32x4 dummy = {0u, 0u, 0u, 0u};
        for (int st = j0; st < N; st += 2) {
            for (unsigned sp = 0; sp < (1u << 15); ++sp) { const unsigned p = __hip_atomic_load(prog + 64 * u, RLX_AGENT); if ((int)p + P4_PD > st) break; __builtin_amdgcn_s_sleep(8); }
            const int n = dir ? N - 1 - st : st; const int uc = uc_index(s, n, h, dir);
            const unsigned char* rec = GDN ? grec_ptr(F, uc) : hrec_ptr(F, uc);
            for (int idx = F.tid; idx < N16; idx += NTHR) { const unsigned char* p = rec + (size_t)idx * 16; asm volatile("global_load_dwordx4 %0, %1, off" : "+v"(dummy) : "v"(p) : "memory"); }
            if (!GDN) { const unsigned char* vb = F.ws + WS_HVB + (size_t)(uc >> 1) * 16384;
                for (int idx = F.tid; idx < 1024; idx += NTHR) { const unsigned char* p = vb + (size_t)idx * 16; asm volatile("global_load_dwordx4 %0, %1, off" : "+v"(dummy) : "v"(p) : "memory"); } }
        }
        asm volatile("s_waitcnt vmcnt(0)" : "+v"(dummy) :: "memory");
        return;
    }
    for (int uidx0 = F.bid; uidx0 < (roles ? 256 : 160); uidx0 += F.G) {
        int uidx = uidx0, ncw = 8, sl0 = 0;
        if (roles) { if (uidx0 >= 128) uidx = uidx0 - 96; else { uidx = uidx0 & 31; ncw = 4; sl0 = 4 * (uidx0 >> 5); } }
        const bool lead = roles && uidx0 < 32;
        const int w = sl0 + F.wave; const bool comp = F.wave < ncw;
        const int dwn = ncw < 8 ? 8 - ncw : 8, dw0 = ncw < 8 ? F.wave - ncw : F.wave;
        int s, h, dir;
        if (uidx < 32) { s = 16 + (uidx >> 3); h = (uidx >> 1) & 3; dir = uidx & 1; } else { const int j = uidx - 32; s = j >> 3; h = (j >> 1) & 3; dir = j & 1; }
        const int N = seq_nchunk(s), bq = s < 16 ? s : s - 16;
        f32x4 S[8];
        if (!comp) {
#pragma unroll
            for (int kt = 0; kt < 8; ++kt) S[kt] = (f32x4){0.f, 0.f, 0.f, 0.f};
        } else if (s >= 16) {
            const float* sp = st_in + (size_t)((bq * 2 + dir) * 4 + h) * 16384 + 16 * w + c;
#pragma unroll
            for (int kt = 0; kt < 8; ++kt)
#pragma unroll
                for (int i = 0; i < 4; ++i) S[kt][i] = sp[(16 * kt + 4 * g + i) * 128];
        } else {
#pragma unroll
            for (int kt = 0; kt < 8; ++kt) S[kt] = (f32x4){0.f, 0.f, 0.f, 0.f};
        }
        const int hfi = sl0 >> 2;
#define P4_PIECE(REC, DST, P) __builtin_amdgcn_global_load_lds((const unsigned*)((REC) + (size_t)(P) * 1024), (LAS unsigned*)((DST) + (P) * 1024), 16, 0, 0)
#define P4_ADDR(STEP, BUF) \
            const int n_ = dir ? N - 1 - (STEP) : (STEP); const int uc_ = uc_index(s, n_, h, dir); \
            const unsigned char* rec_ = (GDN ? grec_ptr(F, uc_) : hrec_ptr(F, uc_)) + F.lane * 16; \
            LAS unsigned char* dst_ = F.lds + (BUF) * P4_BUF + (GDN ? 0 : L_QD); \
            const unsigned char* vb_ = F.ws + WS_HVB + (size_t)(uc_ >> 1) * 16384 + F.lane * 16; LAS unsigned char* dv_ = F.lds + (BUF) * P4_BUF + L_WN;
#define P4_DMA_ALL(STEP, BUF) do { P4_ADDR(STEP, BUF) \
            for (int p = F.wave; p < NPC; p += NWAVES) P4_PIECE(rec_, dst_, p); \
            if (!GDN) { for (int p = F.wave; p < 16; p += NWAVES) P4_PIECE(vb_, dv_, p); } } while (0)
#define P4_DMA_P1(STEP, BUF) do { P4_ADDR(STEP, BUF) \
            if (GDN) { for (int p = dw0; p < 16; p += 4) P4_PIECE(rec_, dst_, p); for (int p = 56 + 8 * hfi + dw0; p < 64 + 8 * hfi; p += 4) P4_PIECE(rec_, dst_, p); } \
            else { for (int p = dw0; p < 16; p += 4) P4_PIECE(rec_, dst_, p); } } while (0)
#define P4_DMA_P2(STEP, BUF) do { P4_ADDR(STEP, BUF) \
            if (GDN) { for (int p = 16 + dw0; p < 56; p += 4) P4_PIECE(rec_, dst_, p); if (dw0 == 0) P4_PIECE(rec_, dst_, 72); } \
            else { for (int p = 8 * hfi + dw0; p < 8 * hfi + 8; p += 4) P4_PIECE(vb_, dv_, p); for (int p = 16 + dw0; p < 40; p += 4) P4_PIECE(rec_, dst_, p); if (dw0 == 0) P4_PIECE(rec_, dst_, 40); } } while (0)
#define FRAG(off, idx) (*(const LAS u32x4*)(img + (off) + ((idx) * 64 + F.lane) * 16))
#define P4_BAR() do { asm volatile("s_waitcnt lgkmcnt(0)" ::: "memory"); __builtin_amdgcn_s_barrier(); } while (0)
        const bool split = ncw < 8;
        P4_DMA_ALL(0, 0);
        asm volatile("s_waitcnt vmcnt(0)" ::: "memory");
        __syncthreads();
        for (int step = 0; step < N; ++step) {
            const int cur = step & 1;
            LAS unsigned char* img = F.lds + cur * P4_BUF;
            const bool more = step + 1 < N;
            if (lead && F.tid == 0) __hip_atomic_store(prog + 64 * uidx, (unsigned)(step + 1), RLX_AGENT);
            if (!split) { if (more) P4_DMA_ALL(step + 1, cur ^ 1); }
            else if (!comp) {
                if (more) { P4_DMA_P1(step + 1, cur ^ 1);
                    if (GDN) asm volatile("s_waitcnt vmcnt(6)" ::: "memory"); else asm volatile("s_waitcnt vmcnt(4)" ::: "memory"); }
                else asm volatile("s_waitcnt vmcnt(0)" ::: "memory");
            }
            const int n = dir ? N - 1 - step : step;
            bf16x8 Sb[4]; bf16x8 Xb[2]; u32x4 fa[8], fb[8]; f32x4 O[4];
            if (comp) {
#pragma unroll
                for (int ks = 0; ks < 4; ++ks) { u32x4 o; o.x = pk2(S[2 * ks][0], S[2 * ks][1]); o.y = pk2(S[2 * ks][2], S[2 * ks][3]); o.z = pk2(S[2 * ks + 1][0], S[2 * ks + 1][1]); o.w = pk2(S[2 * ks + 1][2], S[2 * ks + 1][3]); Sb[ks] = as_frag(o); }
                if (GDN) {
                    f32x4 X[4];
#pragma unroll
                    for (int mt = 0; mt < 4; ++mt)
#pragma unroll
                        for (int k = 0; k < 2; ++k) fa[mt * 2 + k] = FRAG(L_WN, mt * 4 + k);
#pragma unroll
                    for (int mt = 0; mt < 4; ++mt)
#pragma unroll
                        for (int k = 0; k < 2; ++k) fb[mt * 2 + k] = FRAG(L_WN, mt * 4 + 2 + k);
#pragma unroll
                    for (int mt = 0; mt < 4; ++mt) { const u32x2 uu = *(const LAS u32x2*)(img + L_U + ((w * 4 + mt) * 64 + F.lane) * 8); X[mt] = (f32x4){bflo(uu.x), bfhi(uu.x), bflo(uu.y), bfhi(uu.y)}; }
#pragma unroll
                    for (int k = 0; k < 2; ++k)
#pragma unroll
                        for (int mt = 0; mt < 4; ++mt) X[mt] = mfma16(as_frag(fa[mt * 2 + k]), Sb[k], X[mt]);
#pragma unroll
                    for (int k = 0; k < 2; ++k)
#pragma unroll
                        for (int mt = 0; mt < 4; ++mt) X[mt] = mfma16(as_frag(fb[mt * 2 + k]), Sb[2 + k], X[mt]);
#pragma unroll
                    for (int k2 = 0; k2 < 2; ++k2) { u32x4 o; o.x = pk2(X[2 * k2][0], X[2 * k2][1]); o.y = pk2(X[2 * k2][2], X[2 * k2][3]); o.z = pk2(X[2 * k2 + 1][0], X[2 * k2 + 1][1]); o.w = pk2(X[2 * k2 + 1][2], X[2 * k2 + 1][3]); Xb[k2] = as_frag(o); }
                } else {
#pragma unroll
                    for (int mt = 0; mt < 4; ++mt)
#pragma unroll
                        for (int k = 0; k < 2; ++k) { fa[mt * 2 + k] = FRAG(L_QD, mt * 4 + k); fb[mt * 2 + k] = FRAG(L_QD, mt * 4 + 2 + k); }
#pragma unroll
                    for (int mt = 0; mt < 4; ++mt) O[mt] = (f32x4){0.f, 0.f, 0.f, 0.f};
#pragma unroll
                    for (int k = 0; k < 2; ++k)
#pragma unroll
                        for (int mt = 0; mt < 4; ++mt) O[mt] = mfma16(Sb[k], as_frag(fa[mt * 2 + k]), O[mt]);
#pragma unroll
                    for (int k = 0; k < 2; ++k)
#pragma unroll
                        for (int mt = 0; mt < 4; ++mt) O[mt] = mfma16(Sb[2 + k], as_frag(fb[mt * 2 + k]), O[mt]);
                }
            }
            P4_BAR();
            if (split && !comp && more) {
                P4_DMA_P2(step + 1, cur ^ 1);
                if (GDN) { if (dw0 == 0) asm volatile("s_waitcnt vmcnt(11)" ::: "memory"); else asm volatile("s_waitcnt vmcnt(10)" ::: "memory"); }
                else     { if (dw0 == 0) asm volatile("s_waitcnt vmcnt(9)" ::: "memory");  else asm volatile("s_waitcnt vmcnt(8)" ::: "memory"); }
            }
            if (comp) {
                if (GDN) {
#pragma unroll
                    for (int mt = 0; mt < 4; ++mt)
#pragma unroll
                        for (int k = 0; k < 2; ++k) { fa[mt * 2 + k] = FRAG(L_QD, mt * 4 + k); fb[mt * 2 + k] = FRAG(L_QD, mt * 4 + 2 + k); }
#pragma unroll
                    for (int mt = 0; mt < 4; ++mt) O[mt] = (f32x4){0.f, 0.f, 0.f, 0.f};
#pragma unroll
                    for (int k = 0; k < 2; ++k)
#pragma unroll
                        for (int mt = 0; mt < 4; ++mt) O[mt] = mfma16(Sb[k], as_frag(fa[mt * 2 + k]), O[mt]);
#pragma unroll
                    for (int i = 0; i < 8; ++i) fa[i] = FRAG(L_AT, i);
#pragma unroll
                    for (int k = 0; k < 2; ++k)
#pragma unroll
                        for (int mt = 0; mt < 4; ++mt) O[mt] = mfma16(Sb[2 + k], as_frag(fb[mt * 2 + k]), O[mt]);
                } else {
#pragma unroll
                    for (int k2 = 0; k2 < 2; ++k2) Xb[k2] = as_frag(FRAG(L_WN, w * 2 + k2));
#pragma unroll
                    for (int i = 0; i < 8; ++i) fa[i] = FRAG(L_AT, i);
                }
#pragma unroll
                for (int i = 0; i < 8; ++i) fb[i] = FRAG(L_KT, i);
#pragma unroll
                for (int k2 = 0; k2 < 2; ++k2)
#pragma unroll
                    for (int mt = 0; mt < 4; ++mt) O[mt] = mfma16(Xb[k2], as_frag(fa[mt * 2 + k2]), O[mt]);
#pragma unroll
                for (int i = 0; i < 8; ++i) fa[i] = FRAG(L_KT, 8 + i);
                {
                    f32x4 d[8];
                    if (GDN) { const float ds = *(const LAS float*)(img + L_SC);
#pragma unroll
                        for (int kt = 0; kt < 8; ++kt) d[kt] = (f32x4){ds, ds, ds, ds}; }
                    else {
#pragma unroll
                        for (int kt = 0; kt < 8; ++kt) d[kt] = *(const LAS f32x4*)(img + L_U + (16 * kt + 4 * g) * 4); }
#pragma unroll
                    for (int kt = 0; kt < 8; ++kt) S[kt] = S[kt] * d[kt];
                }
#pragma unroll
                for (int k2 = 0; k2 < 2; ++k2)
#pragma unroll
                    for (int kt = 0; kt < 4; ++kt) S[kt] = mfma16(as_frag(fb[kt * 2 + k2]), Xb[k2], S[kt]);
#pragma unroll
                for (int k2 = 0; k2 < 2; ++k2)
#pragma unroll
                    for (int kt = 0; kt < 4; ++kt) S[4 + kt] = mfma16(as_frag(fa[kt * 2 + k2]), Xb[k2], S[4 + kt]);
#pragma unroll
                for (int mt = 0; mt < 4; ++mt) {
                    const int li = 16 * mt + c;
                    const int m = GDN ? tok_b(s, n, li) : tok_a(s, n, li);
                    u32x2 o; o.x = pk2(O[mt][0], O[mt][1]); o.y = pk2(O[mt][2], O[mt][3]);
                    *(u32x2*)(Obase + (size_t)dir * (10 * MiB) + (size_t)m * 512 + h * 128 + 16 * w + 4 * g) = o;
                }
            }
            if (!split) asm volatile("s_waitcnt vmcnt(0)" ::: "memory");
            P4_BAR();
        }
#undef P4_PIECE
#undef P4_ADDR
#undef P4_DMA_ALL
#undef P4_DMA_P1
#undef P4_DMA_P2
#undef P4_BAR
#undef FRAG
        if (s < 16 && comp) {
            float* sp = st_out + (size_t)((bq * 2 + dir) * 4 + h) * 16384 + 16 * w + c;
#pragma unroll
            for (int kt = 0; kt < 8; ++kt)
#pragma unroll
                for (int i = 0; i < 4; ++i) sp[(16 * kt + 4 * g + i) * 128] = S[kt][i];
        }
    }
    if (GDN && roles && F.bid >= 128) { __syncthreads(); late_weights(F, (F.bid - 128) * NWAVES + F.wave, 128 * NWAVES); }
    if (!GDN && roles && F.bid >= 128) { __syncthreads(); p3_gdn(F, NUC - NR_EARLY, NR_EARLY, F.bid - 128, 128); }
}

constexpr int NPHASE = 13;
__global__ void __launch_bounds__(NTHR, 2) mk_fwd(Args args) {
    extern __shared__ __attribute__((aligned(16))) unsigned char lds_raw[];
    Frame F;
    F.lds = (LAS unsigned char*)lds_raw;
    F.tid = threadIdx.x; F.lane = F.tid & 63; F.wave = __builtin_amdgcn_readfirstlane(F.tid >> 6);
    F.bid = blockIdx.x; F.G = gridDim.x;
#pragma unroll
    for (int i = 0; i < N_IN; ++i) F.in[i] = args.in[i];
    F.out = args.out; F.ws = args.ws; F.pacc = 0ull; F.pt0 = 0ull;
    volatile LAS unsigned* MISC = (volatile LAS unsigned*)(F.lds + MISC_OFF);
    for (int u = F.tid; u < (LDS_BYTES - LDSCTL_OFF) / 4; u += NTHR) ((LAS unsigned*)(F.lds + LDSCTL_OFF))[u] = 0u;
    __syncthreads();
    const int lo = args.ph_lo, hi = args.ph_hi;
    const bool multi = (hi - lo) > 1;
    XcdBarrier bar; bar.bar = (unsigned*)(F.ws + WS_CTL) + CW_BAR; bar.x = 0; bar.st = nullptr;
    if (multi) bar = xcd_barrier_post((unsigned*)(F.ws + WS_CTL) + CW_BAR, MISC + 8);
#ifndef PH_MASK
#define PH_MASK 0x1fff
#endif
#define IN(k) (((PH_MASK >> (k)) & 1) && lo <= (k) && (k) < hi)
#define SEAM(k) do { if (IN(k) && IN((k) + 1)) xcd_barrier(bar); } while (0)
#define NREP(k) ((((REP_MASK) >> (k)) & 1) ? 2 : 1)
#define REPSYNC(k) do { if (((REP_MASK) >> (k)) & 1) xcd_barrier(bar); } while (0)

    PROBE_BEGIN(100);
    if (IN(0)) for (int rep = 0; rep < NREP(0); ++rep) { if (rep) REPSYNC(0); p0_prologue(F); } SEAM(0); PROBE_END(100);
    PROBE_BEGIN(101);
    if (IN(1)) for (int rep = 0; rep < NREP(1); ++rep) { if (rep) REPSYNC(1); modnorm_rows<false>(F, F.in[I_XP], F.in[I_XS], nullptr, F.in[I_N1], 0, 1024, WSP(bf16, WS_H)); } SEAM(1); PROBE_END(101);
    PROBE_BEGIN(102);
    if (IN(2)) for (int rep = 0; rep < NREP(2); ++rep) { if (rep) REPSYNC(2);
        pg8::Gemm g{WSP(bf16, WS_H), WSP(bf16, WS_WIN), NT, NPAD, DM}; pg8::StaticOrder S; S.init(NT, NPAD, DM, F.G, F.bid);
        pg8::EpiProj E;
        E.d0 = OUTB(bf16, OUT_QA); E.d1 = OUTB(bf16, OUT_GF); E.d2 = OUTB(bf16, OUT_GB); E.d3 = OUTB(bf16, OUT_VA); E.d4 = WSP(bf16, WS_AG);
        E.d5 = WSP(bf16, WS_BQ); E.d6 = WSP(bf16, WS_BK); E.d7 = WSP(bf16, WS_BV); E.d8 = WSP(bf16, WS_BZ);
        E.BETA = WSP(float, WS_BETA); E.GG = WSP(float, WS_GG); E.lbraw = F.in[I_LB]; E.Alog = F.in[I_ALOG]; E.dtb = F.in[I_DTB];
        pg8::gemm_phase<pg8::EpiProj, pg8::StaticOrder, true, true>(F.lds, g, S, E);
    } SEAM(2); PROBE_END(102);
    PROBE_BEGIN(103);
    if (IN(3)) for (int rep = 0; rep < NREP(3); ++rep) { if (rep) REPSYNC(3); p3_hgrn(F); } SEAM(3); PROBE_END(103);
    PROBE_BEGIN(104);
    if (IN(4)) for (int rep = 0; rep < NREP(4); ++rep) { if (rep) REPSYNC(4); p4_chain<false>(F); } SEAM(4); PROBE_END(104);
    PROBE_BEGIN(105);
    if (IN(5)) for (int rep = 0; rep < NREP(5); ++rep) { if (rep) REPSYNC(5); p3_gdn(F, 0, (F.G == 256) ? NUC - NR_EARLY : NUC, F.bid, F.G); } SEAM(5); PROBE_END(105);
    PROBE_BEGIN(106);
    if (IN(6)) for (int rep = 0; rep < NREP(6); ++rep) { if (rep) REPSYNC(6); p4_chain<true>(F); } SEAM(6); PROBE_END(106);
    PROBE_BEGIN(107);
    if (IN(7)) for (int rep = 0; rep < NREP(7); ++rep) { if (rep) REPSYNC(7); if (F.G != 256) late_weights(F, F.bid * NWAVES + F.wave, F.G * NWAVES); p5_headnorm(F); } SEAM(7); PROBE_END(107);
    PROBE_BEGIN(108);
    if (IN(8)) for (int rep = 0; rep < NREP(8); ++rep) { if (rep) REPSYNC(8);
        pg8::Gemm g{WSP(bf16, WS_YIN), WSP(bf16, WS_WOUT), NT, DM, DM}; pg8::SplitOrder S; S.init(NT, DM, DM, F.G, F.bid);
        pg8::EpiSplit<pg8::EpiRes<false>> E{{F.in[I_XP], F.in[I_XS], nullptr, WSP(bf16, WS_XR), WSP(float, WS_MOD), 2048, nullptr, nullptr, nullptr}, WSP(float, WS_SLAB), (unsigned*)(F.ws + WS_CTL) + CW_SPLIT6, (LAS unsigned*)(F.lds + MISC_OFF + 64)};
        pg8::gemm_phase<pg8::EpiSplit<pg8::EpiRes<false>>, pg8::SplitOrder, true, true>(F.lds, g, S, E);
    } SEAM(8); PROBE_END(108);
    PROBE_BEGIN(109);
    if (IN(9)) for (int rep = 0; rep < NREP(9); ++rep) { if (rep) REPSYNC(9); modnorm_rows<true>(F, nullptr, nullptr, WSP(bf16, WS_XR), F.in[I_N2], 3072, 4096, WSP(bf16, WS_H2)); } SEAM(9); PROBE_END(109);
    PROBE_BEGIN(110);
    if (IN(10)) for (int rep = 0; rep < NREP(10); ++rep) { if (rep) REPSYNC(10);
        pg8::Gemm g{WSP(bf16, WS_H2), WSP(bf16, WS_WGU), NT, 2 * DFF, DM}; pg8::StaticOrder S; S.init(NT, 2 * DFF, DM, F.G, F.bid);
        pg8::EpiGU E{WSP(bf16, WS_GU)};
        pg8::gemm_phase<pg8::EpiGU, pg8::StaticOrder, true, true>(F.lds, g, S, E);
    } SEAM(10); PROBE_END(110);
    PROBE_BEGIN(111);
    if (IN(11)) for (int rep = 0; rep < NREP(11); ++rep) { if (rep) REPSYNC(11);
        pg8::Gemm g{WSP(bf16, WS_GU), WSP(bf16, WS_WDN), NT, DM, DFF}; pg8::SplitOrder S; S.init(NT, DM, DFF, F.G, F.bid);
        pg8::EpiSplit<pg8::EpiRes<true>> E{{nullptr, nullptr, WSP(bf16, WS_XR), WSP(bf16, WS_XR), WSP(float, WS_MOD), 5120, nullptr, nullptr, nullptr}, WSP(float, WS_SLAB), (unsigned*)(F.ws + WS_CTL) + CW_SPLIT9, (LAS unsigned*)(F.lds + MISC_OFF + 64)};
        pg8::gemm_phase<pg8::EpiSplit<pg8::EpiRes<true>>, pg8::SplitOrder, true, true>(F.lds, g, S, E);
    } SEAM(11); PROBE_END(111);
    PROBE_BEGIN(112);
    if (IN(12)) for (int rep = 0; rep < NREP(12); ++rep) { if (rep) REPSYNC(12); final_norm(F); }
    PROBE_END(112);
    if (PROBE_ID != 0 && blockIdx.x == PROBE_BLK && threadIdx.x == 0) { const unsigned long long t0 = __builtin_amdgcn_s_memrealtime(), dt = F.pacc * PROBE_K; while (__builtin_amdgcn_s_memrealtime() - t0 < dt) __builtin_amdgcn_s_sleep(16); }
#undef IN
#undef SEAM
}

extern "C" void kernel_launch(void* const* d_in, const int* in_sizes, int n_in, void* d_out, int out_size, void* d_ws, size_t ws_size, hipStream_t stream) {
    static int grid = 0;
    if (grid == 0) {
        if (n_in != N_IN || ws_size < WS_END) { fprintf(stderr, "kernel_launch: unexpected n_in %d / ws %zu\n", n_in, ws_size); grid = -1; return; }
        int dev = 0, cus = 0;
        if (hipGetDevice(&dev) != hipSuccess || hipDeviceGetAttribute(&cus, hipDeviceAttributeMultiprocessorCount, dev) != hipSuccess) { grid = -1; return; }
        if (hipFuncSetAttribute((const void*)mk_fwd, hipFuncAttributeMaxDynamicSharedMemorySize, LDS_BYTES) != hipSuccess) { fprintf(stderr, "kernel_launch: hipFuncSetAttribute failed\n"); grid = -1; return; }
        int per_cu = 0;
        if (hipOccupancyMaxActiveBlocksPerMultiprocessor(&per_cu, (const void*)mk_fwd, NTHR, LDS_BYTES) != hipSuccess || per_cu < 1) { fprintf(stderr, "kernel_launch: occupancy query reports %d\n", per_cu); }
        (void)hipGetLastError();
        grid = cus < 256 ? cus : 256;
    }
    if (grid < 0) return;
    (void)hipMemsetAsync((char*)d_ws + WS_CTL, 0, CTL_ZERO_BYTES, stream);
    Args a{};
    for (int i = 0; i < N_IN; ++i) a.in[i] = (const float*)d_in[i];
    a.out = (float*)d_out; a.ws = (unsigned char*)d_ws;
#if MK_ONE_LAUNCH
    a.ph_lo = 0; a.ph_hi = NPHASE;
    hipLaunchKernelGGL(mk_fwd, dim3(grid), dim3(NTHR), LDS_BYTES, stream, a);
#else
    for (int k = 0; k < NPHASE; ++k) { a.ph_lo = k; a.ph_hi = k + 1; hipLaunchKernelGGL(mk_fwd, dim3(grid), dim3(NTHR), LDS_BYTES, stream, a); }
#endif
}
```
